# Optimizing an MI355X kernel written in HIP

```python
import math
import jax, jax.numpy as jnp
from jax import lax
import numpy as np

D_MODEL = 1024
BATCH = 4
SEQ = 4096
DEPTH = 2

SB_HEADS = 8
SB_HEAD_DIM = 64
SB_WIDTH = SB_HEADS * SB_HEAD_DIM
DIFF_HEADS = 4
DIFF_QK_DIM = 64
DIFF_V_DIM = 2 * DIFF_QK_DIM
DIFF_QK_WIDTH = DIFF_HEADS * 2 * DIFF_QK_DIM
DIFF_V_WIDTH = DIFF_HEADS * DIFF_V_DIM
ROPE_THETA = 500000.0
ROT_DIM = DIFF_QK_DIM // 4
Q_BLOCK = 128
IN_COLS = 3 * SB_WIDTH + 2 * DIFF_QK_WIDTH + DIFF_V_WIDTH + 2 * D_MODEL
PEER_HEADS = 8
PEER_N_KEYS = 128
PEER_N_EXPERTS = PEER_N_KEYS * PEER_N_KEYS
PEER_TOPK = 16
PEER_QUERY_DIM = 256
PEER_HALF_DIM = PEER_QUERY_DIM // 2
PEER_CHUNK = 128
NORM_EPS = 1e-6

kernel_name = "hybrid_sb_diffattn_peer_adaln"


def rmsnorm(x, g):
    xf = x.astype(jnp.float32)
    y = xf * lax.rsqrt(jnp.mean(xf * xf, axis=-1, keepdims=True) + NORM_EPS)
    return (y * g.astype(jnp.float32)).astype(x.dtype)


def rope_tables(seq_len):
    pos = jnp.arange(seq_len, dtype=jnp.float32)
    inv_freq = 1.0 / (ROPE_THETA ** (jnp.arange(0, ROT_DIM, 2, dtype=jnp.float32) / ROT_DIM))
    ang = pos[:, None] * inv_freq[None, :]
    return jnp.cos(ang), jnp.sin(ang)


def partial_rope(t, cos, sin):
    tf = t.astype(jnp.float32)
    half = ROT_DIM // 2
    t1 = tf[..., :half]
    t2 = tf[..., half:ROT_DIM]
    rot = jnp.concatenate([t1 * cos - t2 * sin, t2 * cos + t1 * sin], axis=-1)
    return jnp.concatenate([rot, tf[..., ROT_DIM:]], axis=-1).astype(t.dtype)


def stick_breaking_attention(q, k, v):
    B, H, S, d = q.shape
    nb = S // Q_BLOCK
    qb = q.reshape(B, H, nb, Q_BLOCK, d).transpose(2, 0, 1, 3, 4)
    kf = k.astype(jnp.float32)
    vf = v.astype(jnp.float32)
    key_pos = jnp.arange(S)
    scale = 1.0 / math.sqrt(d)

    def block(args):
        qi, i = args
        z = jnp.einsum('bhqd,bhkd->bhqk', qi.astype(jnp.float32), kf) * scale
        q_pos = i * Q_BLOCK + jnp.arange(Q_BLOCK)
        mask = key_pos[None, :] < q_pos[:, None]
        log_fail = jnp.where(mask, jax.nn.log_sigmoid(-z), 0.0)
        after = lax.cumsum(log_fail, axis=3, reverse=True) - log_fail
        w = jnp.where(mask, jnp.exp(jax.nn.log_sigmoid(z) + after), 0.0)
        return jnp.einsum('bhqk,bhkd->bhqd', w, vf)

    out = lax.map(block, (qb, jnp.arange(nb)))
    return out.transpose(1, 2, 0, 3, 4).reshape(B, H, S, d).astype(v.dtype)


def diff_attention(q, k, v, lam):
    B, H, _, S, d = q.shape
    dv = v.shape[-1]
    nb = S // Q_BLOCK
    qb = q.reshape(B, H, 2, nb, Q_BLOCK, d).transpose(3, 0, 1, 2, 4, 5)
    kf = k.astype(jnp.float32)
    vf = v.astype(jnp.float32)
    key_pos = jnp.arange(S)
    scale = 1.0 / math.sqrt(d)

    def block(args):
        qi, i = args
        s = jnp.einsum('bhcqd,bhckd->bhcqk', qi.astype(jnp.float32), kf) * scale
        q_pos = i * Q_BLOCK + jnp.arange(Q_BLOCK)
        mask = key_pos[None, :] <= q_pos[:, None]
        p = jax.nn.softmax(jnp.where(mask, s, -jnp.inf), axis=-1)
        w = p[:, :, 0] - lam * p[:, :, 1]
        return jnp.einsum('bhqk,bhkd->bhqd', w, vf)

    out = lax.map(block, (qb, jnp.arange(nb)))
    return out.transpose(1, 2, 0, 3, 4).reshape(B, H, S, dv).astype(v.dtype)


def token_mixer(h, w_in, gate_b, lam_params, subln_g, w_b_sb, w_b_diff, w_out, cos, sin, lam_init):
    B, S, _ = h.shape
    proj = h @ w_in
    sizes = [SB_WIDTH, SB_WIDTH, SB_WIDTH, DIFF_QK_WIDTH, DIFF_QK_WIDTH, DIFF_V_WIDTH, D_MODEL]
    splits = [int(s) for s in np.cumsum(sizes)]
    sb_q, sb_k, sb_v, d_q, d_k, d_v, g_sb_pre, g_diff_pre = jnp.split(proj, splits, axis=-1)

    def heads(t, n, d):
        return t.reshape(B, S, n, d).transpose(0, 2, 1, 3)

    y_sb = stick_breaking_attention(heads(sb_q, SB_HEADS, SB_HEAD_DIM),
                                    heads(sb_k, SB_HEADS, SB_HEAD_DIM),
                                    heads(sb_v, SB_HEADS, SB_HEAD_DIM))
    y_sb = y_sb.transpose(0, 2, 1, 3).reshape(B, S, SB_WIDTH)

    dq = d_q.reshape(B, S, DIFF_HEADS, 2, DIFF_QK_DIM).transpose(0, 2, 3, 1, 4)
    dk = d_k.reshape(B, S, DIFF_HEADS, 2, DIFF_QK_DIM).transpose(0, 2, 3, 1, 4)
    dq = partial_rope(dq, cos, sin)
    dk = partial_rope(dk, cos, sin)
    lp = lam_params.astype(jnp.float32)
    lam = jnp.exp(jnp.sum(lp[0] * lp[1])) - jnp.exp(jnp.sum(lp[2] * lp[3])) + lam_init
    y_diff = diff_attention(dq, dk, heads(d_v, DIFF_HEADS, DIFF_V_DIM), lam)
    y_diff = rmsnorm(y_diff, subln_g) * (1.0 - lam_init)
    y_diff = y_diff.transpose(0, 2, 1, 3).reshape(B, S, DIFF_V_WIDTH)

    g_sb = jax.nn.sigmoid(g_sb_pre + gate_b[:D_MODEL])
    g_diff = jax.nn.sigmoid(g_diff_pre + gate_b[D_MODEL:])
    merged = g_sb * (y_sb @ w_b_sb) + g_diff * (y_diff @ w_b_diff)
    return merged @ w_out


def peer_mixer(h, wq, subkeys, u, v):
    B, S, D = h.shape
    q = (h @ wq).astype(jnp.float32).reshape(B, S, PEER_HEADS, 2, PEER_HALF_DIM)
    scores = jnp.einsum('bshcd,hcnd->bshcn', q, subkeys.astype(jnp.float32))
    s_top, i_top = lax.top_k(scores, PEER_TOPK)
    cand = s_top[..., 0, :, None] + s_top[..., 1, None, :]
    cand_idx = i_top[..., 0, :, None] * PEER_N_KEYS + i_top[..., 1, None, :]
    cand = cand.reshape(B, S, PEER_HEADS, PEER_TOPK * PEER_TOPK)
    cand_idx = cand_idx.reshape(B, S, PEER_HEADS, PEER_TOPK * PEER_TOPK)
    best, pos = lax.top_k(cand, PEER_TOPK)
    expert_idx = jnp.take_along_axis(cand_idx, pos, axis=-1)
    gates = jax.nn.softmax(best, axis=-1)

    T = B * S
    E = PEER_HEADS * PEER_TOPK
    nc = T // PEER_CHUNK
    hc = h.reshape(nc, PEER_CHUNK, D)
    ic = expert_idx.reshape(nc, PEER_CHUNK, E)
    gc = gates.reshape(nc, PEER_CHUNK, E)

    def chunk(args):
        hh, ii, gg = args
        u_sel = jnp.take(u, ii, axis=0)
        a = jnp.einsum('cd,ced->ce', hh.astype(jnp.float32), u_sel.astype(jnp.float32))
        act = jax.nn.gelu(a, approximate=False) * gg
        v_sel = jnp.take(v, ii, axis=0)
        return jnp.einsum('ce,ced->cd', act, v_sel.astype(jnp.float32))

    out = lax.map(chunk, (hc, ic, gc))
    return out.reshape(B, S, D).astype(h.dtype)


def setup_inputs(seed: int = 0) -> dict:
    key = jax.random.key(seed)
    ks = jax.random.split(key, 20)
    f32 = jnp.float32
    D = D_MODEL
    nrm = lambda k, shape, s: jax.random.normal(k, shape, f32) * s
    return {
        "x": nrm(ks[0], (BATCH, SEQ, D), 1.0),
        "c": nrm(ks[1], (BATCH, D), 1.0),
        "norm1_g": 1.0 + nrm(ks[2], (DEPTH, D), 0.02),
        "norm2_g": 1.0 + nrm(ks[3], (DEPTH, D), 0.02),
        "ada_w": nrm(ks[4], (DEPTH, D, 6 * D), 0.5 * D ** -0.5),
        "ada_b": nrm(ks[5], (DEPTH, 6 * D), 0.02),
        "w_in": nrm(ks[6], (DEPTH, D, IN_COLS), D ** -0.5),
        "gate_b": nrm(ks[7], (DEPTH, 2 * D), 0.02),
        "diff_lambda": nrm(ks[8], (DEPTH, 4, DIFF_QK_DIM), 0.1),
        "diff_subln_g": 1.0 + nrm(ks[9], (DEPTH, DIFF_V_DIM), 0.02),
        "w_branch_sb": nrm(ks[10], (DEPTH, SB_WIDTH, D), SB_WIDTH ** -0.5),
        "w_branch_diff": nrm(ks[11], (DEPTH, DIFF_V_WIDTH, D), DIFF_V_WIDTH ** -0.5),
        "w_out": nrm(ks[12], (DEPTH, D, D), D ** -0.5),
        "peer_wq": nrm(ks[13], (DEPTH, D, PEER_HEADS * PEER_QUERY_DIM), D ** -0.5),
        "peer_subkeys": nrm(ks[14], (DEPTH, PEER_HEADS, 2, PEER_N_KEYS, PEER_HALF_DIM), PEER_HALF_DIM ** -0.5),
        "peer_u": nrm(ks[15], (DEPTH, PEER_N_EXPERTS, D), D ** -0.5),
        "peer_v": nrm(ks[16], (DEPTH, PEER_N_EXPERTS, D), 1.0),
        "final_g": 1.0 + nrm(ks[17], (D,), 0.02),
    }


def reference(x, c, norm1_g, norm2_g, ada_w, ada_b, w_in, gate_b, diff_lambda, diff_subln_g,
              w_branch_sb, w_branch_diff, w_out, peer_wq, peer_subkeys, peer_u, peer_v, final_g):
    S = x.shape[1]
    cos, sin = rope_tables(S)
    c_act = jax.nn.silu(c)
    for i in range(DEPTH):
        lam_init = 0.8 - 0.6 * math.exp(-0.3 * i)
        mod = c_act @ ada_w[i] + ada_b[i]
        shift1, scale1, gate1, shift2, scale2, gate2 = jnp.split(mod[:, None, :], 6, axis=-1)
        h = rmsnorm(x, norm1_g[i]) * (1.0 + scale1) + shift1
        y = token_mixer(h, w_in[i], gate_b[i], diff_lambda[i], diff_subln_g[i],
                        w_branch_sb[i], w_branch_diff[i], w_out[i], cos, sin, lam_init)
        x = x + (gate1 * y).astype(x.dtype)
        h = rmsnorm(x, norm2_g[i]) * (1.0 + scale2) + shift2
        y = peer_mixer(h, peer_wq[i], peer_subkeys[i], peer_u[i], peer_v[i])
        x = x + (gate2 * y).astype(x.dtype)
    return rmsnorm(x, final_g)
```

```cpp
#include <hip/hip_runtime.h>
#include <cstdio>
#include <cstdint>
#include <hip/hip_cooperative_groups.h>
namespace pg8 {
#define PG8_LAS __attribute__((address_space(3)))
typedef unsigned short bf16_t;
typedef short bf16x8 __attribute__((ext_vector_type(8)));
typedef float f32x4 __attribute__((ext_vector_type(4)));
typedef unsigned u32x4 __attribute__((ext_vector_type(4)));
constexpr int BM = 256, BK = 64, HALF = 128, HTB = HALF * BK * 2  , STAGE_BYTES = 8 * HTB, NXCD = 8, WGM = 8;

__host__ __device__ __forceinline__ int lds_byte(int r, int c) { const int st = (r >> 4) * 2 + (c >> 5), rr = r & 15, cc = c & 31, ob = rr * 64 + cc * 2; return st * 1024 + (ob ^ (((ob >> 9) & 1) << 5)); }
__host__ __device__ __forceinline__ void stage_rc(int b, int& R, int& C) { const int st = b / 1024, sb = b % 1024, swz = sb ^ (((sb >> 9) & 1) << 5); R = (st >> 1) * 16 + swz / 64; C = (st & 1) * 32 + (swz % 64) / 2; }
__host__ __device__ __forceinline__ int perm32(int rho) { const int n = rho >> 4, i = rho & 15; return 8 * (i >> 2) + 4 * n + (i & 3); }

struct Unit { int pm, pn; };
struct Gemm { const bf16_t* A; const bf16_t* Bt; int M, N, K; };

struct StaticOrder {
    int nM, nN, nwg, G, c;
    __host__ __device__ void init(int M, int N, int G_, int c_) { nM = M / BM; nN = N / BM; nwg = nM * nN; G = G_; c = c_; }
    __host__ __device__ bool next(int i, Unit& u) const {
        const long L = (long)i * G + c; if (L >= nwg) return false;
        int wgid = (int)L; { const int q = nwg / NXCD, r = nwg % NXCD, xcd = wgid % NXCD, off = wgid / NXCD; wgid = (xcd < r ? xcd * (q + 1) : r * (q + 1) + (xcd - r) * q) + off; }
        const int nig = WGM * nN, gid = wgid / nig, fm = gid * WGM, gsz = (nM - fm) < WGM ? (nM - fm) : WGM;
        u.pm = fm + ((wgid % nig) % gsz); u.pn = (wgid % nig) / gsz; return true;
    }
    __device__ __forceinline__ void a_ready(const Unit&) const {}
    __device__ __forceinline__ void done(const Unit&) const {}
};

__device__ __forceinline__ unsigned cvt_pk_bf16(float lo, float hi) { unsigned r; asm volatile("v_cvt_pk_bf16_f32 %0, %1, %2" : "=v"(r) : "v"(lo), "v"(hi)); return r; }
typedef float f32x2 __attribute__((ext_vector_type(2)));
__device__ __forceinline__ f32x2 gelu_pk(f32x2 v) {
    const f32x2 av = __builtin_elementwise_abs(v), d = av * 0.2316418882f + 1.0f;
    f32x2 t; t.x = __builtin_amdgcn_rcpf(d.x); t.y = __builtin_amdgcn_rcpf(d.y);
    f32x2 q = t * 0.5307027145f + (-0.7265760135f); q = q * t + 0.7107068705f; q = q * t + (-0.142248368f); q = q * t + 0.127414796f; q = q * t;
    const f32x2 s = (v * v) * (-0.72134752044f);
    f32x2 e; e.x = __builtin_amdgcn_exp2f(s.x); e.y = __builtin_amdgcn_exp2f(s.y);
    const f32x2 m = v * (q * e), r = v - m;
    f32x2 o; o.x = v.x < 0.f ? m.x : r.x; o.y = v.y < 0.f ? m.y : r.y; return o;
}

template <int ACT  > struct EpiBf16 {
    static constexpr bool PERM = true, AFTER_DRAIN = false; static_assert(ACT == 0 || ACT == 1, "EpiBf16: ACT is 0 (none) or 1 (gelu_pk)");
    bf16_t* O; int ldc; const float* bias; int split_cols; size_t split_stride; float scale0;
    __device__ __forceinline__ void operator()(const f32x4 (&acc)[2][2][4][2], const Unit& u, int wr, int wc, int fr, int fq) const {
        const int row0 = u.pm * BM + wr * 64 + fr; int colt = u.pn * BM; bf16_t* base = O;
        float sc = 1.f; if (split_cols) { const int t = colt / split_cols; base += (size_t)t * split_stride; colt -= t * split_cols; if (t == 0) sc = scale0; }
        const int col0 = colt + wc * 32 + 8 * fq, bcol0 = u.pn * BM + wc * 32 + 8 * fq;
        f32x4 bv[2][2];
#pragma unroll
        for (int bj = 0; bj < 2; ++bj)
#pragma unroll
            for (int n = 0; n < 2; ++n) bv[bj][n] = bias ? *(const f32x4*)(bias + bcol0 + bj * HALF + 4 * n) : (f32x4){0.f, 0.f, 0.f, 0.f};
#pragma unroll
        for (int ai = 0; ai < 2; ++ai)
#pragma unroll
            for (int m = 0; m < 4; ++m) { bf16_t* rowp = base + (size_t)(row0 + ai * HALF + m * 16) * ldc + col0;
#pragma unroll
                for (int bj = 0; bj < 2; ++bj) { f32x4 v0 = acc[ai][bj][m][0] + bv[bj][0], v1 = acc[ai][bj][m][1] + bv[bj][1];
                    if (ACT == 1) { f32x2 a = gelu_pk((f32x2){v0[0], v0[1]}), b = gelu_pk((f32x2){v0[2], v0[3]}), c = gelu_pk((f32x2){v1[0], v1[1]}), d = gelu_pk((f32x2){v1[2], v1[3]});
                        v0 = (f32x4){a.x, a.y, b.x, b.y}; v1 = (f32x4){c.x, c.y, d.x, d.y}; }
                    v0 = v0 * sc; v1 = v1 * sc; u32x4 w; w.x = cvt_pk_bf16(v0[0], v0[1]); w.y = cvt_pk_bf16(v0[2], v0[3]); w.z = cvt_pk_bf16(v1[0], v1[1]); w.w = cvt_pk_bf16(v1[2], v1[3]);
                    *(u32x4*)(rowp + bj * HALF) = w; } }
    }
};
typedef unsigned u32x2 __attribute__((ext_vector_type(2)));
__device__ __forceinline__ f32x4 bf4_to_f32(unsigned lo, unsigned hi) { f32x4 r; r[0] = __uint_as_float(lo << 16); r[1] = __uint_as_float(lo & 0xffff0000u); r[2] = __uint_as_float(hi << 16); r[3] = __uint_as_float(hi & 0xffff0000u); return r; }
__device__ __forceinline__ float sigmoidf_(float x) { return 1.0f / (1.0f + __expf(-x)); }
constexpr size_t EPI_MiB = 1u << 20;
constexpr size_t EPI_WS_ROPE = 1 * EPI_MiB + 256 * 1024, EPI_WS_SBQ = 136 * EPI_MiB, EPI_WS_SBK = 152 * EPI_MiB, EPI_WS_SBV = 168 * EPI_MiB, EPI_WS_SBVT = 184 * EPI_MiB, EPI_WS_DQ = 200 * EPI_MiB, EPI_WS_DK = 216 * EPI_MiB, EPI_WS_DV = 232 * EPI_MiB,
                 EPI_WS_GSB = 248 * EPI_MiB, EPI_WS_GDF = 280 * EPI_MiB;
struct EpiIn {
    static constexpr bool PERM = true, AFTER_DRAIN = false;
    unsigned char* ws; const float* gate_b;
    __device__ __forceinline__ void operator()(const f32x4 (&acc)[2][2][4][2], const Unit& u, int wr, int wc, int fr, int fq) const {
        bf16_t* const sbq = (bf16_t*)(ws + EPI_WS_SBQ); bf16_t* const sbk = (bf16_t*)(ws + EPI_WS_SBK); bf16_t* const sbv = (bf16_t*)(ws + EPI_WS_SBV); bf16_t* const sbvt = (bf16_t*)(ws + EPI_WS_SBVT);
        bf16_t* const dq = (bf16_t*)(ws + EPI_WS_DQ); bf16_t* const dk = (bf16_t*)(ws + EPI_WS_DK); bf16_t* const dv = (bf16_t*)(ws + EPI_WS_DV); bf16_t* const gsb = (bf16_t*)(ws + EPI_WS_GSB); bf16_t* const gdf = (bf16_t*)(ws + EPI_WS_GDF);
        const float* const rope_cos = (const float*)(ws + EPI_WS_ROPE); const float* const rope_sin = rope_cos + 4096 * 8; const float c2 = 0.125f * 1.4426950408889634f;
        const int row0 = u.pm * BM + wr * 64 + fr; const int pn = u.pn; const int seg = pn >> 1;
        const int cc0 = wc * 32 + 8 * fq;
        if (pn >= 12) {
            const bool isdf = pn >= 16; bf16_t* G = isdf ? gdf : gsb; const int gc0 = (pn - (isdf ? 16 : 12)) * 256 + cc0; const float* gb = gate_b + (isdf ? 1024 : 0) + gc0;
            f32x4 bv[2][2];
#pragma unroll
            for (int bj = 0; bj < 2; ++bj)
#pragma unroll
                for (int n = 0; n < 2; ++n) bv[bj][n] = *(const f32x4*)(gb + bj * HALF + 4 * n);
#pragma unroll
            for (int ai = 0; ai < 2; ++ai)
#pragma unroll
                for (int m = 0; m < 4; ++m) { bf16_t* rowp = G + (size_t)(row0 + ai * HALF + m * 16) * 1024 + gc0;
#pragma unroll
                    for (int bj = 0; bj < 2; ++bj) { const f32x4 v0 = acc[ai][bj][m][0] + bv[bj][0], v1 = acc[ai][bj][m][1] + bv[bj][1];
                        u32x4 w; w.x = cvt_pk_bf16(sigmoidf_(v0[0]), sigmoidf_(v0[1])); w.y = cvt_pk_bf16(sigmoidf_(v0[2]), sigmoidf_(v0[3])); w.z = cvt_pk_bf16(sigmoidf_(v1[0]), sigmoidf_(v1[1])); w.w = cvt_pk_bf16(sigmoidf_(v1[2]), sigmoidf_(v1[3]));
                        *(u32x4*)(rowp + bj * HALF) = w; } }
            return;
        }
        const int col0 = (pn & 1) * 256 + cc0;
        if (seg == 3 || seg == 4) {
            bf16_t* O = seg == 3 ? dq : dk; const float sc = seg == 3 ? c2 : 1.0f;
            const bool ropew = (wc & 1) == 0;
            const bool rl = fq < 2;
#pragma unroll
            for (int ai = 0; ai < 2; ++ai)
#pragma unroll
                for (int m = 0; m < 4; ++m) { const int row = row0 + ai * HALF + m * 16; bf16_t* rowp = O + (size_t)row * 512 + col0;
                    f32x4 cs0 = {1.f, 1.f, 1.f, 1.f}, cs1 = cs0, sn0 = {0.f, 0.f, 0.f, 0.f}, sn1 = sn0;
                    if (ropew) { const int pos = row & 4095; cs0 = *(const f32x4*)(rope_cos + pos * 8); cs1 = *(const f32x4*)(rope_cos + pos * 8 + 4); sn0 = *(const f32x4*)(rope_sin + pos * 8); sn1 = *(const f32x4*)(rope_sin + pos * 8 + 4); }
#pragma unroll
                    for (int bj = 0; bj < 2; ++bj) { f32x4 v0 = acc[ai][bj][m][0], v1 = acc[ai][bj][m][1];
                        if (ropew) { f32x4 p0, p1;
#pragma unroll
                            for (int j = 0; j < 4; ++j) { p0[j] = __shfl_xor(v0[j], 16); p1[j] = __shfl_xor(v1[j], 16); }
                            const float sg = (fq == 0) ? -1.0f : 1.0f;
                            if (rl) { v0 = v0 * cs0 + (p0 * sn0) * sg; v1 = v1 * cs1 + (p1 * sn1) * sg; } }
                        v0 = v0 * sc; v1 = v1 * sc;
                        u32x4 w; w.x = cvt_pk_bf16(v0[0], v0[1]); w.y = cvt_pk_bf16(v0[2], v0[3]); w.z = cvt_pk_bf16(v1[0], v1[1]); w.w = cvt_pk_bf16(v1[2], v1[3]);
                        *(u32x4*)(rowp + bj * HALF) = w; } }
            return;
        }
        bf16_t* O = seg == 0 ? sbq : seg == 1 ? sbk : seg == 2 ? sbv : dv; const float sc = seg == 0 ? 0.125f : 1.0f;
#pragma unroll
        for (int ai = 0; ai < 2; ++ai)
#pragma unroll
            for (int m = 0; m < 4; ++m) { const int row = row0 + ai * HALF + m * 16; bf16_t* rowp = O + (size_t)row * 512 + col0;
#pragma unroll
                for (int bj = 0; bj < 2; ++bj) { const f32x4 v0 = acc[ai][bj][m][0] * sc, v1 = acc[ai][bj][m][1] * sc;
                    u32x4 w; w.x = cvt_pk_bf16(v0[0], v0[1]); w.y = cvt_pk_bf16(v0[2], v0[3]); w.z = cvt_pk_bf16(v1[0], v1[1]); w.w = cvt_pk_bf16(v1[2], v1[3]);
                    *(u32x4*)(rowp + bj * HALF) = w;
                    if (seg == 2) {
                        const int b = row >> 12, t = row & 4095;
#pragma unroll
                        for (int j = 0; j < 8; ++j) { const int col = col0 + bj * HALF + j; const int h = col >> 6, d = col & 63;
                            const unsigned word = j < 2 ? w.x : j < 4 ? w.y : j < 6 ? w.z : w.w; const bf16_t e = (bf16_t)((j & 1) ? (word >> 16) : (word & 0xffffu));
                            sbvt[((size_t)(b * 8 + h) * 64 + d) * 4096 + t] = e; } } } }
    }
};
struct EpiGate {
    static constexpr bool PERM = true, AFTER_DRAIN = false;
    bf16_t* O; const bf16_t* gate; const bf16_t* add;
    __device__ __forceinline__ void operator()(const f32x4 (&acc)[2][2][4][2], const Unit& u, int wr, int wc, int fr, int fq) const {
        const int row0 = u.pm * BM + wr * 64 + fr; const int col0 = u.pn * BM + wc * 32 + 8 * fq;
#pragma unroll
        for (int ai = 0; ai < 2; ++ai)
#pragma unroll
            for (int m = 0; m < 4; ++m) { const size_t off = (size_t)(row0 + ai * HALF + m * 16) * 1024 + col0;
#pragma unroll
                for (int bj = 0; bj < 2; ++bj) { const u32x4 g = *(const u32x4*)(gate + off + bj * HALF);
                    f32x4 v0 = acc[ai][bj][m][0] * bf4_to_f32(g.x, g.y), v1 = acc[ai][bj][m][1] * bf4_to_f32(g.z, g.w);
                    if (add) { const u32x4 a = *(const u32x4*)(add + off + bj * HALF); v0 = v0 + bf4_to_f32(a.x, a.y); v1 = v1 + bf4_to_f32(a.z, a.w); }
                    u32x4 w; w.x = cvt_pk_bf16(v0[0], v0[1]); w.y = cvt_pk_bf16(v0[2], v0[3]); w.z = cvt_pk_bf16(v1[0], v1[1]); w.w = cvt_pk_bf16(v1[2], v1[3]);
                    *(u32x4*)(O + off + bj * HALF) = w; } }
    }
};
struct EpiRes {
    static constexpr bool PERM = false, AFTER_DRAIN = false;
    const float* base; float* out; const float* gvec; int gstride;
    __device__ __forceinline__ void operator()(const f32x4 (&acc)[2][2][4][2], const Unit& u, int wr, int wc, int fr, int fq) const {
        const int row0 = u.pm * BM + wr * 64 + fr; const int col0 = u.pn * BM + wc * 32 + 4 * fq; const int b = (u.pm * BM) >> 12;
        f32x4 gv[2][2];
#pragma unroll
        for (int bj = 0; bj < 2; ++bj)
#pragma unroll
            for (int n = 0; n < 2; ++n) gv[bj][n] = *(const f32x4*)(gvec + (size_t)b * gstride + col0 + bj * HALF + n * 16);
#pragma unroll
        for (int ai = 0; ai < 2; ++ai)
#pragma unroll
            for (int m = 0; m < 4; ++m) { const size_t off = (size_t)(row0 + ai * HALF + m * 16) * 1024 + col0;
#pragma unroll
                for (int bj = 0; bj < 2; ++bj)
#pragma unroll
                    for (int n = 0; n < 2; ++n) { const f32x4 bs = *(const f32x4*)(base + off + bj * HALF + n * 16);
                        *(f32x4*)(out + off + bj * HALF + n * 16) = bs + gv[bj][n] * acc[ai][bj][m][n]; } }
    }
};
template <class Epi, class Sched, bool ALIGN_EPI = false, bool SP2 = false>
__device__ __forceinline__ void gemm_phase(PG8_LAS unsigned char* lds, const Gemm g, const Sched& S, const Epi& E) {
    int tid_ = threadIdx.x; asm volatile("" : "+v"(tid_));
    const int tid = tid_, wid = __builtin_amdgcn_readfirstlane(tid >> 6), lane = tid & 63, wr = wid >> 2, wc = wid & 3, fr = lane & 15, fq = lane >> 4;
    const int K = g.K, nt = K / BK;
    unsigned voffA[2], voffB[2];
#pragma unroll
    for (int i = 0; i < 2; ++i) { int R, C; stage_rc(tid * 16 + i * 8192, R, C); const int Rb = Epi::PERM ? ((R & ~31) + perm32(R & 31)) : R;
        voffA[i] = (unsigned)(R * K + C) * 2u; voffB[i] = (unsigned)(Rb * K + C) * 2u; }
    const size_t kstep = (size_t)(BK * 2);
    const size_t hstep = (size_t)HALF * K * 2;
    const size_t tstep = 2 * hstep;
    const unsigned ldsw = (unsigned)wid * 1024u;
    const int aoff = lds_byte(wr * 64 + fr, fq * 8), boff = lds_byte(wc * 32 + fr, fq * 8);
#define PG8_SA(b, h) (((b) * 2 + (h)) * HTB)
#define PG8_SB(b, h) ((4 + (b) * 2 + (h)) * HTB)
#define PG8_STAGE(bufoff, gbase, voff) do { _Pragma("unroll") for (int _i = 0; _i < 2; ++_i) \
        __builtin_amdgcn_global_load_lds((const unsigned*)((const char*)(gbase) + (voff)[_i]), (PG8_LAS unsigned*)(lds + (bufoff) + ldsw + _i * 8192), 16, 0, 0); } while (0)
#define PG8_LDA(dst, b, h) do { _Pragma("unroll") for (int m = 0; m < 4; ++m) _Pragma("unroll") for (int k = 0; k < 2; ++k) dst[m][k] = *(const PG8_LAS bf16x8*)(lds + PG8_SA(b, h) + aoff + m * 2048 + k * 1024); } while (0)
#define PG8_LDB(dst, b, h) do { _Pragma("unroll") for (int n = 0; n < 2; ++n) _Pragma("unroll") for (int k = 0; k < 2; ++k) dst[n][k] = *(const PG8_LAS bf16x8*)(lds + PG8_SB(b, h) + boff + n * 2048 + k * 1024); } while (0)
#define PG8_MMA(ai, bj, At, Bt) do { __builtin_amdgcn_s_setprio(1); _Pragma("unroll") for (int m = 0; m < 4; ++m) _Pragma("unroll") for (int n = 0; n < 2; ++n) _Pragma("unroll") for (int k = 0; k < 2; ++k) \
        acc[ai][bj][m][n] = __builtin_amdgcn_mfma_f32_16x16x32_bf16(Bt[n][k], At[m][k], acc[ai][bj][m][n], 0, 0, 0); __builtin_amdgcn_s_setprio(0); } while (0)
#define PG8_WAIT_V(n) asm volatile("s_waitcnt vmcnt(" #n ")" ::: "memory")
#define PG8_WAIT_L(n) asm volatile("s_waitcnt lgkmcnt(" #n ")" ::: "memory")
#define PG8_BAR __builtin_amdgcn_s_barrier()
#define PG8_SCHED __builtin_amdgcn_sched_barrier(0)
    Unit cur, nxt; int ui = 0;
    if (!S.next(0, cur)) return;
    f32x4 acc[2][2][4][2];
#pragma unroll
    for (int a = 0; a < 2; ++a)
#pragma unroll
        for (int b = 0; b < 2; ++b)
#pragma unroll
            for (int m = 0; m < 4; ++m)
#pragma unroll
                for (int n = 0; n < 2; ++n) acc[a][b][m][n] = (f32x4){0.f, 0.f, 0.f, 0.f};
    bf16x8 At[4][2], B0[2][2], B1[2][2];
    const char* cA = (const char*)g.A + (size_t)cur.pm * tstep; const char* cB = (const char*)g.Bt + (size_t)cur.pn * tstep;
    S.a_ready(cur);
    if constexpr (SP2) {
        PG8_STAGE(PG8_SB(0, 0), cB, voffB); PG8_STAGE(PG8_SB(0, 1), cB + hstep, voffB); PG8_STAGE(PG8_SA(0, 0), cA, voffA); PG8_STAGE(PG8_SA(0, 1), cA + hstep, voffA);
        if (wr == 1) PG8_BAR;
        PG8_WAIT_V(2); PG8_BAR;
        PG8_STAGE(PG8_SB(1, 0), cB + kstep, voffB); PG8_STAGE(PG8_SA(1, 0), cA + kstep, voffA); PG8_STAGE(PG8_SB(1, 1), cB + hstep + kstep, voffB);
        PG8_WAIT_V(6); PG8_BAR;
    } else {
        PG8_STAGE(PG8_SB(0, 0), cB, voffB); PG8_STAGE(PG8_SA(0, 0), cA, voffA); PG8_STAGE(PG8_SB(0, 1), cB + hstep, voffB); PG8_STAGE(PG8_SA(0, 1), cA + hstep, voffA);
        if (wr == 1) PG8_BAR;
        PG8_WAIT_V(4); PG8_BAR;
        PG8_STAGE(PG8_SB(1, 0), cB + kstep, voffB); PG8_STAGE(PG8_SA(1, 0), cA + kstep, voffA); PG8_STAGE(PG8_SB(1, 1), cB + hstep + kstep, voffB);
        PG8_WAIT_V(6); PG8_BAR;
    }
    for (;;) {
        const bool has_next = S.next(ui + 1, nxt);
        const char* nA = has_next ? (const char*)g.A + (size_t)nxt.pm * tstep : cA; const char* nB = has_next ? (const char*)g.Bt + (size_t)nxt.pn * tstep : cB;
        for (int t = 0; t < nt; t += 2) {
            const bool last = (t == nt - 2);
            const char* a1 = cA + (size_t)(t + 1) * kstep;
            const char* a2 = last ? nA : cA + (size_t)(t + 2) * kstep; const char* b2 = last ? nB : cB + (size_t)(t + 2) * kstep;
            const char* a3 = a2 + kstep; const char* b3 = b2 + kstep;
            if (last && has_next) S.a_ready(nxt);
            if constexpr (SP2) {
            PG8_LDB(B0, 0, 0); PG8_LDB(B1, 0, 1); PG8_SCHED; PG8_LDA(At, 0, 0); PG8_STAGE(PG8_SA(1, 1), a1 + hstep, voffA);
            PG8_WAIT_V(8); PG8_WAIT_L(0); PG8_BAR; PG8_MMA(0, 0, At, B0); PG8_MMA(0, 1, At, B1); PG8_BAR; PG8_SCHED;
            PG8_LDA(At, 0, 1); PG8_STAGE(PG8_SB(0, 0), b2, voffB); PG8_STAGE(PG8_SB(0, 1), b2 + hstep, voffB); PG8_STAGE(PG8_SA(0, 0), a2, voffA);
            PG8_WAIT_V(8); PG8_WAIT_L(0); PG8_BAR; PG8_MMA(1, 0, At, B0); PG8_MMA(1, 1, At, B1); PG8_BAR; PG8_SCHED;
            PG8_LDB(B0, 1, 0); PG8_LDB(B1, 1, 1); PG8_SCHED; PG8_LDA(At, 1, 0); PG8_STAGE(PG8_SA(0, 1), a2 + hstep, voffA);
            PG8_WAIT_V(8); PG8_WAIT_L(0); PG8_BAR; PG8_MMA(0, 0, At, B0); PG8_MMA(0, 1, At, B1); PG8_BAR; PG8_SCHED;
            PG8_LDA(At, 1, 1); PG8_STAGE(PG8_SB(1, 0), b3, voffB); PG8_STAGE(PG8_SB(1, 1), b3 + hstep, voffB); PG8_STAGE(PG8_SA(1, 0), a3, voffA);
            PG8_WAIT_V(8); PG8_WAIT_L(0); PG8_BAR; PG8_MMA(1, 0, At, B0); PG8_MMA(1, 1, At, B1); PG8_BAR; PG8_SCHED;
            } else {
            PG8_LDB(B0, 0, 0); PG8_SCHED; PG8_LDA(At, 0, 0); PG8_STAGE(PG8_SA(1, 1), a1 + hstep, voffA);
            PG8_WAIT_L(8); PG8_BAR; PG8_WAIT_L(0); PG8_MMA(0, 0, At, B0); PG8_BAR; PG8_SCHED;
            PG8_LDB(B1, 0, 1); PG8_STAGE(PG8_SB(0, 0), b2, voffB);
            PG8_BAR; PG8_WAIT_L(0); PG8_MMA(0, 1, At, B1); PG8_BAR;
            PG8_LDA(At, 0, 1); PG8_STAGE(PG8_SA(0, 0), a2, voffA);
            PG8_BAR; PG8_WAIT_L(0); PG8_MMA(1, 0, At, B0); PG8_BAR; PG8_SCHED;
            PG8_STAGE(PG8_SB(0, 1), b2 + hstep, voffB);
            PG8_WAIT_V(6); PG8_BAR; PG8_MMA(1, 1, At, B1); PG8_BAR;
            PG8_LDB(B0, 1, 0); PG8_SCHED; PG8_LDA(At, 1, 0); PG8_STAGE(PG8_SA(0, 1), a2 + hstep, voffA);
            PG8_WAIT_L(8); PG8_BAR; PG8_WAIT_L(0); PG8_MMA(0, 0, At, B0); PG8_BAR; PG8_SCHED;
            PG8_LDB(B1, 1, 1); PG8_STAGE(PG8_SB(1, 0), b3, voffB);
            PG8_BAR; PG8_WAIT_L(0); PG8_MMA(0, 1, At, B1); PG8_BAR;
            PG8_LDA(At, 1, 1); PG8_STAGE(PG8_SA(1, 0), a3, voffA);
            PG8_BAR; PG8_WAIT_L(0); PG8_MMA(1, 0, At, B0); PG8_BAR; PG8_SCHED;
            PG8_STAGE(PG8_SB(1, 1), b3 + hstep, voffB);
            PG8_WAIT_V(6); PG8_BAR; PG8_MMA(1, 1, At, B1); PG8_BAR;
            }
        }
        if constexpr (ALIGN_EPI) { if (wr == 0) PG8_BAR; }
        if constexpr (!Epi::AFTER_DRAIN) { E(acc, cur, wr, wc, fr, fq); S.done(cur); }
        if (!has_next) break;
#pragma unroll
        for (int a = 0; a < 2; ++a)
#pragma unroll
            for (int b = 0; b < 2; ++b)
#pragma unroll
                for (int m = 0; m < 4; ++m)
#pragma unroll
                    for (int n = 0; n < 2; ++n) acc[a][b][m][n] = (f32x4){0.f, 0.f, 0.f, 0.f};
        cur = nxt; cA = nA; cB = nB; ++ui;
        if constexpr (ALIGN_EPI) { if (wr == 1) PG8_BAR; }
    }
    PG8_WAIT_V(0);
    if constexpr (!ALIGN_EPI) { if (wr == 0) PG8_BAR; }
    PG8_BAR;
    if constexpr (Epi::AFTER_DRAIN) { E.fused(acc, cur, wr, wc, fr, fq, lds, wid, lane); S.done(cur); }
#undef PG8_SA
#undef PG8_SB
#undef PG8_STAGE
#undef PG8_LDA
#undef PG8_LDB
#undef PG8_MMA
#undef PG8_WAIT_V
#undef PG8_WAIT_L
#undef PG8_BAR
#undef PG8_SCHED
}
}

#ifndef PG8_SP2
#define PG8_SP2 true
#endif
#ifndef PG8_ALIGN
#define PG8_ALIGN true
#endif
#include <hip/hip_bf16.h>
#include <cmath>
namespace attn_body {
using bf16=__hip_bfloat16;
using bf16x8=__attribute__((ext_vector_type(8)))short;
using s16x4=__attribute__((ext_vector_type(4)))short;
using f32x16=__attribute__((ext_vector_type(16)))float;
using u32x4=__attribute__((ext_vector_type(4)))unsigned;
constexpr int BATCH=4,SEQ=4096,D=64,DM=512;
constexpr int NW=8,QBLK=32,QB=QBLK*NW,KVBLK=64,NQB=SEQ/QB;
constexpr int ATTN_PITCH=DM, ATTN_UNIT_ROWS=QB;
__device__ __forceinline__ int crow(int r,int hi){return (r&3)+8*(r>>2)+4*hi;}
#define SBAR() __builtin_amdgcn_sched_barrier(0)
__device__ __forceinline__ void cmask(f32x16&p0,f32x16&p1,int jb,int qrel,int hi){
  const float NEG=-INFINITY; int kb=64*jb+4*hi;
  #pragma unroll
  for(int r=0;r<16;++r){int kv=kb+(r&3)+8*(r>>2); if(kv>qrel)p0[r]=NEG; if(kv+32>qrel)p1[r]=NEG;}
}

constexpr int NSLOT=3, SLOTB=8192;
constexpr int LDS_K=0, LDS_V=NSLOT*SLOTB, LDS_WS=2*NSLOT*SLOTB, LDS_OST=LDS_WS+NW*64*4, LDS_BYTES=LDS_OST+NW*4096;
constexpr float C2=0.125f*1.4426950408889634f;
__device__ __forceinline__ void glds16(const void*gsrc,unsigned lds_dst){unsigned keep;
  asm volatile("s_mov_b32 %0, m0\n\ts_mov_b32 m0, %2\n\ts_nop 0\n\tglobal_load_lds_dwordx4 %1, off\n\ts_mov_b32 m0, %0":"=&s"(keep):"v"(gsrc),"s"(lds_dst):"memory");}
__device__ __forceinline__ float max3f(float a,float b,float c){float r;asm("v_max3_f32 %0, %1, %2, %3":"=v"(r):"v"(a),"v"(b),"v"(c));return r;}
__device__ __forceinline__ float max2f(float a,float b){float r;asm("v_max_f32_e32 %0, %1, %2":"=v"(r):"v"(a),"v"(b));return r;}
__device__ __forceinline__ float fadd_s(float a,float b){float r;asm("v_add_f32_e32 %0, %1, %2":"=v"(r):"v"(a),"v"(b));return r;}
__device__ __forceinline__ float fsub_s(float a,float b){float r;asm("v_sub_f32_e32 %0, %1, %2":"=v"(r):"v"(a),"v"(b));return r;}
typedef float f32x2_t __attribute__((ext_vector_type(2))); typedef __bf16 bf16x2_t __attribute__((ext_vector_type(2)));
__device__ __forceinline__ unsigned cvtpk_s(float lo,float hi){f32x2_t v={lo,hi};bf16x2_t b=__builtin_convertvector(v,bf16x2_t);return __builtin_bit_cast(unsigned,b);}
#define WAIT_BAR(N) asm volatile("s_waitcnt vmcnt(" #N ") lgkmcnt(0)\n\ts_barrier":::"memory")

__device__ __forceinline__ void qkt(f32x16&p0,f32x16&p1,const char*Kslot,const bf16x8*qr,const f32x16&negm,int r32,int hi){
  const char*kb=Kslot+hi*1024+r32*16;
  #pragma unroll
  for(int d0=0;d0<4;++d0){
    const bf16x8 b0=*reinterpret_cast<const bf16x8*>(kb+d0*2048);
    const bf16x8 b1=*reinterpret_cast<const bf16x8*>(kb+d0*2048+512);
    if(d0==0){p0=__builtin_amdgcn_mfma_f32_32x32x16_bf16(b0,qr[0],negm,0,0,0);p1=__builtin_amdgcn_mfma_f32_32x32x16_bf16(b1,qr[0],negm,0,0,0);}
    else{p0=__builtin_amdgcn_mfma_f32_32x32x16_bf16(b0,qr[d0],p0,0,0,0);p1=__builtin_amdgcn_mfma_f32_32x32x16_bf16(b1,qr[d0],p1,0,0,0);}}
}
typedef __attribute__((address_space(3))) const char* lds_cptr;
typedef short v4i16_t __attribute__((ext_vector_type(4)));
__device__ __forceinline__ void kload8(bf16x8*kf,lds_cptr kp){
  kf[0]=*(const __attribute__((address_space(3))) bf16x8*)(kp);      kf[1]=*(const __attribute__((address_space(3))) bf16x8*)(kp+512);
  kf[2]=*(const __attribute__((address_space(3))) bf16x8*)(kp+2048); kf[3]=*(const __attribute__((address_space(3))) bf16x8*)(kp+2560);
  kf[4]=*(const __attribute__((address_space(3))) bf16x8*)(kp+4096); kf[5]=*(const __attribute__((address_space(3))) bf16x8*)(kp+4608);
  kf[6]=*(const __attribute__((address_space(3))) bf16x8*)(kp+6144); kf[7]=*(const __attribute__((address_space(3))) bf16x8*)(kp+6656);
}
__device__ __forceinline__ void kload2(bf16x8*kf,lds_cptr kp,int j){ kf[2*j]=*(const __attribute__((address_space(3))) bf16x8*)(kp+j*2048); kf[2*j+1]=*(const __attribute__((address_space(3))) bf16x8*)(kp+j*2048+512); }
__device__ __forceinline__ s16x4 vtr(lds_cptr p){ return __builtin_bit_cast(s16x4,__builtin_amdgcn_ds_read_tr16_b64_v4i16((__attribute__((address_space(3))) v4i16_t*)p)); }
__device__ __forceinline__ float rowmax(const f32x16&p0,const f32x16&p1){
  float a=max3f(p0[0],p0[1],p1[0]),b=max3f(p0[2],p0[3],p1[1]);a=max3f(a,p1[2],p1[3]);
  #pragma unroll
  for(int r=4;r<16;r+=4){a=max3f(a,p0[r],p0[r+1]);b=max3f(b,p0[r+2],p0[r+3]);a=max3f(a,p1[r],p1[r+1]);b=max3f(b,p1[r+2],p1[r+3]);}
  const float m=max2f(a,b);
  auto rr=__builtin_amdgcn_permlane32_swap(__float_as_uint(m),__float_as_uint(m),false,false);
  return max2f(__uint_as_float(rr[0]),__uint_as_float(rr[1]));
}
__device__ __forceinline__ void pv(f32x16*o,int vb,bf16x8 pa0,bf16x8 pa1,bf16x8 pa2,bf16x8 pa3){
  #pragma unroll
  for(int d0=0;d0<2;++d0){s16x4 lo[4],hi[4];
    #pragma unroll
    for(int ks=0;ks<4;++ks){
      asm volatile("ds_read_b64_tr_b16 %0,%1 offset:%c2":"=&v"(lo[ks]):"v"(vb),"i"(d0*4096+ks*1024):"memory");
      asm volatile("ds_read_b64_tr_b16 %0,%1 offset:%c2":"=&v"(hi[ks]):"v"(vb),"i"(d0*4096+ks*1024+512):"memory");}
    asm volatile("s_waitcnt lgkmcnt(0)":::"memory");SBAR();
    #define PK(k) (bf16x8){lo[k][0],lo[k][1],lo[k][2],lo[k][3],hi[k][0],hi[k][1],hi[k][2],hi[k][3]}
    o[d0]=__builtin_amdgcn_mfma_f32_32x32x16_bf16(pa0,PK(0),o[d0],0,0,0);
    o[d0]=__builtin_amdgcn_mfma_f32_32x32x16_bf16(pa1,PK(1),o[d0],0,0,0);
    o[d0]=__builtin_amdgcn_mfma_f32_32x32x16_bf16(pa2,PK(2),o[d0],0,0,0);
    o[d0]=__builtin_amdgcn_mfma_f32_32x32x16_bf16(pa3,PK(3),o[d0],0,0,0);
    #undef PK
  }
}

#ifndef ATTN_STORE16
#define ATTN_STORE16(p,v) (*(u32x4*)(p)=(v))
#endif
template<int THRL> __device__ __forceinline__ void attn_unit(int b,int qcol,int vcol,int ocol,int qb,const bf16*Q,const bf16*__restrict__ K,const bf16*__restrict__ V,bf16*O,char*shm){
  int tid_=threadIdx.x; asm volatile("":"+v"(tid_)); const int tid=tid_,lane=tid&63,r32=lane&31,hi=lane>>5; const int wid=__builtin_amdgcn_readfirstlane(tid>>6);
  const long rowbase=(long)b*SEQ; const int q0=qb*QB;
  const bf16*Qw=Q+(rowbase+q0+wid*QBLK)*DM+qcol;
  const bf16*Kh=K+rowbase*DM+qcol,*Vh=V+rowbase*DM+vcol;
  const unsigned lds0=(unsigned)(uintptr_t)shm;
  float*wsf=(float*)(shm+LDS_WS)+wid*64;
  const bf16*ksrc=Kh+(long)lane*DM+wid*8;
  const bf16*vsrc=Vh+(long)(16*(wid&3)+(lane>>2))*DM+(wid>>2)*32+(lane&3)*8;
  const unsigned kdst=lds0+LDS_K+wid*1024, vdst=lds0+LDS_V+wid*1024;
  #define DMA_K(t,slot) glds16(ksrc+(long)(t)*KVBLK*DM,(unsigned)__builtin_amdgcn_readfirstlane(kdst+(slot)))
  #define DMA_V(t,slot) glds16(vsrc+(long)(t)*KVBLK*DM,(unsigned)__builtin_amdgcn_readfirstlane(vdst+(slot)))
  const int vb0=(int)(lds0+LDS_V)+((lane>>4)&1)*32+(lane&3)*8+(4*hi+((lane&15)>>2))*64;
  const char*Kbase=shm+LDS_K; bf16x8 kf[8];
  const lds_cptr shm3=(lds_cptr)shm; const lds_cptr kp0=shm3+LDS_K+hi*1024+r32*16; const lds_cptr vp0=shm3+LDS_V+((lane>>4)&1)*32+(lane&3)*8+(4*hi+((lane&15)>>2))*64;
  const int NT=(q0+QB)/KVBLK;
  DMA_K(0,0);DMA_V(0,0);DMA_K(1,SLOTB);
  bf16x8 qr[4];
  #pragma unroll
  for(int d0=0;d0<4;++d0)qr[d0]=*reinterpret_cast<const bf16x8*>(&Qw[(long)r32*DM+d0*16+hi*8]);
  float mhat=0.f,l_reg=0.f;f32x16 o[2];o[0]=f32x16{};o[1]=f32x16{};f32x16 negm=f32x16{};asm volatile("":"+v"(negm));
  const int qrel=wid*QBLK+r32;
  #define CMASK(P0,P1,t) do{int jb_=(t)-(NT-4); if(jb_>=0)cmask(P0,P1,jb_,qrel,hi);}while(0)
  bool resc=false;
  #define START(P0,P1) do{ const float rm=rowmax(P0,P1); resc=false; \
    { const float dl=rm; mhat=fadd_s(mhat,dl); \
      _Pragma("unroll") for(int r=0;r<16;++r){P0[r]=fsub_s(P0[r],dl);P1[r]=fsub_s(P1[r],dl);} \
      _Pragma("unroll") for(int r=0;r<16;++r)negm[r]=-mhat; asm volatile("":"+v"(negm)); } \
    _Pragma("unroll") for(int r=0;r<16;++r)P0[r]=__builtin_amdgcn_exp2f(P0[r]); }while(0)
  #define RESC() do{ if(resc){ asm volatile("s_waitcnt lgkmcnt(0)":::"memory"); \
      _Pragma("unroll") for(int d_=0;d_<2;++d_) _Pragma("unroll") for(int r=0;r<16;++r)o[d_][r]*=wsf[crow(r,hi)]; } }while(0)
  f32x16 pA0,pA1,pB0,pB1;
  int sl_prev=0,sl_cur=0,sl_next=SLOTB;
  #define ROT() do{sl_prev=sl_cur;sl_cur=sl_next;sl_next=(sl_next==(NSLOT-1)*SLOTB)?0:sl_next+SLOTB;}while(0)
  DMA_K(2,2*SLOTB);
  WAIT_BAR(3);
  qkt(pA0,pA1,Kbase,qr,negm,r32,hi);asm volatile("s_nop 15\n\ts_nop 7":"+v"(pA0),"+v"(pA1));CMASK(pA0,pA1,0);
  START(pA0,pA1);
  _Pragma("unroll") for(int r=0;r<16;++r)pA1[r]=__builtin_amdgcn_exp2f(pA1[r]);
  WAIT_BAR(0);
  DMA_K(3,0);DMA_V(1,SLOTB);
  ROT();
  kload8(kf,kp0+sl_cur);
  WAIT_BAR(2);
  s16x4 vlo[8],vhi[8]; u32x4 pw0,pw1,pw2,pw3;
  #define PKW(P,B) cvtpk_s(P[B],P[B+1])
  #define PAF(k) __builtin_bit_cast(bf16x8,pw##k)
  #define VFR(i) (bf16x8){vlo[i][0],vlo[i][1],vlo[i][2],vlo[i][3],vhi[i][0],vhi[i][1],vhi[i][2],vhi[i][3]}
  #define PIN(x) asm volatile("":"+v"(x))
  #define MX3(a,b,c) __builtin_fmaxf(__builtin_fmaxf((a),(b)),(c))
  #define GAPA(MF,A0,A1,A2,A3,W0,W1,PW) do{ MF; sacc+=A0; sacc+=A1; sacc+=A2; sacc+=A3; PIN(sacc); W0; W1; PIN(PW); SBAR(); }while(0)
  #define EX(v) __builtin_amdgcn_exp2f(v)
  #define GAPB(MF,X,B) do{ MF; X[B]=EX(X[B]); X[B+1]=EX(X[B+1]); X[B+2]=EX(X[B+2]); X[B+3]=EX(X[B+3]); PIN(X); SBAR(); }while(0)
  #define VRD(i) do{ vlo[i]=vtr(vp_+(((i)>>2)*4096+((i)&3)*1024)); vhi[i]=vtr(vp_+(((i)>>2)*4096+((i)&3)*1024+512)); }while(0)
  #define KRD(G,j) do{ if(G){ kload2(kf,kp0+sl_next,j); SBAR(); } }while(0)
  #define STEP(C0,C1,P0,P1,t,GK,GV,GL) do{ SBAR(); \
    const lds_cptr vp_=vp0+sl_prev; \
    VRD(0); SBAR(); float sacc=(P0[0]+P0[1]); \
    GAPA(C0=__builtin_amdgcn_mfma_f32_32x32x16_bf16(kf[0],qr[0],negm,0,0,0), P0[2],P0[3],P0[4],P0[5],     pw0[0]=PKW(P0,0), pw0[1]=PKW(P0,2), pw0); \
    VRD(4); SBAR(); GAPA(C1=__builtin_amdgcn_mfma_f32_32x32x16_bf16(kf[1],qr[0],negm,0,0,0), P0[6],P0[7],P0[8],P0[9],     pw0[2]=PKW(P0,4), pw0[3]=PKW(P0,6), pw0); \
    VRD(1); SBAR(); GAPA(C0=__builtin_amdgcn_mfma_f32_32x32x16_bf16(kf[2],qr[1],C0,0,0,0),   P0[10],P0[11],P0[12],P0[13], pw1[0]=PKW(P0,8), pw1[1]=PKW(P0,10), pw1); \
    VRD(5); SBAR(); GAPA(C1=__builtin_amdgcn_mfma_f32_32x32x16_bf16(kf[3],qr[1],C1,0,0,0),   P0[14],P0[15],P1[0],P1[1],   pw1[2]=PKW(P0,12),pw1[3]=PKW(P0,14), pw1); \
    VRD(2); SBAR(); GAPA(C0=__builtin_amdgcn_mfma_f32_32x32x16_bf16(kf[4],qr[2],C0,0,0,0),   P1[2],P1[3],P1[4],P1[5],     pw2[0]=PKW(P1,0), pw2[1]=PKW(P1,2), pw2); \
    VRD(6); SBAR(); GAPA(C1=__builtin_amdgcn_mfma_f32_32x32x16_bf16(kf[5],qr[2],C1,0,0,0),   P1[6],P1[7],P1[8],P1[9],     pw2[2]=PKW(P1,4), pw2[3]=PKW(P1,6), pw2); \
    VRD(3); SBAR(); GAPA(C0=__builtin_amdgcn_mfma_f32_32x32x16_bf16(kf[6],qr[3],C0,0,0,0),   P1[10],P1[11],P1[12],P1[13], pw3[0]=PKW(P1,8), pw3[1]=PKW(P1,10), pw3); \
    VRD(7); SBAR(); GAPA(C1=__builtin_amdgcn_mfma_f32_32x32x16_bf16(kf[7],qr[3],C1,0,0,0),   P1[14],P1[15],0.f,0.f,       pw3[2]=PKW(P1,12),pw3[3]=PKW(P1,14), pw3); \
    l_reg+=sacc; \
    if(GK){DMA_K((t)+3,sl_cur);} if(GV){DMA_V((t)+1,sl_next);} \
    CMASK(C0,C1,t); \
    { float a=MX3(C0[0],C0[1],C1[0]),b=MX3(C0[2],C0[3],C1[1]); a=MX3(a,C1[2],C1[3]); \
      _Pragma("unroll") for(int r=4;r<16;r+=4){a=MX3(a,C0[r],C0[r+1]);b=MX3(b,C0[r+2],C0[r+3]);a=MX3(a,C1[r],C1[r+1]);b=MX3(b,C1[r+2],C1[r+3]);} \
      float rm=__builtin_fmaxf(a,b); { auto rr=__builtin_amdgcn_permlane32_swap(__float_as_uint(rm),__float_as_uint(rm),false,false); rm=__builtin_fmaxf(__uint_as_float(rr[0]),__uint_as_float(rr[1])); } \
      resc=false; \
      if(__builtin_expect(__any(rm>(float)THRL),0)){ const float dl=__builtin_fmaxf(rm,0.f); mhat+=dl; \
        _Pragma("unroll") for(int r=0;r<16;++r){C0[r]-=dl;C1[r]-=dl;} \
        _Pragma("unroll") for(int r=0;r<16;++r)negm[r]=-mhat; asm volatile("":"+v"(negm)); \
        const float f=__builtin_amdgcn_exp2f(-dl); l_reg*=f; if(hi==0)wsf[r32]=f; resc=true; } } \
    SBAR(); \
    GAPB(o[0]=__builtin_amdgcn_mfma_f32_32x32x16_bf16(PAF(0),VFR(0),o[0],0,0,0), C0,0); \
    GAPB(o[1]=__builtin_amdgcn_mfma_f32_32x32x16_bf16(PAF(0),VFR(4),o[1],0,0,0), C0,4); \
    KRD(GL,0); GAPB(o[0]=__builtin_amdgcn_mfma_f32_32x32x16_bf16(PAF(1),VFR(1),o[0],0,0,0), C0,8); \
    KRD(GL,1); GAPB(o[1]=__builtin_amdgcn_mfma_f32_32x32x16_bf16(PAF(1),VFR(5),o[1],0,0,0), C0,12); \
    KRD(GL,2); GAPB(o[0]=__builtin_amdgcn_mfma_f32_32x32x16_bf16(PAF(2),VFR(2),o[0],0,0,0), C1,0); \
    KRD(GL,3); GAPB(o[1]=__builtin_amdgcn_mfma_f32_32x32x16_bf16(PAF(2),VFR(6),o[1],0,0,0), C1,4); \
    GAPB(o[0]=__builtin_amdgcn_mfma_f32_32x32x16_bf16(PAF(3),VFR(3),o[0],0,0,0), C1,8); \
    GAPB(o[1]=__builtin_amdgcn_mfma_f32_32x32x16_bf16(PAF(3),VFR(7),o[1],0,0,0), C1,12); \
    }while(0)
  int t=1;
  #undef CMASK
  #define CMASK(P0,P1,t) do{}while(0)
  for(;t+5<NT;t+=2){
    STEP(pB0,pB1,pA0,pA1,t,true,true,true);     WAIT_BAR(2); RESC(); ROT();
    STEP(pA0,pA1,pB0,pB1,t+1,true,true,true);   WAIT_BAR(2); RESC(); ROT();
  }
  #undef CMASK
  #define CMASK(P0,P1,t) do{int jb_=(t)-(NT-4); if(jb_>=0)cmask(P0,P1,jb_,qrel,hi);}while(0)
  #define ENDW(tt) do{ if((tt)+3<NT){WAIT_BAR(2);} else if((tt)+2<NT){WAIT_BAR(1);} else {WAIT_BAR(0);} }while(0)
  for(;t+1<NT;t+=2){
    STEP(pB0,pB1,pA0,pA1,t,(t+3<NT),(t+1<NT),(t+1<NT));       ENDW(t);   RESC(); ROT();
    STEP(pA0,pA1,pB0,pB1,t+1,(t+4<NT),(t+2<NT),(t+2<NT));     ENDW(t+1); RESC(); ROT();
  }
  STEP(pB0,pB1,pA0,pA1,NT-1,false,false,false); RESC();
  { float sacc=pB0[0]+pB0[1]; _Pragma("unroll") for(int r=2;r<16;++r)sacc+=pB0[r]; _Pragma("unroll") for(int r=0;r<16;++r)sacc+=pB1[r]; l_reg+=sacc;
    pw0=(u32x4){PKW(pB0,0),PKW(pB0,2),PKW(pB0,4),PKW(pB0,6)};pw1=(u32x4){PKW(pB0,8),PKW(pB0,10),PKW(pB0,12),PKW(pB0,14)};pw2=(u32x4){PKW(pB1,0),PKW(pB1,2),PKW(pB1,4),PKW(pB1,6)};pw3=(u32x4){PKW(pB1,8),PKW(pB1,10),PKW(pB1,12),PKW(pB1,14)};
    SBAR(); pv(o,vb0+sl_cur,PAF(0),PAF(1),PAF(2),PAF(3)); }
  #undef PKW
  #undef PAF
  #undef VFR
  #undef PIN
  #undef MX3
  #undef GAPA
  #undef GAPB
  #undef EX
  #undef VRD
  #undef KRD
  #undef STEP
  #undef ENDW
  {auto rr=__builtin_amdgcn_permlane32_swap(__float_as_uint(l_reg),__float_as_uint(l_reg),false,false);l_reg=__uint_as_float(rr[0])+__uint_as_float(rr[1]);}
  if(hi==0)wsf[32+r32]=l_reg;asm volatile("s_waitcnt lgkmcnt(0)":::"memory");
  float rli[16];
  #pragma unroll
  for(int r=0;r<16;++r)rli[r]=__builtin_amdgcn_rcpf(wsf[32+crow(r,hi)]);
  bf16*Ow=O+(rowbase+q0+wid*QBLK)*DM+ocol;
  { bf16*stg=(bf16*)(shm+LDS_OST)+wid*2048;
    #pragma unroll
    for(int r=0;r<16;++r){const int orow=crow(r,hi);
      #pragma unroll
      for(int d0=0;d0<2;++d0)stg[orow*64+d0*32+r32]=__float2bfloat16(o[d0][r]*rli[r]);}
    asm volatile("s_waitcnt lgkmcnt(0)":::"memory");
    #pragma unroll
    for(int i=0;i<4;++i){const int row=i*8+(lane>>3),ch=lane&7; const u32x4 v=*(const u32x4*)(stg+row*64+ch*8); ATTN_STORE16(Ow+(long)row*DM+ch*8,v);} }
  asm volatile("s_waitcnt lgkmcnt(0)\n\ts_barrier":::"memory");
  #undef DMA_K
  #undef DMA_V
  #undef CMASK
  #undef START
  #undef RESC
  #undef ROT
}
constexpr int ATTN_LDS_BYTES=LDS_BYTES;
struct AttnTensors { const bf16* Q; const bf16* K; const bf16* V; bf16* O0; bf16* O1; };
struct AttnUnit { int bh; int qb; };
struct StaticOrder {
  int vcu;
  __device__ __forceinline__ explicit StaticOrder(int grid,int block):vcu((block%8)*(grid/8)+block/8){}
  __device__ __forceinline__ bool next(int i,AttnUnit&u)const{ if(i>=4)return false; const int s=vcu&3; u.bh=vcu>>2; u.qb=(i==0)?s:(i==1)?7-s:(i==2)?8+s:15-s; return true; }
  __device__ __forceinline__ void a_ready(const AttnUnit&)const{}
  __device__ __forceinline__ void done(const AttnUnit&)const{}
};
template<class Sched,int THRL=8> __device__ __forceinline__ void attn_phase(char*lds,const AttnTensors&T,const Sched&S){
  AttnUnit u;
  for(int i=0;S.next(i,u);++i){ S.a_ready(u);
    const int b=u.bh>>4, vh=u.bh&15, head=vh>>2, c=(vh>>1)&1, half=vh&1;
    const int qcol=(head*2+c)*64, vcol=head*128+half*64;
    attn_unit<THRL>(b,qcol,vcol,vcol,u.qb,T.Q,T.K,T.V,c?T.O1:T.O0,lds); S.done(u); }
}
#undef SBAR
#undef WAIT_BAR
}
#define GAS __attribute__((address_space(1)))
#define LAS __attribute__((address_space(3)))
typedef unsigned short bf16;
typedef unsigned v4u __attribute__((ext_vector_type(4)));
typedef float f32x4 __attribute__((ext_vector_type(4)));
typedef short bf16x8 __attribute__((ext_vector_type(8)));
typedef GAS unsigned gu32;
typedef GAS unsigned long long gu64;
#define RLX_AGENT __ATOMIC_RELAXED, __HIP_MEMORY_SCOPE_AGENT
#define LDS_WAIT() asm volatile("s_waitcnt lgkmcnt(0)" ::: "memory")
#define VM_WAIT() asm volatile("s_waitcnt vmcnt(0)" ::: "memory")
__device__ __forceinline__ unsigned long long rt() { return __builtin_amdgcn_s_memrealtime(); }
__device__ __forceinline__ unsigned f2bf(float f) { unsigned u = __builtin_bit_cast(unsigned, f); return (u + 0x7fffu + ((u >> 16) & 1u)) >> 16; }
__device__ __forceinline__ unsigned pk2(float lo, float hi) { return f2bf(lo) | (f2bf(hi) << 16); }

#define XB_TMO      128
#define XB_XCNT(j)  (256  + 64 * (j))
#define XB_XSUB(j)  (1280 + 64 * (j))
#define XB_XGEN(j)  (2304 + 64 * (j))
#define XB_TOP      3328
#define XB_TOPGEN   3392
#define XCD_BAR_WORDS 3456
#define XB_SPIN_CAP (1u << 18)

__device__ __forceinline__ unsigned xb_ld(unsigned* p)              { return __hip_atomic_load(p, __ATOMIC_RELAXED, __HIP_MEMORY_SCOPE_AGENT); }
__device__ __forceinline__ unsigned xb_add(unsigned* p, unsigned v) { return __hip_atomic_fetch_add(p, v, __ATOMIC_RELAXED, __HIP_MEMORY_SCOPE_AGENT); }
__device__ __forceinline__ unsigned xb_xcc_id() { return (unsigned)__builtin_amdgcn_s_getreg((3 << 11) | 20) & 0xFu; }
#define XB_SPIN(cond, bar) do { unsigned _sp = 0; while (cond) { __builtin_amdgcn_s_sleep(1); \
    if ((++_sp & 255u) == 0u) { if (xb_ld(&(bar)[XB_TMO])) break; if (_sp > XB_SPIN_CAP) { atomicAdd(&(bar)[XB_TMO], 1u); break; } } } } while (0)

struct XcdBarrier {
    unsigned* bar; unsigned x;
    volatile LAS unsigned* st;
};

__device__ __forceinline__ XcdBarrier xcd_barrier_post(unsigned* bar, volatile LAS unsigned* st) {
    XcdBarrier b; b.bar = bar; b.x = xb_xcc_id(); b.st = st;
    if (threadIdx.x == 0) (void)xb_add(&bar[XB_XCNT(b.x)], 1u);
    return b;
}
__device__ __forceinline__ void xcd_barrier_complete(unsigned* bar, unsigned x, unsigned& nloc, unsigned& nx) {
    const unsigned G = gridDim.x * gridDim.y * gridDim.z;
    unsigned sum, cnt, mine, sp = 0u;
    for (;;) {
        sum = 0u; cnt = 0u; mine = 0u;
#pragma unroll
        for (unsigned j = 0; j < 16; ++j) { const unsigned c = xb_ld(&bar[XB_XCNT(j)]); sum += c; cnt += (c > 0u) ? 1u : 0u; mine = (j == x) ? c : mine; }
        if (sum == G) break;
        __builtin_amdgcn_s_sleep(1);
        if ((++sp & 255u) == 0u) { if (xb_ld(&bar[XB_TMO])) break; if (sp > XB_SPIN_CAP) { atomicAdd(&bar[XB_TMO], 1u); break; } }
    }
    nloc = mine > 0u ? mine : 1u; nx = cnt > 0u ? cnt : 1u;
}

__device__ __forceinline__ void xcd_barrier(const XcdBarrier& b) {
    asm volatile("s_waitcnt vmcnt(0)" ::: "memory");
    __syncthreads();
    if (threadIdx.x == 0) {
        unsigned* bar = b.bar;
        __builtin_amdgcn_s_waitcnt(0);
        unsigned nloc = b.st[0], nx = b.st[1];
        if (nloc == 0u) { xcd_barrier_complete(bar, b.x, nloc, nx); b.st[0] = nloc; b.st[1] = nx; }
        const unsigned old = xb_add(&bar[XB_XSUB(b.x)], 1u);
        const unsigned gen = old / nloc;
        if (old + 1u == (gen + 1u) * nloc) {
            __builtin_amdgcn_fence(__ATOMIC_RELEASE, "agent");
            asm volatile("s_waitcnt vmcnt(0)" ::: "memory");
            const unsigned og = xb_add(&bar[XB_TOP], 1u);
            const unsigned tg = og / nx;
            if (og + 1u == (tg + 1u) * nx) xb_add(&bar[XB_TOPGEN], 1u);
            else XB_SPIN(xb_ld(&bar[XB_TOPGEN]) == tg, bar);
            __builtin_amdgcn_fence(__ATOMIC_ACQUIRE, "agent");
            xb_add(&bar[XB_XGEN(b.x)], 1u);
            asm volatile("s_waitcnt vmcnt(0)" ::: "memory");
        } else {
            XB_SPIN(xb_ld(&bar[XB_XGEN(b.x)]) == gen, bar);
            __builtin_amdgcn_fence(__ATOMIC_ACQUIRE, "agent");
            asm volatile("s_waitcnt vmcnt(0)" ::: "memory");
        }
    }
    __syncthreads();
}
__device__ __forceinline__ float wave_sum(float v) {
#pragma unroll
    for (int o = 1; o < 64; o <<= 1) v += __shfl_xor(v, o);
    return v;
}
__device__ __forceinline__ void p0_transpose_item(const float* W, int K, int N, bf16* WT, int row_off, LAS float* scr, int item, int lane) {
    const int nblk = N / 32, kb = item / nblk, nb = item % nblk, k0 = 64 * kb, n0 = 32 * nb;
#pragma unroll 8
    for (int i = 0; i < 32; ++i) { const int kk = 2 * i + (lane >> 5); scr[kk * 33 + (lane & 31)] = W[(size_t)(k0 + kk) * N + n0 + (lane & 31)]; }
    LDS_WAIT(); asm volatile("" ::: "memory");
    const int c = lane & 7;
#pragma unroll
    for (int j = 0; j < 4; ++j) { const int n = (lane >> 3) + 8 * j; const LAS float* s = scr + (8 * c) * 33 + n;
        v4u o; o.x = pk2(s[0 * 33], s[1 * 33]); o.y = pk2(s[2 * 33], s[3 * 33]); o.z = pk2(s[4 * 33], s[5 * 33]); o.w = pk2(s[6 * 33], s[7 * 33]);
        *(GAS v4u*)(WT + (size_t)(row_off + n0 + n) * K + k0 + 8 * c) = o; }
    LDS_WAIT(); asm volatile("" ::: "memory");
}
namespace cg = cooperative_groups;
constexpr int NWAVES = 8;
constexpr int BATCH = 4, SEQ = 4096, D = 1024, T = BATCH * SEQ, DEPTH = 2, INCOLS = 5120, NEXP = 16384;
constexpr float NORM_EPS = 1e-6f;
constexpr size_t MiB = 1u << 20;
constexpr size_t WS_CTL = 0, CTL_ZERO_BYTES = 1 * MiB;
constexpr size_t WS_MOD = 1 * MiB;
constexpr size_t WS_ROPE = WS_MOD + 256 * 1024;
constexpr size_t WS_SUBK = 2 * MiB;
constexpr size_t WS_WIN = 4 * MiB;
constexpr size_t WS_WSB = 24 * MiB;
constexpr size_t WS_WDF = 26 * MiB;
constexpr size_t WS_WOUT = 28 * MiB;
constexpr size_t WS_WQ = 32 * MiB;
constexpr size_t WS_UB = 40 * MiB, WS_VB = 72 * MiB;
constexpr size_t WS_H = 104 * MiB;
constexpr size_t WS_SBQ = 136 * MiB, WS_SBK = 152 * MiB, WS_SBV = 168 * MiB, WS_SBVT = 184 * MiB, WS_DQ = 200 * MiB, WS_DK = 216 * MiB, WS_DV = 232 * MiB;
constexpr size_t WS_GSB = 248 * MiB, WS_GDF = 280 * MiB;
constexpr size_t WS_YSB = 312 * MiB, WS_YDF = 328 * MiB;
constexpr size_t WS_M1 = WS_SBQ, WS_MRG = WS_DQ;
constexpr size_t WS_QP = WS_GSB;
constexpr size_t WS_EIDX = WS_SBV, WS_EGATE = WS_SBV + 8 * MiB;
constexpr size_t WS_XA = 344 * MiB, WS_XB = 408 * MiB, WS_END = 472 * MiB;
constexpr int CW_BAR = 4096;
static_assert(WS_ROPE == pg8::EPI_WS_ROPE && WS_SBQ == pg8::EPI_WS_SBQ && WS_SBK == pg8::EPI_WS_SBK && WS_SBV == pg8::EPI_WS_SBV && WS_SBVT == pg8::EPI_WS_SBVT && WS_DQ == pg8::EPI_WS_DQ && WS_DK == pg8::EPI_WS_DK && WS_DV == pg8::EPI_WS_DV && WS_GSB == pg8::EPI_WS_GSB && WS_GDF == pg8::EPI_WS_GDF, "epilogue offsets");
constexpr int RING_OFF = 0, RING_BYTES = 131072;
constexpr int LDSCTL_OFF = RING_BYTES, MISC_OFF = LDSCTL_OFF + 320;
constexpr int LDS_BYTES = 147456;

struct Frame { LAS unsigned char* lds; volatile LAS unsigned* MISC; int tid, lane, wave, vcu, G; };
struct Args { const float* in[18]; float* out; unsigned char* ws; };

__device__ __forceinline__ unsigned short f2bf_s(float f) { return (unsigned short)f2bf(f); }
__device__ __forceinline__ float bf_lo(unsigned w) { return __uint_as_float(w << 16); }
__device__ __forceinline__ float bf_hi(unsigned w) { return __uint_as_float(w & 0xffff0000u); }
typedef __bf16 bf2_t __attribute__((ext_vector_type(2)));
__device__ __forceinline__ float dot2bf(unsigned a, unsigned b, float c) { return __builtin_amdgcn_fdot2_f32_bf16(__builtin_bit_cast(bf2_t, a), __builtin_bit_cast(bf2_t, b), c, false); }

__device__ __forceinline__ void p0_prologue(Frame& F, const Args& A) {
    unsigned char* ws = A.ws;
    LAS float* scr = (LAS float*)(F.lds + RING_OFF + F.wave * 16384);
    const int gw = F.vcu * NWAVES + F.wave, NGW = F.G * NWAVES;
    constexpr int I_IN = (D / 64) * (INCOLS / 32), I_B = (512 / 64) * (D / 32), I_O = (D / 64) * (D / 32), I_Q = (D / 64) * (2048 / 32), IL = I_IN + 2 * I_B + I_O + I_Q;
    for (int it = gw; it < DEPTH * IL; it += NGW) {
        const int l = it / IL; int r = it % IL;
        if (r < I_IN) { p0_transpose_item(A.in[6] + (size_t)l * D * INCOLS, D, INCOLS, (bf16*)(ws + WS_WIN) + (size_t)l * INCOLS * D, 0, scr, r, F.lane); continue; } r -= I_IN;
        if (r < I_B) { p0_transpose_item(A.in[10] + (size_t)l * 512 * D, 512, D, (bf16*)(ws + WS_WSB) + (size_t)l * D * 512, 0, scr, r, F.lane); continue; } r -= I_B;
        if (r < I_B) { p0_transpose_item(A.in[11] + (size_t)l * 512 * D, 512, D, (bf16*)(ws + WS_WDF) + (size_t)l * D * 512, 0, scr, r, F.lane); continue; } r -= I_B;
        if (r < I_O) { p0_transpose_item(A.in[12] + (size_t)l * D * D, D, D, (bf16*)(ws + WS_WOUT) + (size_t)l * D * D, 0, scr, r, F.lane); continue; } r -= I_O;
        p0_transpose_item(A.in[13] + (size_t)l * D * 2048, D, 2048, (bf16*)(ws + WS_WQ) + (size_t)l * 2048 * D, 0, scr, r, F.lane);
    }
    { const int gt = F.vcu * 512 + F.tid, NT = F.G * 512; const float* s = A.in[14]; bf16* o = (bf16*)(ws + WS_SUBK);
      for (int i = gt; i < (DEPTH * 8 * 2 * 128 * 128) / 8; i += NT) { const f32x4 a = *(const f32x4*)(s + (size_t)i * 8), b = *(const f32x4*)(s + (size_t)i * 8 + 4);
          v4u w; w.x = pk2(a.x, a.y); w.y = pk2(a.z, a.w); w.z = pk2(b.x, b.y); w.w = pk2(b.z, b.w); *(v4u*)(o + (size_t)i * 8) = w; } }
    { const int gt = F.vcu * 512 + F.tid, NT = F.G * 512; float* rc = (float*)(ws + WS_ROPE); float* rs = rc + 4096 * 8;
      for (int i = gt; i < 4096 * 8; i += NT) { const int pos = i >> 3, f = i & 7; const float inv = 1.0f / powf(500000.0f, (float)(2 * f) / 16.0f); const float ang = (float)pos * inv; rc[i] = cosf(ang); rs[i] = sinf(ang); } }
    __syncthreads();
    { LAS float* sc = (LAS float*)(F.lds);
      LAS float* red = (LAS float*)(F.lds + 16384);
      for (int i = F.tid; i < 4 * 1024; i += 512) { const float v = A.in[1][i]; sc[i] = v / (1.0f + expf(-v)); }
      __syncthreads();
      for (int j = F.vcu; j < 256; j += F.G) {
          const int cgi = F.tid % 12, ks = F.tid / 12;
          const int g = j * 12 + cgi; const int l = g / 1536, n0 = (g % 1536) * 4;
          f32x4 acc[4]; acc[0] = acc[1] = acc[2] = acc[3] = (f32x4){0.f, 0.f, 0.f, 0.f};
          if (ks < 42) { const float* w = A.in[4] + (size_t)l * D * 6144 + n0;
              for (int k = ks; k < 1024; k += 42) { const f32x4 wv = *(const f32x4*)(w + (size_t)k * 6144);
#pragma unroll
                  for (int b = 0; b < 4; ++b) acc[b] = acc[b] + wv * sc[b * 1024 + k]; }
#pragma unroll
              for (int b = 0; b < 4; ++b)
#pragma unroll
                  for (int e = 0; e < 4; ++e) red[((ks * 12 + cgi) * 4 + b) * 4 + e] = acc[b][e]; }
          __syncthreads();
          if (F.tid < 192) { const int cg2 = F.tid / 16, b = (F.tid / 4) & 3, e = F.tid & 3; float s = 0.f;
              for (int k2 = 0; k2 < 42; ++k2) s += red[((k2 * 12 + cg2) * 4 + b) * 4 + e];
              const int g2 = j * 12 + cg2; const int l2 = g2 / 1536, n2 = (g2 % 1536) * 4 + e;
              ((float*)(ws + WS_MOD))[((size_t)l2 * 4 + b) * 6144 + n2] = s + A.in[5][(size_t)l2 * 6144 + n2]; }
          __syncthreads();
      } }
}
__device__ __forceinline__ void cvt_table(Frame& F, const float* s, bf16* o, int n8) {
    const int gt = F.vcu * 512 + F.tid, NT = F.G * 512;
    for (int i = gt; i < n8; i += NT) { const f32x4 a = *(const f32x4*)(s + (size_t)i * 8), b = *(const f32x4*)(s + (size_t)i * 8 + 4);
        v4u w; w.x = pk2(a.x, a.y); w.y = pk2(a.z, a.w); w.z = pk2(b.x, b.y); w.w = pk2(b.z, b.w); *(v4u*)(o + (size_t)i * 8) = w; }
}
__device__ __forceinline__ void hnorm_phase(Frame& F, const float* x, const float* g, const float* shift, const float* scale  , bf16* H) {
    const int gw = F.vcu * NWAVES + F.wave, NGW = F.G * NWAVES;
    for (int m = gw; m < T; m += NGW) { const int b = m >> 12;
        const f32x4* xr = (const f32x4*)(x + (size_t)m * D) + F.lane; f32x4 v[4]; float s = 0.f;
#pragma unroll
        for (int j = 0; j < 4; ++j) { v[j] = xr[64 * j]; s += (v[j].x * v[j].x + v[j].y * v[j].y) + (v[j].z * v[j].z + v[j].w * v[j].w); }
        const float r = 1.0f / sqrtf(wave_sum(s) * (1.0f / D) + NORM_EPS);
        unsigned long long* o8 = (unsigned long long*)(H + (size_t)m * D) + F.lane;
#pragma unroll
        for (int j = 0; j < 4; ++j) { const int c = 4 * F.lane + 256 * j; const f32x4 gg = *(const f32x4*)(g + c), sh = *(const f32x4*)(shift + (size_t)b * 6144 + c), sc = *(const f32x4*)(scale + (size_t)b * 6144 + c);
            const f32x4 h = (v[j] * r) * gg * (sc + 1.0f) + sh;
            o8[64 * j] = (unsigned long long)pk2(h.x, h.y) | ((unsigned long long)pk2(h.z, h.w) << 32); }
    }
}
#ifndef SB_CUT
#define SB_CUT (-110.0f)
#endif
__device__ __forceinline__ void sb_scalar_phase(Frame& F, const bf16* SBQ, const bf16* SBK, const bf16* SBV, bf16* YSB) {
    for (int u = F.vcu; u < 256; u += F.G) {
        const int bh = u >> 3, chunk = u & 7, b = bh >> 3, h = bh & 7, t = chunk * 512 + F.tid;
        const size_t rowq = (size_t)(b * SEQ + t) * 512 + h * 64;
        float q[64], o[64];
#pragma unroll
        for (int i = 0; i < 8; ++i) { const v4u w = *(const v4u*)(SBQ + rowq + i * 8); q[8 * i] = bf_lo(w.x); q[8 * i + 1] = bf_hi(w.x); q[8 * i + 2] = bf_lo(w.y); q[8 * i + 3] = bf_hi(w.y); q[8 * i + 4] = bf_lo(w.z); q[8 * i + 5] = bf_hi(w.z); q[8 * i + 6] = bf_lo(w.w); q[8 * i + 7] = bf_hi(w.w); }
#pragma unroll
        for (int i = 0; i < 64; ++i) o[i] = 0.f;
        float c = 0.f;
        for (int it = 0;; ++it) { const int s = t - 1 - it; const bool act = (s >= 0) && (c > SB_CUT);
            if (!__any(act)) break;
            if (act) { const size_t rowk = (size_t)(b * SEQ + s) * 512 + h * 64; float z0 = 0.f, z1 = 0.f;
#pragma unroll
                for (int i = 0; i < 8; ++i) { const v4u w = *(const v4u*)(SBK + rowk + i * 8);
                    z0 += q[8 * i] * bf_lo(w.x) + q[8 * i + 2] * bf_lo(w.y) + q[8 * i + 4] * bf_lo(w.z) + q[8 * i + 6] * bf_lo(w.w);
                    z1 += q[8 * i + 1] * bf_hi(w.x) + q[8 * i + 3] * bf_hi(w.y) + q[8 * i + 5] * bf_hi(w.z) + q[8 * i + 7] * bf_hi(w.w); }
                const float z = z0 + z1;
                const float lf = -(fmaxf(z, 0.f) + log1pf(expf(-fabsf(z))));
                const float wgt = expf(z + lf + c); c += lf;
#pragma unroll
                for (int i = 0; i < 8; ++i) { const v4u w = *(const v4u*)(SBV + rowk + i * 8);
                    o[8 * i] += wgt * bf_lo(w.x); o[8 * i + 1] += wgt * bf_hi(w.x); o[8 * i + 2] += wgt * bf_lo(w.y); o[8 * i + 3] += wgt * bf_hi(w.y);
                    o[8 * i + 4] += wgt * bf_lo(w.z); o[8 * i + 5] += wgt * bf_hi(w.z); o[8 * i + 6] += wgt * bf_lo(w.w); o[8 * i + 7] += wgt * bf_hi(w.w); } } }
#pragma unroll
        for (int i = 0; i < 8; ++i) { v4u w; w.x = pk2(o[8 * i], o[8 * i + 1]); w.y = pk2(o[8 * i + 2], o[8 * i + 3]); w.z = pk2(o[8 * i + 4], o[8 * i + 5]); w.w = pk2(o[8 * i + 6], o[8 * i + 7]); *(v4u*)(YSB + rowq + i * 8) = w; }
    }
}
__device__ __forceinline__ void diffcombine_phase(Frame& F, const bf16* O0, const bf16* O1, const float* lamp  , const float* subg  , float lam_init, bf16* YDF) {
    const int gw = F.vcu * NWAVES + F.wave, NGW = F.G * NWAVES;
    const float s1 = wave_sum(lamp[F.lane] * lamp[64 + F.lane]), s2 = wave_sum(lamp[128 + F.lane] * lamp[192 + F.lane]);
    const float lam = expf(s1) - expf(s2) + lam_init;
    const int dd = (8 * F.lane) & 127; const f32x4 g0 = *(const f32x4*)(subg + dd), g1 = *(const f32x4*)(subg + dd + 4);
    for (int m = gw; m < T; m += NGW) {
        const v4u a = *(const v4u*)(O0 + (size_t)m * 512 + 8 * F.lane), bq = *(const v4u*)(O1 + (size_t)m * 512 + 8 * F.lane);
        float y[8]; y[0] = bf_lo(a.x) - lam * bf_lo(bq.x); y[1] = bf_hi(a.x) - lam * bf_hi(bq.x); y[2] = bf_lo(a.y) - lam * bf_lo(bq.y); y[3] = bf_hi(a.y) - lam * bf_hi(bq.y);
        y[4] = bf_lo(a.z) - lam * bf_lo(bq.z); y[5] = bf_hi(a.z) - lam * bf_hi(bq.z); y[6] = bf_lo(a.w) - lam * bf_lo(bq.w); y[7] = bf_hi(a.w) - lam * bf_hi(bq.w);
        float ss = 0.f;
#pragma unroll
        for (int j = 0; j < 8; ++j) ss += y[j] * y[j];
        ss += __shfl_xor(ss, 1); ss += __shfl_xor(ss, 2); ss += __shfl_xor(ss, 4); ss += __shfl_xor(ss, 8);
        const float rn = (1.0f / sqrtf(ss * (1.0f / 128.0f) + NORM_EPS)) * (1.0f - lam_init);
        v4u w; w.x = pk2(y[0] * rn * g0.x, y[1] * rn * g0.y); w.y = pk2(y[2] * rn * g0.z, y[3] * rn * g0.w); w.z = pk2(y[4] * rn * g1.x, y[5] * rn * g1.y); w.w = pk2(y[6] * rn * g1.z, y[7] * rn * g1.w);
        *(v4u*)(YDF + (size_t)m * 512 + 8 * F.lane) = w;
    }
}
__device__ __forceinline__ void topk_phase(Frame& F, const bf16* QP, const bf16* SUBK  , int* EIDX, float* EGATE) {
    LAS unsigned char* kl = F.lds;
    for (int u = F.vcu; u < 256; u += F.G) {
        const int h = u & 7, chunk = u >> 3, t = chunk * 512 + F.tid;
        __syncthreads();
        { const v4u* src = (const v4u*)(SUBK + (size_t)h * 2 * 128 * 128);
          for (int i = F.tid; i < 4096; i += 512) *(LAS v4u*)(kl + (size_t)i * 16) = src[i]; }
        __syncthreads();
        float lst[2][16];
#pragma unroll
        for (int c = 0; c < 2; ++c) {
            unsigned q[64];
            { const v4u* qs = (const v4u*)(QP + (size_t)t * 2048 + h * 256 + c * 128);
#pragma unroll
              for (int i = 0; i < 16; ++i) { const v4u w = qs[i]; q[4 * i] = w.x; q[4 * i + 1] = w.y; q[4 * i + 2] = w.z; q[4 * i + 3] = w.w; } }
#pragma unroll
            for (int k = 0; k < 16; ++k) lst[c][k] = -3.0e38f;
            for (int n = 0; n < 128; ++n) {
                const LAS v4u* kr = (const LAS v4u*)(kl + (size_t)(c * 128 + n) * 256);
                float s0 = 0.f, s1 = 0.f;
#pragma unroll
                for (int i = 0; i < 16; ++i) { const v4u kk = kr[i]; s0 = dot2bf(q[4 * i], kk.x, s0); s1 = dot2bf(q[4 * i + 1], kk.y, s1); s0 = dot2bf(q[4 * i + 2], kk.z, s0); s1 = dot2bf(q[4 * i + 3], kk.w, s1); }
                float v = __uint_as_float((__float_as_uint(s0 + s1) & ~127u) | (unsigned)n);
#pragma unroll
                for (int k = 0; k < 16; ++k) { const float hi = fmaxf(lst[c][k], v), lo = fminf(lst[c][k], v); lst[c][k] = hi; v = lo; }
            }
        }
        float bv[16];
#pragma unroll
        for (int k = 0; k < 16; ++k) bv[k] = -3.0e38f;
#pragma unroll
        for (int i = 0; i < 16; ++i)
#pragma unroll
            for (int j = 0; j < 16; ++j) if ((i + 1) * (j + 1) <= 16) {
                const unsigned a = __float_as_uint(lst[0][i]), b = __float_as_uint(lst[1][j]);
                float v = __uint_as_float((__float_as_uint(__uint_as_float(a & ~127u) + __uint_as_float(b & ~127u)) & ~255u) | (unsigned)(i * 16 + j));
#pragma unroll
                for (int k = 0; k < 16; ++k) { const float hi = fmaxf(bv[k], v), lo = fminf(bv[k], v); bv[k] = hi; v = lo; }
            }
        unsigned w0[4], w1[4];
#pragma unroll
        for (int k = 0; k < 4; ++k) { w0[k] = 0u; w1[k] = 0u;
#pragma unroll
            for (int b = 0; b < 4; ++b) { w0[k] |= (__float_as_uint(lst[0][4 * k + b]) & 127u) << (8 * b); w1[k] |= (__float_as_uint(lst[1][4 * k + b]) & 127u) << (8 * b); } }
        float e[16], sum = 0.f; int bp[16];
        const float vmax = __uint_as_float(__float_as_uint(bv[0]) & ~255u);
#pragma unroll
        for (int k = 0; k < 16; ++k) { const unsigned bits = __float_as_uint(bv[k]); const unsigned id = bits & 255u, ii = id >> 4, jj = id & 15u;
            const unsigned s0 = (ii >> 2) == 0 ? w0[0] : (ii >> 2) == 1 ? w0[1] : (ii >> 2) == 2 ? w0[2] : w0[3];
            const unsigned s1 = (jj >> 2) == 0 ? w1[0] : (jj >> 2) == 1 ? w1[1] : (jj >> 2) == 2 ? w1[2] : w1[3];
            bp[k] = (int)((((s0 >> (8 * (ii & 3))) & 127u) << 7) | ((s1 >> (8 * (jj & 3))) & 127u));
            e[k] = expf(__uint_as_float(bits & ~255u) - vmax); sum += e[k]; }
        const float inv = 1.0f / sum;
        int* ei = EIDX + (size_t)t * 128 + h * 16; float* eg = EGATE + (size_t)t * 128 + h * 16;
#pragma unroll
        for (int k = 0; k < 16; k += 4) { *(int4*)(ei + k) = make_int4(bp[k], bp[k + 1], bp[k + 2], bp[k + 3]); *(f32x4*)(eg + k) = (f32x4){e[k] * inv, e[k + 1] * inv, e[k + 2] * inv, e[k + 3] * inv}; }
    }
    __syncthreads();
}
__device__ __forceinline__ void gather_phase(Frame& F, const bf16* H2, const int* EIDX, const float* EGATE, const bf16* UB, const bf16* VB, const float* x1, const float* gate2  ,
                                             float* xout, const float* final_g  ) {
    const int gw = F.vcu * NWAVES + F.wave, NGW = F.G * NWAVES; const int l = F.lane;
    for (int m = gw; m < T; m += NGW) { const int b = m >> 12;
        const v4u ha = *(const v4u*)(H2 + (size_t)m * D + 8 * l), hb = *(const v4u*)(H2 + (size_t)m * D + 512 + 8 * l);
        const int i0 = EIDX[(size_t)m * 128 + l], i1 = EIDX[(size_t)m * 128 + 64 + l]; const float g0 = EGATE[(size_t)m * 128 + l], g1 = EGATE[(size_t)m * 128 + 64 + l];
        float oa[8], ob[8];
#pragma unroll
        for (int j = 0; j < 8; ++j) { oa[j] = 0.f; ob[j] = 0.f; }
#pragma unroll 2
        for (int e = 0; e < 128; ++e) {
            const int ei = (e < 64) ? __builtin_amdgcn_readlane(i0, e & 63) : __builtin_amdgcn_readlane(i1, e & 63);
            const float ge = __uint_as_float((e < 64) ? __builtin_amdgcn_readlane(__float_as_uint(g0), e & 63) : __builtin_amdgcn_readlane(__float_as_uint(g1), e & 63));
            const bf16* ur = UB + (size_t)ei * D; const bf16* vr = VB + (size_t)ei * D;
            const v4u ua = *(const v4u*)(ur + 8 * l), ub = *(const v4u*)(ur + 512 + 8 * l);
            const v4u va = *(const v4u*)(vr + 8 * l), vb = *(const v4u*)(vr + 512 + 8 * l);
            float p = 0.f, p2 = 0.f;
            p = dot2bf(ha.x, ua.x, p); p2 = dot2bf(ha.y, ua.y, p2); p = dot2bf(ha.z, ua.z, p); p2 = dot2bf(ha.w, ua.w, p2);
            p = dot2bf(hb.x, ub.x, p); p2 = dot2bf(hb.y, ub.y, p2); p = dot2bf(hb.z, ub.z, p); p2 = dot2bf(hb.w, ub.w, p2);
            const float a = wave_sum(p + p2);
            const float act = 0.5f * a * (1.0f + erff(a * 0.70710678118654752f)) * ge;
            oa[0] += act * bf_lo(va.x); oa[1] += act * bf_hi(va.x); oa[2] += act * bf_lo(va.y); oa[3] += act * bf_hi(va.y); oa[4] += act * bf_lo(va.z); oa[5] += act * bf_hi(va.z); oa[6] += act * bf_lo(va.w); oa[7] += act * bf_hi(va.w);
            ob[0] += act * bf_lo(vb.x); ob[1] += act * bf_hi(vb.x); ob[2] += act * bf_lo(vb.y); ob[3] += act * bf_hi(vb.y); ob[4] += act * bf_lo(vb.z); ob[5] += act * bf_hi(vb.z); ob[6] += act * bf_lo(vb.w); ob[7] += act * bf_hi(vb.w);
        }
        const float* xr = x1 + (size_t)m * D; const float* gr = gate2 + (size_t)b * 6144; float* orow = xout + (size_t)m * D;
        f32x4 r[4];
#pragma unroll
        for (int k = 0; k < 4; ++k) { const int c = (k < 2 ? 0 : 512) + 8 * l + 4 * (k & 1); const f32x4 xv = *(const f32x4*)(xr + c), gv = *(const f32x4*)(gr + c);
            const float* os = (k < 2 ? oa : ob) + 4 * (k & 1); r[k] = xv + gv * (f32x4){os[0], os[1], os[2], os[3]}; }
        if (final_g) { float s = 0.f;
#pragma unroll
            for (int k = 0; k < 4; ++k) s += (r[k].x * r[k].x + r[k].y * r[k].y) + (r[k].z * r[k].z + r[k].w * r[k].w);
            const float rn = 1.0f / sqrtf(wave_sum(s) * (1.0f / D) + NORM_EPS);
#pragma unroll
            for (int k = 0; k < 4; ++k) { const int c = (k < 2 ? 0 : 512) + 8 * l + 4 * (k & 1); r[k] = r[k] * rn * *(const f32x4*)(final_g + c); } }
#pragma unroll
        for (int k = 0; k < 4; ++k) { const int c = (k < 2 ? 0 : 512) + 8 * l + 4 * (k & 1); *(f32x4*)(orow + c) = r[k]; }
    }
}

#define WSP(T_, off) ((T_*)(ws + (off)))
#define RETID() do { int t_ = threadIdx.x; asm volatile("" : "+v"(t_)); F.tid = t_; F.lane = t_ & 63; F.wave = __builtin_amdgcn_readfirstlane(t_ >> 6); } while (0)
#define GRID_BAR() xcd_barrier(bar)
template <int l> __device__ __forceinline__ void layer_program(Frame& F, const Args& args, unsigned char* ws, const XcdBarrier& bar, unsigned char* lds) {
        const float* mod = WSP(const float, WS_MOD) + (size_t)l * 4 * 6144;
#ifndef NO_P1
        RETID();
        hnorm_phase(F, (l == 0) ? args.in[0] : WSP(const float, WS_XB), args.in[2] + (size_t)l * D, mod + 0, mod + 1024, WSP(bf16, WS_H));
        cvt_table(F, args.in[15] + (size_t)l * NEXP * D, WSP(bf16, WS_UB), NEXP * D / 8);
        cvt_table(F, args.in[16] + (size_t)l * NEXP * D, WSP(bf16, WS_VB), NEXP * D / 8);
#endif
        GRID_BAR();
#ifndef NO_P2
        { pg8::Gemm g{WSP(const bf16, WS_H), WSP(const bf16, WS_WIN) + (size_t)l * INCOLS * D, T, INCOLS, D}; pg8::StaticOrder S; S.init(T, INCOLS, F.G, (int)blockIdx.x);
          pg8::EpiIn E{ws, args.in[7] + (size_t)l * 2048};
          pg8::gemm_phase<pg8::EpiIn, pg8::StaticOrder, PG8_ALIGN, PG8_SP2>(F.lds + RING_OFF, g, S, E); }
#endif
        GRID_BAR();
#ifndef NO_P3A
        { const attn_body::AttnTensors AT{WSP(const attn_body::bf16, WS_DQ), WSP(const attn_body::bf16, WS_DK), WSP(const attn_body::bf16, WS_DV), WSP(attn_body::bf16, WS_H), WSP(attn_body::bf16, WS_H) + (size_t)T * 512};
          const attn_body::StaticOrder S((int)F.G, (int)blockIdx.x);
          attn_body::attn_phase<attn_body::StaticOrder>((char*)lds + RING_OFF, AT, S); }
#endif
#ifndef NO_P3B
        RETID();
        sb_scalar_phase(F, WSP(const bf16, WS_SBQ), WSP(const bf16, WS_SBK), WSP(const bf16, WS_SBV), WSP(bf16, WS_YSB));
#endif
        GRID_BAR();
#ifndef NO_P4
        { pg8::Gemm g{WSP(const bf16, WS_YSB), WSP(const bf16, WS_WSB) + (size_t)l * D * 512, T, D, 512}; pg8::StaticOrder S; S.init(T, D, F.G, (int)blockIdx.x);
          pg8::EpiGate E{WSP(bf16, WS_M1), WSP(const bf16, WS_GSB), nullptr};
          pg8::gemm_phase<pg8::EpiGate, pg8::StaticOrder, PG8_ALIGN, PG8_SP2>(F.lds + RING_OFF, g, S, E); }
        RETID();
        diffcombine_phase(F, WSP(const bf16, WS_H), WSP(const bf16, WS_H) + (size_t)T * 512, args.in[8] + (size_t)l * 256, args.in[9] + (size_t)l * 128, 0.8f - 0.6f * expf(-0.3f * (float)l), WSP(bf16, WS_YDF));
#endif
        GRID_BAR();
#ifndef NO_P5
        { pg8::Gemm g{WSP(const bf16, WS_YDF), WSP(const bf16, WS_WDF) + (size_t)l * D * 512, T, D, 512}; pg8::StaticOrder S; S.init(T, D, F.G, (int)blockIdx.x);
          pg8::EpiGate E{WSP(bf16, WS_MRG), WSP(const bf16, WS_GDF), WSP(const bf16, WS_M1)};
          pg8::gemm_phase<pg8::EpiGate, pg8::StaticOrder, PG8_ALIGN, PG8_SP2>(F.lds + RING_OFF, g, S, E); }
#endif
        GRID_BAR();
#ifndef NO_P6
        { pg8::Gemm g{WSP(const bf16, WS_MRG), WSP(const bf16, WS_WOUT) + (size_t)l * D * D, T, D, D}; pg8::StaticOrder S; S.init(T, D, F.G, (int)blockIdx.x);
          pg8::EpiRes E{(l == 0) ? args.in[0] : WSP(const float, WS_XB), WSP(float, WS_XA), mod + 2048, 6144};
          pg8::gemm_phase<pg8::EpiRes, pg8::StaticOrder, PG8_ALIGN, PG8_SP2>(F.lds + RING_OFF, g, S, E); }
#endif
        GRID_BAR();
#ifndef NO_P7
        RETID();
        hnorm_phase(F, WSP(const float, WS_XA), args.in[3] + (size_t)l * D, mod + 3072, mod + 4096, WSP(bf16, WS_H));
#endif
        GRID_BAR();
#ifndef NO_P8
        { pg8::Gemm g{WSP(const bf16, WS_H), WSP(const bf16, WS_WQ) + (size_t)l * 2048 * D, T, 2048, D}; pg8::StaticOrder S; S.init(T, 2048, F.G, (int)blockIdx.x);
          pg8::EpiBf16<0> E{WSP(bf16, WS_QP), 2048, nullptr, 0, 0, 1.f};
          pg8::gemm_phase<pg8::EpiBf16<0>, pg8::StaticOrder, PG8_ALIGN, PG8_SP2>(F.lds + RING_OFF, g, S, E); }
#endif
        GRID_BAR();
#ifndef NO_P9
        RETID();
        topk_phase(F, WSP(const bf16, WS_QP), WSP(const bf16, WS_SUBK) + (size_t)l * 8 * 2 * 128 * 128, WSP(int, WS_EIDX), WSP(float, WS_EGATE));
#endif
        GRID_BAR();
#ifndef NO_P10
        RETID();
        gather_phase(F, WSP(const bf16, WS_H), WSP(const int, WS_EIDX), WSP(const float, WS_EGATE), WSP(const bf16, WS_UB), WSP(const bf16, WS_VB), WSP(const float, WS_XA), mod + 5120,
                     (l == DEPTH - 1) ? args.out : WSP(float, WS_XB), (l == DEPTH - 1) ? args.in[17] : nullptr);
#endif
        if (l + 1 < DEPTH) GRID_BAR();
}
__global__ void __launch_bounds__(NWAVES * 64, 2) mega_fwd(Args args) {
    extern __shared__ __attribute__((aligned(16))) unsigned char lds[];
    Frame F; F.lds = (LAS unsigned char*)lds; F.MISC = (volatile LAS unsigned*)(F.lds + MISC_OFF);
    F.tid = threadIdx.x; F.lane = F.tid & 63; F.wave = __builtin_amdgcn_readfirstlane(F.tid >> 6);
    F.G = gridDim.x; { const int bx = blockIdx.x; F.vcu = (F.G % 8 == 0) ? (bx % 8) * (F.G / 8) + bx / 8 : bx; }
    unsigned char* ws = args.ws;
    gu32* ctl = (gu32*)(ws + WS_CTL);
    for (int u = F.tid; u < (LDS_BYTES - LDSCTL_OFF) / 4; u += NWAVES * 64) ((LAS unsigned*)(F.lds + LDSCTL_OFF))[u] = 0u;
    __syncthreads();
    XcdBarrier bar = xcd_barrier_post((unsigned*)(ctl + CW_BAR), F.MISC + 8);
    p0_prologue(F, args);
    asm volatile("s_waitcnt vmcnt(0)" ::: "memory");
    cg::this_grid().sync();
    GRID_BAR();
    layer_program<0>(F, args, ws, bar, lds);
    layer_program<1>(F, args, ws, bar, lds);
}

extern "C" void kernel_launch(void* const* d_in, const int* in_sizes, int n_in, void* d_out, int out_size, void* d_ws, size_t ws_size, hipStream_t stream) {
    static int grid = 0;
    if (grid == 0) {
        if (n_in != 18 || in_sizes[0] != T * D || out_size != T * D || ws_size < WS_END) { fprintf(stderr, "kernel_launch: unexpected shapes (n_in %d, in0 %d, out %d, ws %zu < %zu); nothing launched\n", n_in, n_in > 0 ? in_sizes[0] : -1, out_size, ws_size, (size_t)WS_END); grid = -1; return; }
        int dev = 0, cus = 0, per_cu = 0;
        if (hipGetDevice(&dev) != hipSuccess || hipDeviceGetAttribute(&cus, hipDeviceAttributeMultiprocessorCount, dev) != hipSuccess) { fprintf(stderr, "kernel_launch: device query failed\n"); grid = -1; return; }
        if (hipFuncSetAttribute((const void*)mega_fwd, hipFuncAttributeMaxDynamicSharedMemorySize, LDS_BYTES) != hipSuccess) { fprintf(stderr, "kernel_launch: hipFuncSetAttribute failed\n"); grid = -1; return; }
        if (hipOccupancyMaxActiveBlocksPerMultiprocessor(&per_cu, (const void*)mega_fwd, NWAVES * 64, LDS_BYTES) != hipSuccess || per_cu < 1) { fprintf(stderr, "kernel_launch: occupancy query reports %d workgroups per CU\n", per_cu); (void)hipGetLastError(); grid = -1; return; }
        grid = cus;
    }
    if (grid < 0) return;
    if (hipMemsetAsync((char*)d_ws + WS_CTL, 0, CTL_ZERO_BYTES, stream) != hipSuccess) { fprintf(stderr, "kernel_launch: hipMemsetAsync failed\n"); return; }
    Args a{};
    for (int i = 0; i < 18; ++i) a.in[i] = (const float*)d_in[i];
    a.out = (float*)d_out; a.ws = (unsigned char*)d_ws;
    void* kargs[] = {&a};
    const hipError_t le = hipLaunchCooperativeKernel((const void*)mega_fwd, dim3(grid), dim3(NWAVES * 64), kargs, LDS_BYTES, stream);
    if (le != hipSuccess) fprintf(stderr, "kernel_launch: cooperative launch failed: %s (grid %d)\n", hipGetErrorName(le), grid);
}
```

```cpp
#include <hip/hip_runtime.h>
#include <cstdio>
#include <cstdint>
#include <hip/hip_cooperative_groups.h>
namespace pg8 {
#define PG8_LAS __attribute__((address_space(3)))
typedef unsigned short bf16_t;
typedef short bf16x8 __attribute__((ext_vector_type(8)));
typedef float f32x4 __attribute__((ext_vector_type(4)));
typedef unsigned u32x4 __attribute__((ext_vector_type(4)));
constexpr int BM = 256, BK = 64, HALF = 128, HTB = HALF * BK * 2  , STAGE_BYTES = 8 * HTB, NXCD = 8, WGM = 8;

__host__ __device__ __forceinline__ int lds_byte(int r, int c) { const int st = (r >> 4) * 2 + (c >> 5), rr = r & 15, cc = c & 31, ob = rr * 64 + cc * 2; return st * 1024 + (ob ^ (((ob >> 9) & 1) << 5)); }
__host__ __device__ __forceinline__ void stage_rc(int b, int& R, int& C) { const int st = b / 1024, sb = b % 1024, swz = sb ^ (((sb >> 9) & 1) << 5); R = (st >> 1) * 16 + swz / 64; C = (st & 1) * 32 + (swz % 64) / 2; }
__host__ __device__ __forceinline__ int perm32(int rho) { const int n = rho >> 4, i = rho & 15; return 8 * (i >> 2) + 4 * n + (i & 3); }

struct Unit { int pm, pn; };
struct Gemm { const bf16_t* A; const bf16_t* Bt; int M, N, K; };

struct StaticOrder {
    int nM, nN, nwg, G, c;
    __host__ __device__ void init(int M, int N, int G_, int c_) { nM = M / BM; nN = N / BM; nwg = nM * nN; G = G_; c = c_; }
    __host__ __device__ bool next(int i, Unit& u) const {
        const long L = (long)i * G + c; if (L >= nwg) return false;
        int wgid = (int)L; { const int q = nwg / NXCD, r = nwg % NXCD, xcd = wgid % NXCD, off = wgid / NXCD; wgid = (xcd < r ? xcd * (q + 1) : r * (q + 1) + (xcd - r) * q) + off; }
        const int nig = WGM * nN, gid = wgid / nig, fm = gid * WGM, gsz = (nM - fm) < WGM ? (nM - fm) : WGM;
        u.pm = fm + ((wgid % nig) % gsz); u.pn = (wgid % nig) / gsz; return true;
    }
    __device__ __forceinline__ void a_ready(const Unit&) const {}
    __device__ __forceinline__ void done(const Unit&) const {}
};

__device__ __forceinline__ unsigned cvt_pk_bf16(float lo, float hi) { unsigned r; asm volatile("v_cvt_pk_bf16_f32 %0, %1, %2" : "=v"(r) : "v"(lo), "v"(hi)); return r; }
typedef float f32x2 __attribute__((ext_vector_type(2)));
__device__ __forceinline__ f32x2 gelu_pk(f32x2 v) {
    const f32x2 av = __builtin_elementwise_abs(v), d = av * 0.2316418882f + 1.0f;
    f32x2 t; t.x = __builtin_amdgcn_rcpf(d.x); t.y = __builtin_amdgcn_rcpf(d.y);
    f32x2 q = t * 0.5307027145f + (-0.7265760135f); q = q * t + 0.7107068705f; q = q * t + (-0.142248368f); q = q * t + 0.127414796f; q = q * t;
    const f32x2 s = (v * v) * (-0.72134752044f);
    f32x2 e; e.x = __builtin_amdgcn_exp2f(s.x); e.y = __builtin_amdgcn_exp2f(s.y);
    const f32x2 m = v * (q * e), r = v - m;
    f32x2 o; o.x = v.x < 0.f ? m.x : r.x; o.y = v.y < 0.f ? m.y : r.y; return o;
}

template <int ACT  > struct EpiBf16 {
    static constexpr bool PERM = true, AFTER_DRAIN = false; static_assert(ACT == 0 || ACT == 1, "EpiBf16: ACT is 0 (none) or 1 (gelu_pk)");
    bf16_t* O; int ldc; const float* bias; int split_cols; size_t split_stride; float scale0;
    __device__ __forceinline__ void operator()(const f32x4 (&acc)[2][2][4][2], const Unit& u, int wr, int wc, int fr, int fq) const {
        const int row0 = u.pm * BM + wr * 64 + fr; int colt = u.pn * BM; bf16_t* base = O;
        float sc = 1.f; if (split_cols) { const int t = colt / split_cols; base += (size_t)t * split_stride; colt -= t * split_cols; if (t == 0) sc = scale0; }
        const int col0 = colt + wc * 32 + 8 * fq, bcol0 = u.pn * BM + wc * 32 + 8 * fq;
        f32x4 bv[2][2];
#pragma unroll
        for (int bj = 0; bj < 2; ++bj)
#pragma unroll
            for (int n = 0; n < 2; ++n) bv[bj][n] = bias ? *(const f32x4*)(bias + bcol0 + bj * HALF + 4 * n) : (f32x4){0.f, 0.f, 0.f, 0.f};
#pragma unroll
        for (int ai = 0; ai < 2; ++ai)
#pragma unroll
            for (int m = 0; m < 4; ++m) { bf16_t* rowp = base + (size_t)(row0 + ai * HALF + m * 16) * ldc + col0;
#pragma unroll
                for (int bj = 0; bj < 2; ++bj) { f32x4 v0 = acc[ai][bj][m][0] + bv[bj][0], v1 = acc[ai][bj][m][1] + bv[bj][1];
                    if (ACT == 1) { f32x2 a = gelu_pk((f32x2){v0[0], v0[1]}), b = gelu_pk((f32x2){v0[2], v0[3]}), c = gelu_pk((f32x2){v1[0], v1[1]}), d = gelu_pk((f32x2){v1[2], v1[3]});
                        v0 = (f32x4){a.x, a.y, b.x, b.y}; v1 = (f32x4){c.x, c.y, d.x, d.y}; }
                    v0 = v0 * sc; v1 = v1 * sc; u32x4 w; w.x = cvt_pk_bf16(v0[0], v0[1]); w.y = cvt_pk_bf16(v0[2], v0[3]); w.z = cvt_pk_bf16(v1[0], v1[1]); w.w = cvt_pk_bf16(v1[2], v1[3]);
                    *(u32x4*)(rowp + bj * HALF) = w; } }
    }
};
typedef unsigned u32x2 __attribute__((ext_vector_type(2)));
__device__ __forceinline__ f32x4 bf4_to_f32(unsigned lo, unsigned hi) { f32x4 r; r[0] = __uint_as_float(lo << 16); r[1] = __uint_as_float(lo & 0xffff0000u); r[2] = __uint_as_float(hi << 16); r[3] = __uint_as_float(hi & 0xffff0000u); return r; }
__device__ __forceinline__ float sigmoidf_(float x) { return 1.0f / (1.0f + __expf(-x)); }
constexpr size_t EPI_MiB = 1u << 20;
constexpr size_t EPI_WS_ROPE = 1 * EPI_MiB + 256 * 1024, EPI_WS_SBQ = 136 * EPI_MiB, EPI_WS_SBK = 152 * EPI_MiB, EPI_WS_SBV = 168 * EPI_MiB, EPI_WS_SBVT = 184 * EPI_MiB, EPI_WS_DQ = 200 * EPI_MiB, EPI_WS_DK = 216 * EPI_MiB, EPI_WS_DV = 232 * EPI_MiB,
                 EPI_WS_GSB = 248 * EPI_MiB, EPI_WS_GDF = 280 * EPI_MiB;
struct EpiIn {
    static constexpr bool PERM = true, AFTER_DRAIN = false;
    unsigned char* ws; const float* gate_b;
    __device__ __forceinline__ void operator()(const f32x4 (&acc)[2][2][4][2], const Unit& u, int wr, int wc, int fr, int fq) const {
        bf16_t* const sbq = (bf16_t*)(ws + EPI_WS_SBQ); bf16_t* const sbk = (bf16_t*)(ws + EPI_WS_SBK); bf16_t* const sbv = (bf16_t*)(ws + EPI_WS_SBV); bf16_t* const sbvt = (bf16_t*)(ws + EPI_WS_SBVT);
        bf16_t* const dq = (bf16_t*)(ws + EPI_WS_DQ); bf16_t* const dk = (bf16_t*)(ws + EPI_WS_DK); bf16_t* const dv = (bf16_t*)(ws + EPI_WS_DV); bf16_t* const gsb = (bf16_t*)(ws + EPI_WS_GSB); bf16_t* const gdf = (bf16_t*)(ws + EPI_WS_GDF);
        const float* const rope_cos = (const float*)(ws + EPI_WS_ROPE); const float* const rope_sin = rope_cos + 4096 * 8; const float c2 = 0.125f * 1.4426950408889634f;
        const int row0 = u.pm * BM + wr * 64 + fr; const int pn = u.pn; const int seg = pn >> 1;
        const int cc0 = wc * 32 + 8 * fq;
        if (pn >= 12) {
            const bool isdf = pn >= 16; bf16_t* G = isdf ? gdf : gsb; const int gc0 = (pn - (isdf ? 16 : 12)) * 256 + cc0; const float* gb = gate_b + (isdf ? 1024 : 0) + gc0;
            f32x4 bv[2][2];
#pragma unroll
            for (int bj = 0; bj < 2; ++bj)
#pragma unroll
                for (int n = 0; n < 2; ++n) bv[bj][n] = *(const f32x4*)(gb + bj * HALF + 4 * n);
#pragma unroll
            for (int ai = 0; ai < 2; ++ai)
#pragma unroll
                for (int m = 0; m < 4; ++m) { bf16_t* rowp = G + (size_t)(row0 + ai * HALF + m * 16) * 1024 + gc0;
#pragma unroll
                    for (int bj = 0; bj < 2; ++bj) { const f32x4 v0 = acc[ai][bj][m][0] + bv[bj][0], v1 = acc[ai][bj][m][1] + bv[bj][1];
                        u32x4 w; w.x = cvt_pk_bf16(sigmoidf_(v0[0]), sigmoidf_(v0[1])); w.y = cvt_pk_bf16(sigmoidf_(v0[2]), sigmoidf_(v0[3])); w.z = cvt_pk_bf16(sigmoidf_(v1[0]), sigmoidf_(v1[1])); w.w = cvt_pk_bf16(sigmoidf_(v1[2]), sigmoidf_(v1[3]));
                        *(u32x4*)(rowp + bj * HALF) = w; } }
            return;
        }
        const int col0 = (pn & 1) * 256 + cc0;
        if (seg == 3 || seg == 4) {
            bf16_t* O = seg == 3 ? dq : dk; const float sc = seg == 3 ? c2 : 1.0f;
            const bool ropew = (wc & 1) == 0;
            const bool rl = fq < 2;
#pragma unroll
            for (int ai = 0; ai < 2; ++ai)
#pragma unroll
                for (int m = 0; m < 4; ++m) { const int row = row0 + ai * HALF + m * 16; bf16_t* rowp = O + (size_t)row * 512 + col0;
                    f32x4 cs0 = {1.f, 1.f, 1.f, 1.f}, cs1 = cs0, sn0 = {0.f, 0.f, 0.f, 0.f}, sn1 = sn0;
                    if (ropew) { const int pos = row & 4095; cs0 = *(const f32x4*)(rope_cos + pos * 8); cs1 = *(const f32x4*)(rope_cos + pos * 8 + 4); sn0 = *(const f32x4*)(rope_sin + pos * 8); sn1 = *(const f32x4*)(rope_sin + pos * 8 + 4); }
#pragma unroll
                    for (int bj = 0; bj < 2; ++bj) { f32x4 v0 = acc[ai][bj][m][0], v1 = acc[ai][bj][m][1];
                        if (ropew) { f32x4 p0, p1;
#pragma unroll
                            for (int j = 0; j < 4; ++j) { p0[j] = __shfl_xor(v0[j], 16); p1[j] = __shfl_xor(v1[j], 16); }
                            const float sg = (fq == 0) ? -1.0f : 1.0f;
                            if (rl) { v0 = v0 * cs0 + (p0 * sn0) * sg; v1 = v1 * cs1 + (p1 * sn1) * sg; } }
                        v0 = v0 * sc; v1 = v1 * sc;
                        u32x4 w; w.x = cvt_pk_bf16(v0[0], v0[1]); w.y = cvt_pk_bf16(v0[2], v0[3]); w.z = cvt_pk_bf16(v1[0], v1[1]); w.w = cvt_pk_bf16(v1[2], v1[3]);
                        *(u32x4*)(rowp + bj * HALF) = w; } }
            return;
        }
        bf16_t* O = seg == 0 ? sbq : seg == 1 ? sbk : seg == 2 ? sbv : dv; const float sc = seg == 0 ? 0.125f : 1.0f;
#pragma unroll
        for (int ai = 0; ai < 2; ++ai)
#pragma unroll
            for (int m = 0; m < 4; ++m) { const int row = row0 + ai * HALF + m * 16; bf16_t* rowp = O + (size_t)row * 512 + col0;
#pragma unroll
                for (int bj = 0; bj < 2; ++bj) { const f32x4 v0 = acc[ai][bj][m][0] * sc, v1 = acc[ai][bj][m][1] * sc;
                    u32x4 w; w.x = cvt_pk_bf16(v0[0], v0[1]); w.y = cvt_pk_bf16(v0[2], v0[3]); w.z = cvt_pk_bf16(v1[0], v1[1]); w.w = cvt_pk_bf16(v1[2], v1[3]);
                    *(u32x4*)(rowp + bj * HALF) = w;
#if defined(SBVT_STORE)
                    if (seg == 2) {
                        const int b = row >> 12, t = row & 4095;
#pragma unroll
                        for (int j = 0; j < 8; ++j) { const int col = col0 + bj * HALF + j; const int h = col >> 6, d = col & 63;
                            const unsigned word = j < 2 ? w.x : j < 4 ? w.y : j < 6 ? w.z : w.w; const bf16_t e = (bf16_t)((j & 1) ? (word >> 16) : (word & 0xffffu));
                            sbvt[((size_t)(b * 8 + h) * 64 + d) * 4096 + t] = e; } }
#endif
                } }
    }
};
struct EpiGate {
    static constexpr bool PERM = true, AFTER_DRAIN = false;
    bf16_t* O; const bf16_t* gate; const bf16_t* add;
    __device__ __forceinline__ void operator()(const f32x4 (&acc)[2][2][4][2], const Unit& u, int wr, int wc, int fr, int fq) const {
        const int row0 = u.pm * BM + wr * 64 + fr; const int col0 = u.pn * BM + wc * 32 + 8 * fq;
#pragma unroll
        for (int ai = 0; ai < 2; ++ai)
#pragma unroll
            for (int m = 0; m < 4; ++m) { const size_t off = (size_t)(row0 + ai * HALF + m * 16) * 1024 + col0;
#pragma unroll
                for (int bj = 0; bj < 2; ++bj) { const u32x4 g = *(const u32x4*)(gate + off + bj * HALF);
                    f32x4 v0 = acc[ai][bj][m][0] * bf4_to_f32(g.x, g.y), v1 = acc[ai][bj][m][1] * bf4_to_f32(g.z, g.w);
                    if (add) { const u32x4 a = *(const u32x4*)(add + off + bj * HALF); v0 = v0 + bf4_to_f32(a.x, a.y); v1 = v1 + bf4_to_f32(a.z, a.w); }
                    u32x4 w; w.x = cvt_pk_bf16(v0[0], v0[1]); w.y = cvt_pk_bf16(v0[2], v0[3]); w.z = cvt_pk_bf16(v1[0], v1[1]); w.w = cvt_pk_bf16(v1[2], v1[3]);
                    *(u32x4*)(O + off + bj * HALF) = w; } }
    }
};
struct EpiRes {
    static constexpr bool PERM = false, AFTER_DRAIN = false;
    const float* base; float* out; const float* gvec; int gstride;
    __device__ __forceinline__ void operator()(const f32x4 (&acc)[2][2][4][2], const Unit& u, int wr, int wc, int fr, int fq) const {
        const int row0 = u.pm * BM + wr * 64 + fr; const int col0 = u.pn * BM + wc * 32 + 4 * fq; const int b = (u.pm * BM) >> 12;
        f32x4 gv[2][2];
#pragma unroll
        for (int bj = 0; bj < 2; ++bj)
#pragma unroll
            for (int n = 0; n < 2; ++n) gv[bj][n] = *(const f32x4*)(gvec + (size_t)b * gstride + col0 + bj * HALF + n * 16);
#pragma unroll
        for (int ai = 0; ai < 2; ++ai)
#pragma unroll
            for (int m = 0; m < 4; ++m) { const size_t off = (size_t)(row0 + ai * HALF + m * 16) * 1024 + col0;
#pragma unroll
                for (int bj = 0; bj < 2; ++bj)
#pragma unroll
                    for (int n = 0; n < 2; ++n) { const f32x4 bs = *(const f32x4*)(base + off + bj * HALF + n * 16);
                        *(f32x4*)(out + off + bj * HALF + n * 16) = bs + gv[bj][n] * acc[ai][bj][m][n]; } }
    }
};
template <class Epi, class Sched, bool ALIGN_EPI = false, bool SP2 = false>
__device__ __forceinline__ void gemm_phase(PG8_LAS unsigned char* lds, const Gemm g, const Sched& S, const Epi& E) {
    int tid_ = threadIdx.x; asm volatile("" : "+v"(tid_));
    const int tid = tid_, wid = __builtin_amdgcn_readfirstlane(tid >> 6), lane = tid & 63, wr = wid >> 2, wc = wid & 3, fr = lane & 15, fq = lane >> 4;
    const int K = g.K, nt = K / BK;
    unsigned voffA[2], voffB[2];
#pragma unroll
    for (int i = 0; i < 2; ++i) { int R, C; stage_rc(tid * 16 + i * 8192, R, C); const int Rb = Epi::PERM ? ((R & ~31) + perm32(R & 31)) : R;
        voffA[i] = (unsigned)(R * K + C) * 2u; voffB[i] = (unsigned)(Rb * K + C) * 2u; }
    const size_t kstep = (size_t)(BK * 2);
    const size_t hstep = (size_t)HALF * K * 2;
    const size_t tstep = 2 * hstep;
    const unsigned ldsw = (unsigned)wid * 1024u;
    const int aoff = lds_byte(wr * 64 + fr, fq * 8), boff = lds_byte(wc * 32 + fr, fq * 8);
#define PG8_SA(b, h) (((b) * 2 + (h)) * HTB)
#define PG8_SB(b, h) ((4 + (b) * 2 + (h)) * HTB)
#define PG8_STAGE(bufoff, gbase, voff) do { _Pragma("unroll") for (int _i = 0; _i < 2; ++_i) \
        __builtin_amdgcn_global_load_lds((const unsigned*)((const char*)(gbase) + (voff)[_i]), (PG8_LAS unsigned*)(lds + (bufoff) + ldsw + _i * 8192), 16, 0, 0); } while (0)
#define PG8_LDA(dst, b, h) do { _Pragma("unroll") for (int m = 0; m < 4; ++m) _Pragma("unroll") for (int k = 0; k < 2; ++k) dst[m][k] = *(const PG8_LAS bf16x8*)(lds + PG8_SA(b, h) + aoff + m * 2048 + k * 1024); } while (0)
#define PG8_LDB(dst, b, h) do { _Pragma("unroll") for (int n = 0; n < 2; ++n) _Pragma("unroll") for (int k = 0; k < 2; ++k) dst[n][k] = *(const PG8_LAS bf16x8*)(lds + PG8_SB(b, h) + boff + n * 2048 + k * 1024); } while (0)
#define PG8_MMA(ai, bj, At, Bt) do { __builtin_amdgcn_s_setprio(1); _Pragma("unroll") for (int m = 0; m < 4; ++m) _Pragma("unroll") for (int n = 0; n < 2; ++n) _Pragma("unroll") for (int k = 0; k < 2; ++k) \
        acc[ai][bj][m][n] = __builtin_amdgcn_mfma_f32_16x16x32_bf16(Bt[n][k], At[m][k], acc[ai][bj][m][n], 0, 0, 0); __builtin_amdgcn_s_setprio(0); } while (0)
#define PG8_WAIT_V(n) asm volatile("s_waitcnt vmcnt(" #n ")" ::: "memory")
#define PG8_WAIT_L(n) asm volatile("s_waitcnt lgkmcnt(" #n ")" ::: "memory")
#define PG8_BAR __builtin_amdgcn_s_barrier()
#define PG8_SCHED __builtin_amdgcn_sched_barrier(0)
    Unit cur, nxt; int ui = 0;
    if (!S.next(0, cur)) return;
    f32x4 acc[2][2][4][2];
#pragma unroll
    for (int a = 0; a < 2; ++a)
#pragma unroll
        for (int b = 0; b < 2; ++b)
#pragma unroll
            for (int m = 0; m < 4; ++m)
#pragma unroll
                for (int n = 0; n < 2; ++n) acc[a][b][m][n] = (f32x4){0.f, 0.f, 0.f, 0.f};
    bf16x8 At[4][2], B0[2][2], B1[2][2];
    const char* cA = (const char*)g.A + (size_t)cur.pm * tstep; const char* cB = (const char*)g.Bt + (size_t)cur.pn * tstep;
    S.a_ready(cur);
    if constexpr (SP2) {
        PG8_STAGE(PG8_SB(0, 0), cB, voffB); PG8_STAGE(PG8_SB(0, 1), cB + hstep, voffB); PG8_STAGE(PG8_SA(0, 0), cA, voffA); PG8_STAGE(PG8_SA(0, 1), cA + hstep, voffA);
        if (wr == 1) PG8_BAR;
        PG8_WAIT_V(2); PG8_BAR;
        PG8_STAGE(PG8_SB(1, 0), cB + kstep, voffB); PG8_STAGE(PG8_SA(1, 0), cA + kstep, voffA); PG8_STAGE(PG8_SB(1, 1), cB + hstep + kstep, voffB);
        PG8_WAIT_V(6); PG8_BAR;
    } else {
        PG8_STAGE(PG8_SB(0, 0), cB, voffB); PG8_STAGE(PG8_SA(0, 0), cA, voffA); PG8_STAGE(PG8_SB(0, 1), cB + hstep, voffB); PG8_STAGE(PG8_SA(0, 1), cA + hstep, voffA);
        if (wr == 1) PG8_BAR;
        PG8_WAIT_V(4); PG8_BAR;
        PG8_STAGE(PG8_SB(1, 0), cB + kstep, voffB); PG8_STAGE(PG8_SA(1, 0), cA + kstep, voffA); PG8_STAGE(PG8_SB(1, 1), cB + hstep + kstep, voffB);
        PG8_WAIT_V(6); PG8_BAR;
    }
    for (;;) {
        const bool has_next = S.next(ui + 1, nxt);
        const char* nA = has_next ? (const char*)g.A + (size_t)nxt.pm * tstep : cA; const char* nB = has_next ? (const char*)g.Bt + (size_t)nxt.pn * tstep : cB;
        for (int t = 0; t < nt; t += 2) {
            const bool last = (t == nt - 2);
            const char* a1 = cA + (size_t)(t + 1) * kstep;
            const char* a2 = last ? nA : cA + (size_t)(t + 2) * kstep; const char* b2 = last ? nB : cB + (size_t)(t + 2) * kstep;
            const char* a3 = a2 + kstep; const char* b3 = b2 + kstep;
            if (last && has_next) S.a_ready(nxt);
            if constexpr (SP2) {
            PG8_LDB(B0, 0, 0); PG8_LDB(B1, 0, 1); PG8_SCHED; PG8_LDA(At, 0, 0); PG8_STAGE(PG8_SA(1, 1), a1 + hstep, voffA);
            PG8_WAIT_V(8); PG8_WAIT_L(0); PG8_BAR; PG8_MMA(0, 0, At, B0); PG8_MMA(0, 1, At, B1); PG8_BAR; PG8_SCHED;
            PG8_LDA(At, 0, 1); PG8_STAGE(PG8_SB(0, 0), b2, voffB); PG8_STAGE(PG8_SB(0, 1), b2 + hstep, voffB); PG8_STAGE(PG8_SA(0, 0), a2, voffA);
            PG8_WAIT_V(8); PG8_WAIT_L(0); PG8_BAR; PG8_MMA(1, 0, At, B0); PG8_MMA(1, 1, At, B1); PG8_BAR; PG8_SCHED;
            PG8_LDB(B0, 1, 0); PG8_LDB(B1, 1, 1); PG8_SCHED; PG8_LDA(At, 1, 0); PG8_STAGE(PG8_SA(0, 1), a2 + hstep, voffA);
            PG8_WAIT_V(8); PG8_WAIT_L(0); PG8_BAR; PG8_MMA(0, 0, At, B0); PG8_MMA(0, 1, At, B1); PG8_BAR; PG8_SCHED;
            PG8_LDA(At, 1, 1); PG8_STAGE(PG8_SB(1, 0), b3, voffB); PG8_STAGE(PG8_SB(1, 1), b3 + hstep, voffB); PG8_STAGE(PG8_SA(1, 0), a3, voffA);
            PG8_WAIT_V(8); PG8_WAIT_L(0); PG8_BAR; PG8_MMA(1, 0, At, B0); PG8_MMA(1, 1, At, B1); PG8_BAR; PG8_SCHED;
            } else {
            PG8_LDB(B0, 0, 0); PG8_SCHED; PG8_LDA(At, 0, 0); PG8_STAGE(PG8_SA(1, 1), a1 + hstep, voffA);
            PG8_WAIT_L(8); PG8_BAR; PG8_WAIT_L(0); PG8_MMA(0, 0, At, B0); PG8_BAR; PG8_SCHED;
            PG8_LDB(B1, 0, 1); PG8_STAGE(PG8_SB(0, 0), b2, voffB);
            PG8_BAR; PG8_WAIT_L(0); PG8_MMA(0, 1, At, B1); PG8_BAR;
            PG8_LDA(At, 0, 1); PG8_STAGE(PG8_SA(0, 0), a2, voffA);
            PG8_BAR; PG8_WAIT_L(0); PG8_MMA(1, 0, At, B0); PG8_BAR; PG8_SCHED;
            PG8_STAGE(PG8_SB(0, 1), b2 + hstep, voffB);
            PG8_WAIT_V(6); PG8_BAR; PG8_MMA(1, 1, At, B1); PG8_BAR;
            PG8_LDB(B0, 1, 0); PG8_SCHED; PG8_LDA(At, 1, 0); PG8_STAGE(PG8_SA(0, 1), a2 + hstep, voffA);
            PG8_WAIT_L(8); PG8_BAR; PG8_WAIT_L(0); PG8_MMA(0, 0, At, B0); PG8_BAR; PG8_SCHED;
            PG8_LDB(B1, 1, 1); PG8_STAGE(PG8_SB(1, 0), b3, voffB);
            PG8_BAR; PG8_WAIT_L(0); PG8_MMA(0, 1, At, B1); PG8_BAR;
            PG8_LDA(At, 1, 1); PG8_STAGE(PG8_SA(1, 0), a3, voffA);
            PG8_BAR; PG8_WAIT_L(0); PG8_MMA(1, 0, At, B0); PG8_BAR; PG8_SCHED;
            PG8_STAGE(PG8_SB(1, 1), b3 + hstep, voffB);
            PG8_WAIT_V(6); PG8_BAR; PG8_MMA(1, 1, At, B1); PG8_BAR;
            }
        }
        if constexpr (ALIGN_EPI) { if (wr == 0) PG8_BAR; }
        if constexpr (!Epi::AFTER_DRAIN) { E(acc, cur, wr, wc, fr, fq); S.done(cur); }
        if (!has_next) break;
#pragma unroll
        for (int a = 0; a < 2; ++a)
#pragma unroll
            for (int b = 0; b < 2; ++b)
#pragma unroll
                for (int m = 0; m < 4; ++m)
#pragma unroll
                    for (int n = 0; n < 2; ++n) acc[a][b][m][n] = (f32x4){0.f, 0.f, 0.f, 0.f};
        cur = nxt; cA = nA; cB = nB; ++ui;
        if constexpr (ALIGN_EPI) { if (wr == 1) PG8_BAR; }
    }
    PG8_WAIT_V(0);
    if constexpr (!ALIGN_EPI) { if (wr == 0) PG8_BAR; }
    PG8_BAR;
    if constexpr (Epi::AFTER_DRAIN) { E.fused(acc, cur, wr, wc, fr, fq, lds, wid, lane); S.done(cur); }
#undef PG8_SA
#undef PG8_SB
#undef PG8_STAGE
#undef PG8_LDA
#undef PG8_LDB
#undef PG8_MMA
#undef PG8_WAIT_V
#undef PG8_WAIT_L
#undef PG8_BAR
#undef PG8_SCHED
}
}

#ifndef PG8_SP2
#define PG8_SP2 true
#endif
#ifndef PG8_ALIGN
#define PG8_ALIGN true
#endif
#include <hip/hip_bf16.h>
#include <cmath>
namespace attn_body {
using bf16=__hip_bfloat16;
using bf16x8=__attribute__((ext_vector_type(8)))short;
using s16x4=__attribute__((ext_vector_type(4)))short;
using f32x16=__attribute__((ext_vector_type(16)))float;
using u32x4=__attribute__((ext_vector_type(4)))unsigned;
constexpr int BATCH=4,SEQ=4096,D=64,DM=512;
constexpr int NW=8,QBLK=32,QB=QBLK*NW,KVBLK=64,NQB=SEQ/QB;
constexpr int ATTN_PITCH=DM, ATTN_UNIT_ROWS=QB;
__device__ __forceinline__ int crow(int r,int hi){return (r&3)+8*(r>>2)+4*hi;}
#define SBAR() __builtin_amdgcn_sched_barrier(0)
__device__ __forceinline__ void cmask(f32x16&p0,f32x16&p1,int jb,int qrel,int hi){
  const float NEG=-INFINITY; int kb=64*jb+4*hi;
  #pragma unroll
  for(int r=0;r<16;++r){int kv=kb+(r&3)+8*(r>>2); if(kv>qrel)p0[r]=NEG; if(kv+32>qrel)p1[r]=NEG;}
}

constexpr int NSLOT=3, SLOTB=8192;
constexpr int LDS_K=0, LDS_V=NSLOT*SLOTB, LDS_WS=2*NSLOT*SLOTB, LDS_OST=LDS_WS+NW*64*4, LDS_BYTES=LDS_OST+NW*4096;
constexpr float C2=0.125f*1.4426950408889634f;
__device__ __forceinline__ void glds16(const void*gsrc,unsigned lds_dst){unsigned keep;
  asm volatile("s_mov_b32 %0, m0\n\ts_mov_b32 m0, %2\n\ts_nop 0\n\tglobal_load_lds_dwordx4 %1, off\n\ts_mov_b32 m0, %0":"=&s"(keep):"v"(gsrc),"s"(lds_dst):"memory");}
__device__ __forceinline__ float max3f(float a,float b,float c){float r;asm("v_max3_f32 %0, %1, %2, %3":"=v"(r):"v"(a),"v"(b),"v"(c));return r;}
__device__ __forceinline__ float max2f(float a,float b){float r;asm("v_max_f32_e32 %0, %1, %2":"=v"(r):"v"(a),"v"(b));return r;}
__device__ __forceinline__ float fadd_s(float a,float b){float r;asm("v_add_f32_e32 %0, %1, %2":"=v"(r):"v"(a),"v"(b));return r;}
__device__ __forceinline__ float fsub_s(float a,float b){float r;asm("v_sub_f32_e32 %0, %1, %2":"=v"(r):"v"(a),"v"(b));return r;}
typedef float f32x2_t __attribute__((ext_vector_type(2))); typedef __bf16 bf16x2_t __attribute__((ext_vector_type(2)));
__device__ __forceinline__ unsigned cvtpk_s(float lo,float hi){f32x2_t v={lo,hi};bf16x2_t b=__builtin_convertvector(v,bf16x2_t);return __builtin_bit_cast(unsigned,b);}
#define WAIT_BAR(N) asm volatile("s_waitcnt vmcnt(" #N ") lgkmcnt(0)\n\ts_barrier":::"memory")

__device__ __forceinline__ void qkt(f32x16&p0,f32x16&p1,const char*Kslot,const bf16x8*qr,const f32x16&negm,int r32,int hi){
  const char*kb=Kslot+hi*1024+r32*16;
  #pragma unroll
  for(int d0=0;d0<4;++d0){
    const bf16x8 b0=*reinterpret_cast<const bf16x8*>(kb+d0*2048);
    const bf16x8 b1=*reinterpret_cast<const bf16x8*>(kb+d0*2048+512);
    if(d0==0){p0=__builtin_amdgcn_mfma_f32_32x32x16_bf16(b0,qr[0],negm,0,0,0);p1=__builtin_amdgcn_mfma_f32_32x32x16_bf16(b1,qr[0],negm,0,0,0);}
    else{p0=__builtin_amdgcn_mfma_f32_32x32x16_bf16(b0,qr[d0],p0,0,0,0);p1=__builtin_amdgcn_mfma_f32_32x32x16_bf16(b1,qr[d0],p1,0,0,0);}}
}
typedef __attribute__((address_space(3))) const char* lds_cptr;
typedef short v4i16_t __attribute__((ext_vector_type(4)));
__device__ __forceinline__ void kload8(bf16x8*kf,lds_cptr kp){
  kf[0]=*(const __attribute__((address_space(3))) bf16x8*)(kp);      kf[1]=*(const __attribute__((address_space(3))) bf16x8*)(kp+512);
  kf[2]=*(const __attribute__((address_space(3))) bf16x8*)(kp+2048); kf[3]=*(const __attribute__((address_space(3))) bf16x8*)(kp+2560);
  kf[4]=*(const __attribute__((address_space(3))) bf16x8*)(kp+4096); kf[5]=*(const __attribute__((address_space(3))) bf16x8*)(kp+4608);
  kf[6]=*(const __attribute__((address_space(3))) bf16x8*)(kp+6144); kf[7]=*(const __attribute__((address_space(3))) bf16x8*)(kp+6656);
}
__device__ __forceinline__ void kload2(bf16x8*kf,lds_cptr kp,int j){ kf[2*j]=*(const __attribute__((address_space(3))) bf16x8*)(kp+j*2048); kf[2*j+1]=*(const __attribute__((address_space(3))) bf16x8*)(kp+j*2048+512); }
__device__ __forceinline__ s16x4 vtr(lds_cptr p){ return __builtin_bit_cast(s16x4,__builtin_amdgcn_ds_read_tr16_b64_v4i16((__attribute__((address_space(3))) v4i16_t*)p)); }
__device__ __forceinline__ float rowmax(const f32x16&p0,const f32x16&p1){
  float a=max3f(p0[0],p0[1],p1[0]),b=max3f(p0[2],p0[3],p1[1]);a=max3f(a,p1[2],p1[3]);
  #pragma unroll
  for(int r=4;r<16;r+=4){a=max3f(a,p0[r],p0[r+1]);b=max3f(b,p0[r+2],p0[r+3]);a=max3f(a,p1[r],p1[r+1]);b=max3f(b,p1[r+2],p1[r+3]);}
  const float m=max2f(a,b);
  auto rr=__builtin_amdgcn_permlane32_swap(__float_as_uint(m),__float_as_uint(m),false,false);
  return max2f(__uint_as_float(rr[0]),__uint_as_float(rr[1]));
}
__device__ __forceinline__ void pv(f32x16*o,int vb,bf16x8 pa0,bf16x8 pa1,bf16x8 pa2,bf16x8 pa3){
  #pragma unroll
  for(int d0=0;d0<2;++d0){s16x4 lo[4],hi[4];
    #pragma unroll
    for(int ks=0;ks<4;++ks){
      asm volatile("ds_read_b64_tr_b16 %0,%1 offset:%c2":"=&v"(lo[ks]):"v"(vb),"i"(d0*4096+ks*1024):"memory");
      asm volatile("ds_read_b64_tr_b16 %0,%1 offset:%c2":"=&v"(hi[ks]):"v"(vb),"i"(d0*4096+ks*1024+512):"memory");}
    asm volatile("s_waitcnt lgkmcnt(0)":::"memory");SBAR();
    #define PK(k) (bf16x8){lo[k][0],lo[k][1],lo[k][2],lo[k][3],hi[k][0],hi[k][1],hi[k][2],hi[k][3]}
    o[d0]=__builtin_amdgcn_mfma_f32_32x32x16_bf16(pa0,PK(0),o[d0],0,0,0);
    o[d0]=__builtin_amdgcn_mfma_f32_32x32x16_bf16(pa1,PK(1),o[d0],0,0,0);
    o[d0]=__builtin_amdgcn_mfma_f32_32x32x16_bf16(pa2,PK(2),o[d0],0,0,0);
    o[d0]=__builtin_amdgcn_mfma_f32_32x32x16_bf16(pa3,PK(3),o[d0],0,0,0);
    #undef PK
  }
}

#ifndef ATTN_STORE16
#define ATTN_STORE16(p,v) (*(u32x4*)(p)=(v))
#endif
template<int THRL> __device__ __forceinline__ void attn_unit(int b,int qcol,int vcol,int ocol,int qb,const bf16*Q,const bf16*__restrict__ K,const bf16*__restrict__ V,bf16*O,char*shm){
  int tid_=threadIdx.x; asm volatile("":"+v"(tid_)); const int tid=tid_,lane=tid&63,r32=lane&31,hi=lane>>5; const int wid=__builtin_amdgcn_readfirstlane(tid>>6);
  const long rowbase=(long)b*SEQ; const int q0=qb*QB;
  const bf16*Qw=Q+(rowbase+q0+wid*QBLK)*DM+qcol;
  const bf16*Kh=K+rowbase*DM+qcol,*Vh=V+rowbase*DM+vcol;
  const unsigned lds0=(unsigned)(uintptr_t)shm;
  float*wsf=(float*)(shm+LDS_WS)+wid*64;
  const bf16*ksrc=Kh+(long)lane*DM+wid*8;
  const bf16*vsrc=Vh+(long)(16*(wid&3)+(lane>>2))*DM+(wid>>2)*32+(lane&3)*8;
  const unsigned kdst=lds0+LDS_K+wid*1024, vdst=lds0+LDS_V+wid*1024;
  #define DMA_K(t,slot) glds16(ksrc+(long)(t)*KVBLK*DM,(unsigned)__builtin_amdgcn_readfirstlane(kdst+(slot)))
  #define DMA_V(t,slot) glds16(vsrc+(long)(t)*KVBLK*DM,(unsigned)__builtin_amdgcn_readfirstlane(vdst+(slot)))
  const int vb0=(int)(lds0+LDS_V)+((lane>>4)&1)*32+(lane&3)*8+(4*hi+((lane&15)>>2))*64;
  const char*Kbase=shm+LDS_K; bf16x8 kf[8];
  const lds_cptr shm3=(lds_cptr)shm; const lds_cptr kp0=shm3+LDS_K+hi*1024+r32*16; const lds_cptr vp0=shm3+LDS_V+((lane>>4)&1)*32+(lane&3)*8+(4*hi+((lane&15)>>2))*64;
  const int NT=(q0+QB)/KVBLK;
  DMA_K(0,0);DMA_V(0,0);DMA_K(1,SLOTB);
  bf16x8 qr[4];
  #pragma unroll
  for(int d0=0;d0<4;++d0)qr[d0]=*reinterpret_cast<const bf16x8*>(&Qw[(long)r32*DM+d0*16+hi*8]);
  float mhat=0.f,l_reg=0.f;f32x16 o[2];o[0]=f32x16{};o[1]=f32x16{};f32x16 negm=f32x16{};asm volatile("":"+v"(negm));
  const int qrel=wid*QBLK+r32;
  #define CMASK(P0,P1,t) do{int jb_=(t)-(NT-4); if(jb_>=0)cmask(P0,P1,jb_,qrel,hi);}while(0)
  bool resc=false;
  #define START(P0,P1) do{ const float rm=rowmax(P0,P1); resc=false; \
    { const float dl=rm; mhat=fadd_s(mhat,dl); \
      _Pragma("unroll") for(int r=0;r<16;++r){P0[r]=fsub_s(P0[r],dl);P1[r]=fsub_s(P1[r],dl);} \
      _Pragma("unroll") for(int r=0;r<16;++r)negm[r]=-mhat; asm volatile("":"+v"(negm)); } \
    _Pragma("unroll") for(int r=0;r<16;++r)P0[r]=__builtin_amdgcn_exp2f(P0[r]); }while(0)
  #define RESC() do{ if(resc){ asm volatile("s_waitcnt lgkmcnt(0)":::"memory"); \
      _Pragma("unroll") for(int d_=0;d_<2;++d_) _Pragma("unroll") for(int r=0;r<16;++r)o[d_][r]*=wsf[crow(r,hi)]; } }while(0)
  f32x16 pA0,pA1,pB0,pB1;
  int sl_prev=0,sl_cur=0,sl_next=SLOTB;
  #define ROT() do{sl_prev=sl_cur;sl_cur=sl_next;sl_next=(sl_next==(NSLOT-1)*SLOTB)?0:sl_next+SLOTB;}while(0)
  DMA_K(2,2*SLOTB);
  WAIT_BAR(3);
  qkt(pA0,pA1,Kbase,qr,negm,r32,hi);asm volatile("s_nop 15\n\ts_nop 7":"+v"(pA0),"+v"(pA1));CMASK(pA0,pA1,0);
  START(pA0,pA1);
  _Pragma("unroll") for(int r=0;r<16;++r)pA1[r]=__builtin_amdgcn_exp2f(pA1[r]);
  WAIT_BAR(0);
  DMA_K(3,0);DMA_V(1,SLOTB);
  ROT();
  kload8(kf,kp0+sl_cur);
  WAIT_BAR(2);
  s16x4 vlo[8],vhi[8]; u32x4 pw0,pw1,pw2,pw3;
  #define PKW(P,B) cvtpk_s(P[B],P[B+1])
  #define PAF(k) __builtin_bit_cast(bf16x8,pw##k)
  #define VFR(i) (bf16x8){vlo[i][0],vlo[i][1],vlo[i][2],vlo[i][3],vhi[i][0],vhi[i][1],vhi[i][2],vhi[i][3]}
  #define PIN(x) asm volatile("":"+v"(x))
  #define MX3(a,b,c) __builtin_fmaxf(__builtin_fmaxf((a),(b)),(c))
  #define GAPA(MF,A0,A1,A2,A3,W0,W1,PW) do{ MF; sacc+=A0; sacc+=A1; sacc+=A2; sacc+=A3; PIN(sacc); W0; W1; PIN(PW); SBAR(); }while(0)
  #define EX(v) __builtin_amdgcn_exp2f(v)
  #define GAPB(MF,X,B) do{ MF; X[B]=EX(X[B]); X[B+1]=EX(X[B+1]); X[B+2]=EX(X[B+2]); X[B+3]=EX(X[B+3]); PIN(X); SBAR(); }while(0)
  #define VRD(i) do{ vlo[i]=vtr(vp_+(((i)>>2)*4096+((i)&3)*1024)); vhi[i]=vtr(vp_+(((i)>>2)*4096+((i)&3)*1024+512)); }while(0)
  #define KRD(G,j) do{ if(G){ kload2(kf,kp0+sl_next,j); SBAR(); } }while(0)
  #define STEP(C0,C1,P0,P1,t,GK,GV,GL) do{ SBAR(); \
    const lds_cptr vp_=vp0+sl_prev; \
    VRD(0); SBAR(); float sacc=(P0[0]+P0[1]); \
    GAPA(C0=__builtin_amdgcn_mfma_f32_32x32x16_bf16(kf[0],qr[0],negm,0,0,0), P0[2],P0[3],P0[4],P0[5],     pw0[0]=PKW(P0,0), pw0[1]=PKW(P0,2), pw0); \
    VRD(4); SBAR(); GAPA(C1=__builtin_amdgcn_mfma_f32_32x32x16_bf16(kf[1],qr[0],negm,0,0,0), P0[6],P0[7],P0[8],P0[9],     pw0[2]=PKW(P0,4), pw0[3]=PKW(P0,6), pw0); \
    VRD(1); SBAR(); GAPA(C0=__builtin_amdgcn_mfma_f32_32x32x16_bf16(kf[2],qr[1],C0,0,0,0),   P0[10],P0[11],P0[12],P0[13], pw1[0]=PKW(P0,8), pw1[1]=PKW(P0,10), pw1); \
    VRD(5); SBAR(); GAPA(C1=__builtin_amdgcn_mfma_f32_32x32x16_bf16(kf[3],qr[1],C1,0,0,0),   P0[14],P0[15],P1[0],P1[1],   pw1[2]=PKW(P0,12),pw1[3]=PKW(P0,14), pw1); \
    VRD(2); SBAR(); GAPA(C0=__builtin_amdgcn_mfma_f32_32x32x16_bf16(kf[4],qr[2],C0,0,0,0),   P1[2],P1[3],P1[4],P1[5],     pw2[0]=PKW(P1,0), pw2[1]=PKW(P1,2), pw2); \
    VRD(6); SBAR(); GAPA(C1=__builtin_amdgcn_mfma_f32_32x32x16_bf16(kf[5],qr[2],C1,0,0,0),   P1[6],P1[7],P1[8],P1[9],     pw2[2]=PKW(P1,4), pw2[3]=PKW(P1,6), pw2); \
    VRD(3); SBAR(); GAPA(C0=__builtin_amdgcn_mfma_f32_32x32x16_bf16(kf[6],qr[3],C0,0,0,0),   P1[10],P1[11],P1[12],P1[13], pw3[0]=PKW(P1,8), pw3[1]=PKW(P1,10), pw3); \
    VRD(7); SBAR(); GAPA(C1=__builtin_amdgcn_mfma_f32_32x32x16_bf16(kf[7],qr[3],C1,0,0,0),   P1[14],P1[15],0.f,0.f,       pw3[2]=PKW(P1,12),pw3[3]=PKW(P1,14), pw3); \
    l_reg+=sacc; \
    if(GK){DMA_K((t)+3,sl_cur);} if(GV){DMA_V((t)+1,sl_next);} \
    CMASK(C0,C1,t); \
    { float a=MX3(C0[0],C0[1],C1[0]),b=MX3(C0[2],C0[3],C1[1]); a=MX3(a,C1[2],C1[3]); \
      _Pragma("unroll") for(int r=4;r<16;r+=4){a=MX3(a,C0[r],C0[r+1]);b=MX3(b,C0[r+2],C0[r+3]);a=MX3(a,C1[r],C1[r+1]);b=MX3(b,C1[r+2],C1[r+3]);} \
      float rm=__builtin_fmaxf(a,b); { auto rr=__builtin_amdgcn_permlane32_swap(__float_as_uint(rm),__float_as_uint(rm),false,false); rm=__builtin_fmaxf(__uint_as_float(rr[0]),__uint_as_float(rr[1])); } \
      resc=false; \
      if(__builtin_expect(__any(rm>(float)THRL),0)){ const float dl=__builtin_fmaxf(rm,0.f); mhat+=dl; \
        _Pragma("unroll") for(int r=0;r<16;++r){C0[r]-=dl;C1[r]-=dl;} \
        _Pragma("unroll") for(int r=0;r<16;++r)negm[r]=-mhat; asm volatile("":"+v"(negm)); \
        const float f=__builtin_amdgcn_exp2f(-dl); l_reg*=f; if(hi==0)wsf[r32]=f; resc=true; } } \
    SBAR(); \
    GAPB(o[0]=__builtin_amdgcn_mfma_f32_32x32x16_bf16(PAF(0),VFR(0),o[0],0,0,0), C0,0); \
    GAPB(o[1]=__builtin_amdgcn_mfma_f32_32x32x16_bf16(PAF(0),VFR(4),o[1],0,0,0), C0,4); \
    KRD(GL,0); GAPB(o[0]=__builtin_amdgcn_mfma_f32_32x32x16_bf16(PAF(1),VFR(1),o[0],0,0,0), C0,8); \
    KRD(GL,1); GAPB(o[1]=__builtin_amdgcn_mfma_f32_32x32x16_bf16(PAF(1),VFR(5),o[1],0,0,0), C0,12); \
    KRD(GL,2); GAPB(o[0]=__builtin_amdgcn_mfma_f32_32x32x16_bf16(PAF(2),VFR(2),o[0],0,0,0), C1,0); \
    KRD(GL,3); GAPB(o[1]=__builtin_amdgcn_mfma_f32_32x32x16_bf16(PAF(2),VFR(6),o[1],0,0,0), C1,4); \
    GAPB(o[0]=__builtin_amdgcn_mfma_f32_32x32x16_bf16(PAF(3),VFR(3),o[0],0,0,0), C1,8); \
    GAPB(o[1]=__builtin_amdgcn_mfma_f32_32x32x16_bf16(PAF(3),VFR(7),o[1],0,0,0), C1,12); \
    }while(0)
  int t=1;
  #undef CMASK
  #define CMASK(P0,P1,t) do{}while(0)
  for(;t+5<NT;t+=2){
    STEP(pB0,pB1,pA0,pA1,t,true,true,true);     WAIT_BAR(2); RESC(); ROT();
    STEP(pA0,pA1,pB0,pB1,t+1,true,true,true);   WAIT_BAR(2); RESC(); ROT();
  }
  #undef CMASK
  #define CMASK(P0,P1,t) do{int jb_=(t)-(NT-4); if(jb_>=0)cmask(P0,P1,jb_,qrel,hi);}while(0)
  #define ENDW(tt) do{ if((tt)+3<NT){WAIT_BAR(2);} else if((tt)+2<NT){WAIT_BAR(1);} else {WAIT_BAR(0);} }while(0)
  for(;t+1<NT;t+=2){
    STEP(pB0,pB1,pA0,pA1,t,(t+3<NT),(t+1<NT),(t+1<NT));       ENDW(t);   RESC(); ROT();
    STEP(pA0,pA1,pB0,pB1,t+1,(t+4<NT),(t+2<NT),(t+2<NT));     ENDW(t+1); RESC(); ROT();
  }
  STEP(pB0,pB1,pA0,pA1,NT-1,false,false,false); RESC();
  { float sacc=pB0[0]+pB0[1]; _Pragma("unroll") for(int r=2;r<16;++r)sacc+=pB0[r]; _Pragma("unroll") for(int r=0;r<16;++r)sacc+=pB1[r]; l_reg+=sacc;
    pw0=(u32x4){PKW(pB0,0),PKW(pB0,2),PKW(pB0,4),PKW(pB0,6)};pw1=(u32x4){PKW(pB0,8),PKW(pB0,10),PKW(pB0,12),PKW(pB0,14)};pw2=(u32x4){PKW(pB1,0),PKW(pB1,2),PKW(pB1,4),PKW(pB1,6)};pw3=(u32x4){PKW(pB1,8),PKW(pB1,10),PKW(pB1,12),PKW(pB1,14)};
    SBAR(); pv(o,vb0+sl_cur,PAF(0),PAF(1),PAF(2),PAF(3)); }
  #undef PKW
  #undef PAF
  #undef VFR
  #undef PIN
  #undef MX3
  #undef GAPA
  #undef GAPB
  #undef EX
  #undef VRD
  #undef KRD
  #undef STEP
  #undef ENDW
  {auto rr=__builtin_amdgcn_permlane32_swap(__float_as_uint(l_reg),__float_as_uint(l_reg),false,false);l_reg=__uint_as_float(rr[0])+__uint_as_float(rr[1]);}
  if(hi==0)wsf[32+r32]=l_reg;asm volatile("s_waitcnt lgkmcnt(0)":::"memory");
  float rli[16];
  #pragma unroll
  for(int r=0;r<16;++r)rli[r]=__builtin_amdgcn_rcpf(wsf[32+crow(r,hi)]);
  bf16*Ow=O+(rowbase+q0+wid*QBLK)*DM+ocol;
  { bf16*stg=(bf16*)(shm+LDS_OST)+wid*2048;
    #pragma unroll
    for(int r=0;r<16;++r){const int orow=crow(r,hi);
      #pragma unroll
      for(int d0=0;d0<2;++d0)stg[orow*64+d0*32+r32]=__float2bfloat16(o[d0][r]*rli[r]);}
    asm volatile("s_waitcnt lgkmcnt(0)":::"memory");
    #pragma unroll
    for(int i=0;i<4;++i){const int row=i*8+(lane>>3),ch=lane&7; const u32x4 v=*(const u32x4*)(stg+row*64+ch*8); ATTN_STORE16(Ow+(long)row*DM+ch*8,v);} }
  asm volatile("s_waitcnt lgkmcnt(0)\n\ts_barrier":::"memory");
  #undef DMA_K
  #undef DMA_V
  #undef CMASK
  #undef START
  #undef RESC
  #undef ROT
}
constexpr int ATTN_LDS_BYTES=LDS_BYTES;
struct AttnTensors { const bf16* Q; const bf16* K; const bf16* V; bf16* O0; bf16* O1; };
struct AttnUnit { int bh; int qb; };
struct StaticOrder {
  int vcu;
  __device__ __forceinline__ explicit StaticOrder(int grid,int block):vcu((block%8)*(grid/8)+block/8){}
  __device__ __forceinline__ bool next(int i,AttnUnit&u)const{ if(i>=4)return false; const int s=vcu&3; u.bh=vcu>>2; u.qb=(i==0)?s:(i==1)?7-s:(i==2)?8+s:15-s; return true; }
  __device__ __forceinline__ void a_ready(const AttnUnit&)const{}
  __device__ __forceinline__ void done(const AttnUnit&)const{}
};
template<class Sched,int THRL=8> __device__ __forceinline__ void attn_phase(char*lds,const AttnTensors&T,const Sched&S){
  AttnUnit u;
  for(int i=0;S.next(i,u);++i){ S.a_ready(u);
    const int b=u.bh>>4, vh=u.bh&15, head=vh>>2, c=(vh>>1)&1, half=vh&1;
    const int qcol=(head*2+c)*64, vcol=head*128+half*64;
    attn_unit<THRL>(b,qcol,vcol,vcol,u.qb,T.Q,T.K,T.V,c?T.O1:T.O0,lds); S.done(u); }
}
#undef SBAR
#undef WAIT_BAR
}
#define GAS __attribute__((address_space(1)))
#define LAS __attribute__((address_space(3)))
typedef unsigned short bf16;
typedef unsigned v4u __attribute__((ext_vector_type(4)));
typedef float f32x4 __attribute__((ext_vector_type(4)));
typedef short bf16x8 __attribute__((ext_vector_type(8)));
typedef GAS unsigned gu32;
typedef GAS unsigned long long gu64;
#define RLX_AGENT __ATOMIC_RELAXED, __HIP_MEMORY_SCOPE_AGENT
#define LDS_WAIT() asm volatile("s_waitcnt lgkmcnt(0)" ::: "memory")
#define VM_WAIT() asm volatile("s_waitcnt vmcnt(0)" ::: "memory")
__device__ __forceinline__ unsigned long long rt() { return __builtin_amdgcn_s_memrealtime(); }
__device__ __forceinline__ unsigned f2bf(float f) { unsigned u = __builtin_bit_cast(unsigned, f); return (u + 0x7fffu + ((u >> 16) & 1u)) >> 16; }
__device__ __forceinline__ unsigned pk2(float lo, float hi) { return f2bf(lo) | (f2bf(hi) << 16); }

#define XB_TMO      128
#define XB_XCNT(j)  (256  + 64 * (j))
#define XB_XSUB(j)  (1280 + 64 * (j))
#define XB_XGEN(j)  (2304 + 64 * (j))
#define XB_TOP      3328
#define XB_TOPGEN   3392
#define XCD_BAR_WORDS 3456
#define XB_SPIN_CAP (1u << 18)

__device__ __forceinline__ unsigned xb_ld(unsigned* p)              { return __hip_atomic_load(p, __ATOMIC_RELAXED, __HIP_MEMORY_SCOPE_AGENT); }
__device__ __forceinline__ unsigned xb_add(unsigned* p, unsigned v) { return __hip_atomic_fetch_add(p, v, __ATOMIC_RELAXED, __HIP_MEMORY_SCOPE_AGENT); }
__device__ __forceinline__ unsigned xb_xcc_id() { return (unsigned)__builtin_amdgcn_s_getreg((3 << 11) | 20) & 0xFu; }
#define XB_SPIN(cond, bar) do { unsigned _sp = 0; while (cond) { __builtin_amdgcn_s_sleep(1); \
    if ((++_sp & 255u) == 0u) { if (xb_ld(&(bar)[XB_TMO])) break; if (_sp > XB_SPIN_CAP) { atomicAdd(&(bar)[XB_TMO], 1u); break; } } } } while (0)

struct XcdBarrier {
    unsigned* bar; unsigned x;
    volatile LAS unsigned* st;
};

__device__ __forceinline__ XcdBarrier xcd_barrier_post(unsigned* bar, volatile LAS unsigned* st) {
    XcdBarrier b; b.bar = bar; b.x = xb_xcc_id(); b.st = st;
    if (threadIdx.x == 0) (void)xb_add(&bar[XB_XCNT(b.x)], 1u);
    return b;
}
__device__ __forceinline__ void xcd_barrier_complete(unsigned* bar, unsigned x, unsigned& nloc, unsigned& nx) {
    const unsigned G = gridDim.x * gridDim.y * gridDim.z;
    unsigned sum, cnt, mine, sp = 0u;
    for (;;) {
        sum = 0u; cnt = 0u; mine = 0u;
#pragma unroll
        for (unsigned j = 0; j < 16; ++j) { const unsigned c = xb_ld(&bar[XB_XCNT(j)]); sum += c; cnt += (c > 0u) ? 1u : 0u; mine = (j == x) ? c : mine; }
        if (sum == G) break;
        __builtin_amdgcn_s_sleep(1);
        if ((++sp & 255u) == 0u) { if (xb_ld(&bar[XB_TMO])) break; if (sp > XB_SPIN_CAP) { atomicAdd(&bar[XB_TMO], 1u); break; } }
    }
    nloc = mine > 0u ? mine : 1u; nx = cnt > 0u ? cnt : 1u;
}

__device__ __forceinline__ void xcd_barrier(const XcdBarrier& b) {
    asm volatile("s_waitcnt vmcnt(0)" ::: "memory");
    __syncthreads();
    if (threadIdx.x == 0) {
        unsigned* bar = b.bar;
        __builtin_amdgcn_s_waitcnt(0);
        unsigned nloc = b.st[0], nx = b.st[1];
        if (nloc == 0u) { xcd_barrier_complete(bar, b.x, nloc, nx); b.st[0] = nloc; b.st[1] = nx; }
        const unsigned old = xb_add(&bar[XB_XSUB(b.x)], 1u);
        const unsigned gen = old / nloc;
        if (old + 1u == (gen + 1u) * nloc) {
            __builtin_amdgcn_fence(__ATOMIC_RELEASE, "agent");
            asm volatile("s_waitcnt vmcnt(0)" ::: "memory");
            const unsigned og = xb_add(&bar[XB_TOP], 1u);
            const unsigned tg = og / nx;
            if (og + 1u == (tg + 1u) * nx) xb_add(&bar[XB_TOPGEN], 1u);
            else XB_SPIN(xb_ld(&bar[XB_TOPGEN]) == tg, bar);
            __builtin_amdgcn_fence(__ATOMIC_ACQUIRE, "agent");
            xb_add(&bar[XB_XGEN(b.x)], 1u);
            asm volatile("s_waitcnt vmcnt(0)" ::: "memory");
        } else {
            XB_SPIN(xb_ld(&bar[XB_XGEN(b.x)]) == gen, bar);
            __builtin_amdgcn_fence(__ATOMIC_ACQUIRE, "agent");
            asm volatile("s_waitcnt vmcnt(0)" ::: "memory");
        }
    }
    __syncthreads();
}
__device__ __forceinline__ float wave_sum(float v) {
#pragma unroll
    for (int o = 1; o < 64; o <<= 1) v += __shfl_xor(v, o);
    return v;
}
__device__ __forceinline__ void p0_transpose_item(const float* W, int K, int N, bf16* WT, int row_off, LAS float* scr, int item, int lane) {
    const int nblk = N / 32, kb = item / nblk, nb = item % nblk, k0 = 64 * kb, n0 = 32 * nb;
#pragma unroll 8
    for (int i = 0; i < 32; ++i) { const int kk = 2 * i + (lane >> 5); scr[kk * 33 + (lane & 31)] = W[(size_t)(k0 + kk) * N + n0 + (lane & 31)]; }
    LDS_WAIT(); asm volatile("" ::: "memory");
    const int c = lane & 7;
#pragma unroll
    for (int j = 0; j < 4; ++j) { const int n = (lane >> 3) + 8 * j; const LAS float* s = scr + (8 * c) * 33 + n;
        v4u o; o.x = pk2(s[0 * 33], s[1 * 33]); o.y = pk2(s[2 * 33], s[3 * 33]); o.z = pk2(s[4 * 33], s[5 * 33]); o.w = pk2(s[6 * 33], s[7 * 33]);
        *(GAS v4u*)(WT + (size_t)(row_off + n0 + n) * K + k0 + 8 * c) = o; }
    LDS_WAIT(); asm volatile("" ::: "memory");
}
namespace cg = cooperative_groups;
constexpr int NWAVES = 8;
constexpr int BATCH = 4, SEQ = 4096, D = 1024, T = BATCH * SEQ, DEPTH = 2, INCOLS = 5120, NEXP = 16384;
constexpr float NORM_EPS = 1e-6f;
constexpr size_t MiB = 1u << 20;
constexpr size_t WS_CTL = 0, CTL_ZERO_BYTES = 1 * MiB;
constexpr size_t WS_MOD = 1 * MiB;
constexpr size_t WS_ROPE = WS_MOD + 256 * 1024;
constexpr size_t WS_SUBK = 2 * MiB;
constexpr size_t WS_WIN = 4 * MiB;
constexpr size_t WS_WSB = 24 * MiB;
constexpr size_t WS_WDF = 26 * MiB;
constexpr size_t WS_WOUT = 28 * MiB;
constexpr size_t WS_WQ = 32 * MiB;
constexpr size_t WS_U8 = 40 * MiB, WS_V8 = 56 * MiB;
constexpr size_t WS_H = 104 * MiB;
constexpr size_t WS_SBQ = 136 * MiB, WS_SBK = 152 * MiB, WS_SBV = 168 * MiB, WS_SBVT = 184 * MiB, WS_DQ = 200 * MiB, WS_DK = 216 * MiB, WS_DV = 232 * MiB;
constexpr size_t WS_GSB = 248 * MiB, WS_GDF = 280 * MiB;
constexpr size_t WS_YSB = 312 * MiB, WS_YDF = 328 * MiB;
constexpr size_t WS_M1 = WS_SBQ, WS_MRG = WS_DQ;
constexpr size_t WS_QP = WS_GSB;
constexpr size_t WS_EIDX = WS_SBV, WS_EGATE = WS_SBV + 8 * MiB;
constexpr size_t WS_XA = 344 * MiB, WS_XB = 408 * MiB, WS_END = 472 * MiB;
constexpr size_t WS_APART = 200 * MiB;
constexpr int CW_BAR = 4096, CW_RANK = 8192;
static_assert(WS_ROPE == pg8::EPI_WS_ROPE && WS_SBQ == pg8::EPI_WS_SBQ && WS_SBK == pg8::EPI_WS_SBK && WS_SBV == pg8::EPI_WS_SBV && WS_SBVT == pg8::EPI_WS_SBVT && WS_DQ == pg8::EPI_WS_DQ && WS_DK == pg8::EPI_WS_DK && WS_DV == pg8::EPI_WS_DV && WS_GSB == pg8::EPI_WS_GSB && WS_GDF == pg8::EPI_WS_GDF, "epilogue offsets");
constexpr int RING_OFF = 0, RING_BYTES = 131072;
constexpr int LDSCTL_OFF = RING_BYTES, MISC_OFF = LDSCTL_OFF + 320;
constexpr int LDS_BYTES = 147456;

struct Frame { LAS unsigned char* lds; volatile LAS unsigned* MISC; int tid, lane, wave, vcu, G; };
struct Args { const float* in[18]; float* out; unsigned char* ws; };

__device__ __forceinline__ unsigned short f2bf_s(float f) { return (unsigned short)f2bf(f); }
__device__ __forceinline__ float bf_lo(unsigned w) { return __uint_as_float(w << 16); }
__device__ __forceinline__ float bf_hi(unsigned w) { return __uint_as_float(w & 0xffff0000u); }
typedef __bf16 bf2_t __attribute__((ext_vector_type(2)));
__device__ __forceinline__ float dot2bf(unsigned a, unsigned b, float c) { return __builtin_amdgcn_fdot2_f32_bf16(__builtin_bit_cast(bf2_t, a), __builtin_bit_cast(bf2_t, b), c, false); }

__device__ __forceinline__ void p0_prologue(Frame& F, const Args& A) {
    unsigned char* ws = A.ws;
    LAS float* scr = (LAS float*)(F.lds + RING_OFF + F.wave * 16384);
    const int gw = F.vcu * NWAVES + F.wave, NGW = F.G * NWAVES;
    constexpr int I_IN = (D / 64) * (INCOLS / 32), I_B = (512 / 64) * (D / 32), I_O = (D / 64) * (D / 32), I_Q = (D / 64) * (2048 / 32), IL = I_IN + 2 * I_B + I_O + I_Q;
    for (int it = gw; it < DEPTH * IL; it += NGW) {
        const int l = it / IL; int r = it % IL;
        if (r < I_IN) { p0_transpose_item(A.in[6] + (size_t)l * D * INCOLS, D, INCOLS, (bf16*)(ws + WS_WIN) + (size_t)l * INCOLS * D, 0, scr, r, F.lane); continue; } r -= I_IN;
        if (r < I_B) { p0_transpose_item(A.in[10] + (size_t)l * 512 * D, 512, D, (bf16*)(ws + WS_WSB) + (size_t)l * D * 512, 0, scr, r, F.lane); continue; } r -= I_B;
        if (r < I_B) { p0_transpose_item(A.in[11] + (size_t)l * 512 * D, 512, D, (bf16*)(ws + WS_WDF) + (size_t)l * D * 512, 0, scr, r, F.lane); continue; } r -= I_B;
        if (r < I_O) { p0_transpose_item(A.in[12] + (size_t)l * D * D, D, D, (bf16*)(ws + WS_WOUT) + (size_t)l * D * D, 0, scr, r, F.lane); continue; } r -= I_O;
        p0_transpose_item(A.in[13] + (size_t)l * D * 2048, D, 2048, (bf16*)(ws + WS_WQ) + (size_t)l * 2048 * D, 0, scr, r, F.lane);
    }
    { const int gt = F.vcu * 512 + F.tid, NT = F.G * 512; const float* s = A.in[14]; bf16* o = (bf16*)(ws + WS_SUBK);
      for (int i = gt; i < (DEPTH * 8 * 2 * 128 * 128) / 8; i += NT) { const f32x4 a = *(const f32x4*)(s + (size_t)i * 8), b = *(const f32x4*)(s + (size_t)i * 8 + 4);
          v4u w; w.x = pk2(a.x, a.y); w.y = pk2(a.z, a.w); w.z = pk2(b.x, b.y); w.w = pk2(b.z, b.w); *(v4u*)(o + (size_t)i * 8) = w; } }
    { const int gt = F.vcu * 512 + F.tid, NT = F.G * 512; float* rc = (float*)(ws + WS_ROPE); float* rs = rc + 4096 * 8;
      for (int i = gt; i < 4096 * 8; i += NT) { const int pos = i >> 3, f = i & 7; const float inv = 1.0f / powf(500000.0f, (float)(2 * f) / 16.0f); const float ang = (float)pos * inv; rc[i] = cosf(ang); rs[i] = sinf(ang); } }
    __syncthreads();
    { LAS float* sc = (LAS float*)(F.lds);
      LAS float* red = (LAS float*)(F.lds + 16384);
      for (int i = F.tid; i < 4 * 1024; i += 512) { const float v = A.in[1][i]; sc[i] = v / (1.0f + expf(-v)); }
      __syncthreads();
      for (int j = F.vcu; j < 256; j += F.G) {
          const int cgi = F.tid % 12, ks = F.tid / 12;
          const int g = j * 12 + cgi; const int l = g / 1536, n0 = (g % 1536) * 4;
          f32x4 acc[4]; acc[0] = acc[1] = acc[2] = acc[3] = (f32x4){0.f, 0.f, 0.f, 0.f};
          if (ks < 42) { const float* w = A.in[4] + (size_t)l * D * 6144 + n0;
              for (int k = ks; k < 1024; k += 42) { const f32x4 wv = *(const f32x4*)(w + (size_t)k * 6144);
#pragma unroll
                  for (int b = 0; b < 4; ++b) acc[b] = acc[b] + wv * sc[b * 1024 + k]; }
#pragma unroll
              for (int b = 0; b < 4; ++b)
#pragma unroll
                  for (int e = 0; e < 4; ++e) red[((ks * 12 + cgi) * 4 + b) * 4 + e] = acc[b][e]; }
          __syncthreads();
          if (F.tid < 192) { const int cg2 = F.tid / 16, b = (F.tid / 4) & 3, e = F.tid & 3; float s = 0.f;
              for (int k2 = 0; k2 < 42; ++k2) s += red[((k2 * 12 + cg2) * 4 + b) * 4 + e];
              const int g2 = j * 12 + cg2; const int l2 = g2 / 1536, n2 = (g2 % 1536) * 4 + e;
              ((float*)(ws + WS_MOD))[((size_t)l2 * 4 + b) * 6144 + n2] = s + A.in[5][(size_t)l2 * 6144 + n2]; }
          __syncthreads();
      } }
}
__device__ __forceinline__ void cvt_table8(Frame& F, const float* s, unsigned char* o, float scale) {
    const int gt = F.vcu * 512 + F.tid, NT = F.G * 512;
    for (int i = gt; i < NEXP * 64; i += NT) { const int e = i >> 6, r = (i >> 3) & 7, sub = i & 7; const float* p = s + (size_t)i * 16;
        const f32x4 a = *(const f32x4*)p * scale, b = *(const f32x4*)(p + 4) * scale, c = *(const f32x4*)(p + 8) * scale, d = *(const f32x4*)(p + 12) * scale;
        v4u w; int t;
        t = __builtin_amdgcn_cvt_pk_fp8_f32(a.x, a.y, 0, false); t = __builtin_amdgcn_cvt_pk_fp8_f32(a.z, a.w, t, true); w.x = (unsigned)t;
        t = __builtin_amdgcn_cvt_pk_fp8_f32(b.x, b.y, 0, false); t = __builtin_amdgcn_cvt_pk_fp8_f32(b.z, b.w, t, true); w.y = (unsigned)t;
        t = __builtin_amdgcn_cvt_pk_fp8_f32(c.x, c.y, 0, false); t = __builtin_amdgcn_cvt_pk_fp8_f32(c.z, c.w, t, true); w.z = (unsigned)t;
        t = __builtin_amdgcn_cvt_pk_fp8_f32(d.x, d.y, 0, false); t = __builtin_amdgcn_cvt_pk_fp8_f32(d.z, d.w, t, true); w.w = (unsigned)t;
        *(v4u*)(o + ((size_t)r * NEXP + e) * 128 + sub * 16) = w; }
}
__device__ __forceinline__ void hnorm_phase(Frame& F, const float* x, const float* g, const float* shift, const float* scale  , bf16* H) {
    const int gw = F.vcu * NWAVES + F.wave, NGW = F.G * NWAVES;
    for (int m = gw; m < T; m += NGW) { const int b = m >> 12;
        const f32x4* xr = (const f32x4*)(x + (size_t)m * D) + F.lane; f32x4 v[4]; float s = 0.f;
#pragma unroll
        for (int j = 0; j < 4; ++j) { v[j] = xr[64 * j]; s += (v[j].x * v[j].x + v[j].y * v[j].y) + (v[j].z * v[j].z + v[j].w * v[j].w); }
        const float r = 1.0f / sqrtf(wave_sum(s) * (1.0f / D) + NORM_EPS);
        unsigned long long* o8 = (unsigned long long*)(H + (size_t)m * D) + F.lane;
#pragma unroll
        for (int j = 0; j < 4; ++j) { const int c = 4 * F.lane + 256 * j; const f32x4 gg = *(const f32x4*)(g + c), sh = *(const f32x4*)(shift + (size_t)b * 6144 + c), sc = *(const f32x4*)(scale + (size_t)b * 6144 + c);
            const f32x4 h = (v[j] * r) * gg * (sc + 1.0f) + sh;
            o8[64 * j] = (unsigned long long)pk2(h.x, h.y) | ((unsigned long long)pk2(h.z, h.w) << 32); }
    }
}
#ifndef SB_CUT
#define SB_CUT (-110.0f)
#endif
__device__ __forceinline__ void sb_scalar_phase(Frame& F, const bf16* SBQ, const bf16* SBK, const bf16* SBV, bf16* YSB) {
    for (int u = F.vcu; u < 256; u += F.G) {
        const int bh = u >> 3, chunk = u & 7, b = bh >> 3, h = bh & 7, t = chunk * 512 + F.tid;
        const size_t rowq = (size_t)(b * SEQ + t) * 512 + h * 64;
        float q[64], o[64];
#pragma unroll
        for (int i = 0; i < 8; ++i) { const v4u w = *(const v4u*)(SBQ + rowq + i * 8); q[8 * i] = bf_lo(w.x); q[8 * i + 1] = bf_hi(w.x); q[8 * i + 2] = bf_lo(w.y); q[8 * i + 3] = bf_hi(w.y); q[8 * i + 4] = bf_lo(w.z); q[8 * i + 5] = bf_hi(w.z); q[8 * i + 6] = bf_lo(w.w); q[8 * i + 7] = bf_hi(w.w); }
#pragma unroll
        for (int i = 0; i < 64; ++i) o[i] = 0.f;
        float c = 0.f;
        for (int it = 0;; ++it) { const int s = t - 1 - it; const bool act = (s >= 0) && (c > SB_CUT);
            if (!__any(act)) break;
            if (act) { const size_t rowk = (size_t)(b * SEQ + s) * 512 + h * 64; float z0 = 0.f, z1 = 0.f;
#pragma unroll
                for (int i = 0; i < 8; ++i) { const v4u w = *(const v4u*)(SBK + rowk + i * 8);
                    z0 += q[8 * i] * bf_lo(w.x) + q[8 * i + 2] * bf_lo(w.y) + q[8 * i + 4] * bf_lo(w.z) + q[8 * i + 6] * bf_lo(w.w);
                    z1 += q[8 * i + 1] * bf_hi(w.x) + q[8 * i + 3] * bf_hi(w.y) + q[8 * i + 5] * bf_hi(w.z) + q[8 * i + 7] * bf_hi(w.w); }
                const float z = z0 + z1;
                const float lf = -(fmaxf(z, 0.f) + log1pf(expf(-fabsf(z))));
                const float wgt = expf(z + lf + c); c += lf;
#pragma unroll
                for (int i = 0; i < 8; ++i) { const v4u w = *(const v4u*)(SBV + rowk + i * 8);
                    o[8 * i] += wgt * bf_lo(w.x); o[8 * i + 1] += wgt * bf_hi(w.x); o[8 * i + 2] += wgt * bf_lo(w.y); o[8 * i + 3] += wgt * bf_hi(w.y);
                    o[8 * i + 4] += wgt * bf_lo(w.z); o[8 * i + 5] += wgt * bf_hi(w.z); o[8 * i + 6] += wgt * bf_lo(w.w); o[8 * i + 7] += wgt * bf_hi(w.w); } } }
#pragma unroll
        for (int i = 0; i < 8; ++i) { v4u w; w.x = pk2(o[8 * i], o[8 * i + 1]); w.y = pk2(o[8 * i + 2], o[8 * i + 3]); w.z = pk2(o[8 * i + 4], o[8 * i + 5]); w.w = pk2(o[8 * i + 6], o[8 * i + 7]); *(v4u*)(YSB + rowq + i * 8) = w; }
    }
}
typedef float f32x16_ __attribute__((ext_vector_type(16)));
typedef unsigned u32x2_ __attribute__((ext_vector_type(2)));
__device__ __forceinline__ unsigned cvtpk_bf16(float lo, float hi) { typedef float f2_ __attribute__((ext_vector_type(2))); typedef __bf16 b2_ __attribute__((ext_vector_type(2))); f2_ v = {lo, hi}; b2_ b = __builtin_convertvector(v, b2_); return __builtin_bit_cast(unsigned, b); }
__device__ __forceinline__ void sb_mfma_phase(Frame& F, const bf16* SBQ, const bf16* SBK, const bf16* SBVT, bf16* YSB) {
    const int lane = F.lane, r32 = lane & 31, hi = lane >> 5;
    const float L2E = 1.4426950408889634f, LN2 = 0.6931471805599453f;
    for (int u = F.vcu; u < 512; u += F.G) {
        const int bh = u >> 4, chunk = u & 15, b = bh >> 3, h = bh & 7, q0 = chunk * 256 + F.wave * 32;
        bf16x8 qf[4];
#pragma unroll
        for (int d0 = 0; d0 < 4; ++d0) qf[d0] = *(const bf16x8*)(SBQ + (size_t)(b * SEQ + q0 + r32) * 512 + h * 64 + d0 * 16 + hi * 8);
        f32x16_ o0 = {}, o1 = {}; float c = 0.f; const int qg = q0 + r32;
        for (int jt = q0 >> 6; jt >= 0; --jt) {
            const int kv0 = jt * 64;
            const bf16* kp = SBK + (size_t)(b * SEQ + kv0 + r32) * 512 + h * 64 + hi * 8;
            f32x16_ p0 = {}, p1 = {};
#pragma unroll
            for (int d0 = 0; d0 < 4; ++d0) { const bf16x8 k0 = *(const bf16x8*)(kp + d0 * 16), k1 = *(const bf16x8*)(kp + 32 * 512 + d0 * 16);
                p0 = __builtin_amdgcn_mfma_f32_32x32x16_bf16(k0, qf[d0], p0, 0, 0, 0); p1 = __builtin_amdgcn_mfma_f32_32x32x16_bf16(k1, qf[d0], p1, 0, 0, 0); }
            u32x2_ vf[4][2][2];
            { const bf16* vp = SBVT + (size_t)(h * 64 + r32) * 16384 + b * 4096 + kv0 + 4 * hi;
#pragma unroll
              for (int s = 0; s < 4; ++s)
#pragma unroll
                  for (int db = 0; db < 2; ++db) { vf[s][db][0] = *(const u32x2_*)(vp + (size_t)db * 32 * 16384 + 16 * s); vf[s][db][1] = *(const u32x2_*)(vp + (size_t)db * 32 * 16384 + 16 * s + 8); } }
            const bool diag = (kv0 + 63 >= q0);
            float z[32], sfx[32];
#pragma unroll
            for (int r = 0; r < 16; ++r) { z[r] = p0[r]; z[16 + r] = p1[r]; }
            if (diag) {
#pragma unroll
                for (int r = 0; r < 32; ++r) { const int kv = kv0 + (r & 3) + 8 * ((r & 15) >> 2) + 4 * hi + 32 * (r >> 4); if (kv >= qg) z[r] = -1.0e30f; } }
#pragma unroll
            for (int r = 0; r < 32; ++r) { const float e = __builtin_amdgcn_exp2f(-__builtin_fabsf(z[r]) * L2E); sfx[r] = -(__builtin_fmaxf(z[r], 0.f) + __builtin_amdgcn_logf(1.0f + e) * LN2); }
            float gs[8], pg[8];
#pragma unroll
            for (int k = 0; k < 8; ++k) { sfx[4 * k + 2] += sfx[4 * k + 3]; sfx[4 * k + 1] += sfx[4 * k + 2]; sfx[4 * k] += sfx[4 * k + 1]; gs[k] = sfx[4 * k]; }
#pragma unroll
            for (int k = 0; k < 8; ++k) pg[k] = __shfl_xor(gs[k], 32);
            float tail = 0.f;
#pragma unroll
            for (int k = 7; k >= 0; --k) { const float off = tail + (hi == 0 ? pg[k] : 0.f); tail += gs[k] + pg[k];
                sfx[4 * k] += off; sfx[4 * k + 1] += off; sfx[4 * k + 2] += off; sfx[4 * k + 3] += off; }
            unsigned pw[16];
#pragma unroll
            for (int r = 0; r < 32; r += 2) { const float w0 = __builtin_amdgcn_exp2f((z[r] + sfx[r] + c) * L2E), w1 = __builtin_amdgcn_exp2f((z[r + 1] + sfx[r + 1] + c) * L2E); pw[r >> 1] = cvtpk_bf16(w0, w1); }
            c += tail;
#pragma unroll
            for (int s = 0; s < 4; ++s) { const v4u pa = {pw[4 * s], pw[4 * s + 1], pw[4 * s + 2], pw[4 * s + 3]};
                const v4u b0 = {vf[s][0][0].x, vf[s][0][0].y, vf[s][0][1].x, vf[s][0][1].y}, b1 = {vf[s][1][0].x, vf[s][1][0].y, vf[s][1][1].x, vf[s][1][1].y};
                o0 = __builtin_amdgcn_mfma_f32_32x32x16_bf16(__builtin_bit_cast(bf16x8, pa), __builtin_bit_cast(bf16x8, b0), o0, 0, 0, 0);
                o1 = __builtin_amdgcn_mfma_f32_32x32x16_bf16(__builtin_bit_cast(bf16x8, pa), __builtin_bit_cast(bf16x8, b1), o1, 0, 0, 0); }
            if (__all(c < SB_CUT)) break;
        }
        bf16* yo = YSB + (size_t)(b * SEQ + q0) * 512 + h * 64 + r32;
#pragma unroll
        for (int r = 0; r < 16; ++r) { const int qr = (r & 3) + 8 * (r >> 2) + 4 * hi; yo[(size_t)qr * 512] = f2bf_s(o0[r]); yo[(size_t)qr * 512 + 32] = f2bf_s(o1[r]); }
    }
}
__device__ __forceinline__ void diffcombine_phase(Frame& F, const bf16* O0, const bf16* O1, const float* lamp  , const float* subg  , float lam_init, bf16* YDF) {
    const int gw = F.vcu * NWAVES + F.wave, NGW = F.G * NWAVES;
    const float s1 = wave_sum(lamp[F.lane] * lamp[64 + F.lane]), s2 = wave_sum(lamp[128 + F.lane] * lamp[192 + F.lane]);
    const float lam = expf(s1) - expf(s2) + lam_init;
    const int dd = (8 * F.lane) & 127; const f32x4 g0 = *(const f32x4*)(subg + dd), g1 = *(const f32x4*)(subg + dd + 4);
    for (int m = gw; m < T; m += NGW) {
        const v4u a = *(const v4u*)(O0 + (size_t)m * 512 + 8 * F.lane), bq = *(const v4u*)(O1 + (size_t)m * 512 + 8 * F.lane);
        float y[8]; y[0] = bf_lo(a.x) - lam * bf_lo(bq.x); y[1] = bf_hi(a.x) - lam * bf_hi(bq.x); y[2] = bf_lo(a.y) - lam * bf_lo(bq.y); y[3] = bf_hi(a.y) - lam * bf_hi(bq.y);
        y[4] = bf_lo(a.z) - lam * bf_lo(bq.z); y[5] = bf_hi(a.z) - lam * bf_hi(bq.z); y[6] = bf_lo(a.w) - lam * bf_lo(bq.w); y[7] = bf_hi(a.w) - lam * bf_hi(bq.w);
        float ss = 0.f;
#pragma unroll
        for (int j = 0; j < 8; ++j) ss += y[j] * y[j];
        ss += __shfl_xor(ss, 1); ss += __shfl_xor(ss, 2); ss += __shfl_xor(ss, 4); ss += __shfl_xor(ss, 8);
        const float rn = (1.0f / sqrtf(ss * (1.0f / 128.0f) + NORM_EPS)) * (1.0f - lam_init);
        v4u w; w.x = pk2(y[0] * rn * g0.x, y[1] * rn * g0.y); w.y = pk2(y[2] * rn * g0.z, y[3] * rn * g0.w); w.z = pk2(y[4] * rn * g1.x, y[5] * rn * g1.y); w.w = pk2(y[6] * rn * g1.z, y[7] * rn * g1.w);
        *(v4u*)(YDF + (size_t)m * 512 + 8 * F.lane) = w;
    }
}
__device__ __forceinline__ void topk_phase(Frame& F, const bf16* QP, const bf16* SUBK  , int* EIDX, float* EGATE) {
    LAS unsigned char* kl = F.lds;
    for (int u = F.vcu; u < 256; u += F.G) {
        const int h = u & 7, chunk = u >> 3, t = chunk * 512 + F.tid;
        __syncthreads();
        { const v4u* src = (const v4u*)(SUBK + (size_t)h * 2 * 128 * 128);
          for (int i = F.tid; i < 4096; i += 512) *(LAS v4u*)(kl + (size_t)i * 16) = src[i]; }
        __syncthreads();
        float lst[2][16];
#pragma unroll
        for (int c = 0; c < 2; ++c) {
            unsigned q[64];
            { const v4u* qs = (const v4u*)(QP + (size_t)t * 2048 + h * 256 + c * 128);
#pragma unroll
              for (int i = 0; i < 16; ++i) { const v4u w = qs[i]; q[4 * i] = w.x; q[4 * i + 1] = w.y; q[4 * i + 2] = w.z; q[4 * i + 3] = w.w; } }
#pragma unroll
            for (int k = 0; k < 16; ++k) lst[c][k] = -3.0e38f;
            for (int n = 0; n < 128; ++n) {
                const LAS v4u* kr = (const LAS v4u*)(kl + (size_t)(c * 128 + n) * 256);
                float s0 = 0.f, s1 = 0.f;
#pragma unroll
                for (int i = 0; i < 16; ++i) { const v4u kk = kr[i]; s0 = dot2bf(q[4 * i], kk.x, s0); s1 = dot2bf(q[4 * i + 1], kk.y, s1); s0 = dot2bf(q[4 * i + 2], kk.z, s0); s1 = dot2bf(q[4 * i + 3], kk.w, s1); }
                float v = __uint_as_float((__float_as_uint(s0 + s1) & ~127u) | (unsigned)n);
#pragma unroll
                for (int k = 0; k < 16; ++k) { const float hi = fmaxf(lst[c][k], v), lo = fminf(lst[c][k], v); lst[c][k] = hi; v = lo; }
            }
        }
        float bv[16];
#pragma unroll
        for (int k = 0; k < 16; ++k) bv[k] = -3.0e38f;
#pragma unroll
        for (int i = 0; i < 16; ++i)
#pragma unroll
            for (int j = 0; j < 16; ++j) if ((i + 1) * (j + 1) <= 16) {
                const unsigned a = __float_as_uint(lst[0][i]), b = __float_as_uint(lst[1][j]);
                float v = __uint_as_float((__float_as_uint(__uint_as_float(a & ~127u) + __uint_as_float(b & ~127u)) & ~255u) | (unsigned)(i * 16 + j));
#pragma unroll
                for (int k = 0; k < 16; ++k) { const float hi = fmaxf(bv[k], v), lo = fminf(bv[k], v); bv[k] = hi; v = lo; }
            }
        unsigned w0[4], w1[4];
#pragma unroll
        for (int k = 0; k < 4; ++k) { w0[k] = 0u; w1[k] = 0u;
#pragma unroll
            for (int b = 0; b < 4; ++b) { w0[k] |= (__float_as_uint(lst[0][4 * k + b]) & 127u) << (8 * b); w1[k] |= (__float_as_uint(lst[1][4 * k + b]) & 127u) << (8 * b); } }
        float e[16], sum = 0.f; int bp[16];
        const float vmax = __uint_as_float(__float_as_uint(bv[0]) & ~255u);
#pragma unroll
        for (int k = 0; k < 16; ++k) { const unsigned bits = __float_as_uint(bv[k]); const unsigned id = bits & 255u, ii = id >> 4, jj = id & 15u;
            const unsigned s0 = (ii >> 2) == 0 ? w0[0] : (ii >> 2) == 1 ? w0[1] : (ii >> 2) == 2 ? w0[2] : w0[3];
            const unsigned s1 = (jj >> 2) == 0 ? w1[0] : (jj >> 2) == 1 ? w1[1] : (jj >> 2) == 2 ? w1[2] : w1[3];
            bp[k] = (int)((((s0 >> (8 * (ii & 3))) & 127u) << 7) | ((s1 >> (8 * (jj & 3))) & 127u));
            e[k] = expf(__uint_as_float(bits & ~255u) - vmax); sum += e[k]; }
        const float inv = 1.0f / sum;
        int* ei = EIDX + (size_t)t * 128 + h * 16; float* eg = EGATE + (size_t)t * 128 + h * 16;
#pragma unroll
        for (int k = 0; k < 16; k += 4) { *(int4*)(ei + k) = make_int4(bp[k], bp[k + 1], bp[k + 2], bp[k + 3]); *(f32x4*)(eg + k) = (f32x4){e[k] * inv, e[k + 1] * inv, e[k + 2] * inv, e[k + 3] * inv}; }
    }
    __syncthreads();
}
struct XInfo { int k, nloc, nx, xi; };
__device__ __forceinline__ float dpp_add8(float s) {
    s += __builtin_bit_cast(float, __builtin_amdgcn_update_dpp(0, __builtin_bit_cast(int, s), 0xB1, 0xF, 0xF, true));
    s += __builtin_bit_cast(float, __builtin_amdgcn_update_dpp(0, __builtin_bit_cast(int, s), 0x4E, 0xF, 0xF, true));
    s += __builtin_bit_cast(float, __builtin_amdgcn_update_dpp(0, __builtin_bit_cast(int, s), 0x141, 0xF, 0xF, true));
    return s; }
typedef float f32x2_ __attribute__((ext_vector_type(2)));
__device__ __forceinline__ void peerA_phase(Frame& F, const XInfo X, const bf16* H2, const int* EIDX, const unsigned char* U8, float* APART) {
    const int sub = F.lane & 7, slot = F.lane >> 3;
    for (int r = X.xi; r < 8; r += X.nx) {
        const unsigned char* Ur = U8 + (size_t)r * NEXP * 128 + sub * 16; float* Ar = APART + (size_t)r * T * 128;
        for (int t = X.k * NWAVES + F.wave; t < T; t += X.nloc * NWAVES) {
            const v4u h0 = *(const v4u*)(H2 + (size_t)t * D + 128 * r + 16 * sub), h1 = *(const v4u*)(H2 + (size_t)t * D + 128 * r + 16 * sub + 8);
            int e[16]; v4u w[16];
#pragma unroll
            for (int i = 0; i < 16; ++i) e[i] = EIDX[(size_t)t * 128 + 8 * i + slot];
#pragma unroll
            for (int i = 0; i < 16; ++i) w[i] = *(const v4u*)(Ur + (size_t)e[i] * 128);
            const float hf[16] = {bf_lo(h0.x), bf_hi(h0.x), bf_lo(h0.y), bf_hi(h0.y), bf_lo(h0.z), bf_hi(h0.z), bf_lo(h0.w), bf_hi(h0.w), bf_lo(h1.x), bf_hi(h1.x), bf_lo(h1.y), bf_hi(h1.y), bf_lo(h1.z), bf_hi(h1.z), bf_lo(h1.w), bf_hi(h1.w)};
#pragma unroll
            for (int i = 0; i < 16; ++i) { float p = 0.f, q = 0.f;
#pragma unroll
                for (int c = 0; c < 4; ++c) { const int wd = (int)w[i][c]; const f32x2_ lo = __builtin_amdgcn_cvt_pk_f32_fp8(wd, false), hi = __builtin_amdgcn_cvt_pk_f32_fp8(wd, true);
                    p += hf[4 * c] * lo.x + hf[4 * c + 2] * hi.x; q += hf[4 * c + 1] * lo.y + hf[4 * c + 3] * hi.y; }
                const float s = dpp_add8(p + q);
                if (sub == 0) Ar[(size_t)t * 128 + 8 * i + slot] = s; }
        }
    }
}
__device__ __forceinline__ void peerAct_phase(Frame& F, const float* APART, float* EGATE) {
    const int gt = F.vcu * 512 + F.tid, NT = F.G * 512;
    for (int i = gt; i < T * 128 / 4; i += NT) { f32x4 a = *(const f32x4*)(APART + (size_t)i * 4);
#pragma unroll
        for (int r = 1; r < 8; ++r) a = a + *(const f32x4*)(APART + (size_t)r * T * 128 + (size_t)i * 4);
        a = a * (1.0f / 32.0f); const f32x4 g = *(const f32x4*)(EGATE + (size_t)i * 4); f32x4 o;
#pragma unroll
        for (int j = 0; j < 4; ++j) o[j] = 0.5f * a[j] * (1.0f + erff(a[j] * 0.70710678118654752f)) * g[j];
        *(f32x4*)(EGATE + (size_t)i * 4) = o; }
}
__device__ __forceinline__ void peerB_phase(Frame& F, const XInfo X, const float* ACT, const int* EIDX, const unsigned char* V8, const float* x1, const float* gate2  , float* xout) {
    const int sub = F.lane & 7, slot = F.lane >> 3;
    for (int r = X.xi; r < 8; r += X.nx) {
        const unsigned char* Vr = V8 + (size_t)r * NEXP * 128 + sub * 16;
        for (int t = X.k * NWAVES + F.wave; t < T; t += X.nloc * NWAVES) {
            int e[16]; float a[16]; v4u w[16];
#pragma unroll
            for (int i = 0; i < 16; ++i) { e[i] = EIDX[(size_t)t * 128 + 8 * i + slot]; a[i] = ACT[(size_t)t * 128 + 8 * i + slot]; }
#pragma unroll
            for (int i = 0; i < 16; ++i) w[i] = *(const v4u*)(Vr + (size_t)e[i] * 128);
            float acc[16];
#pragma unroll
            for (int j = 0; j < 16; ++j) acc[j] = 0.f;
#pragma unroll
            for (int i = 0; i < 16; ++i)
#pragma unroll
                for (int c = 0; c < 4; ++c) { const int wd = (int)w[i][c]; const f32x2_ lo = __builtin_amdgcn_cvt_pk_f32_fp8(wd, false), hi = __builtin_amdgcn_cvt_pk_f32_fp8(wd, true);
                    acc[4 * c] += a[i] * lo.x; acc[4 * c + 1] += a[i] * lo.y; acc[4 * c + 2] += a[i] * hi.x; acc[4 * c + 3] += a[i] * hi.y; }
#pragma unroll
            for (int j = 0; j < 16; ++j) { float s = acc[j]; s += __shfl_xor(s, 8); s += __shfl_xor(s, 16); s += __shfl_xor(s, 32); acc[j] = s; }
            if (slot == 0) { const int b = t >> 12; const size_t off = (size_t)t * D + 128 * r + 16 * sub; const float* gr = gate2 + (size_t)b * 6144 + 128 * r + 16 * sub;
#pragma unroll
                for (int j = 0; j < 4; ++j) { const f32x4 xv = *(const f32x4*)(x1 + off + 4 * j), gv = *(const f32x4*)(gr + 4 * j);
                    *(f32x4*)(xout + off + 4 * j) = xv + gv * (f32x4){acc[4 * j], acc[4 * j + 1], acc[4 * j + 2], acc[4 * j + 3]}; } }
        }
    }
}
__device__ __forceinline__ void finalnorm_phase(Frame& F, const float* x, const float* g, float* out, const unsigned char* ws) {
    const int gw = F.vcu * NWAVES + F.wave, NGW = F.G * NWAVES;
    for (int m = gw; m < T; m += NGW) {
        const f32x4* xr = (const f32x4*)(x + (size_t)m * D) + F.lane; f32x4 v[4]; float s = 0.f;
#pragma unroll
        for (int j = 0; j < 4; ++j) { v[j] = xr[64 * j]; s += (v[j].x * v[j].x + v[j].y * v[j].y) + (v[j].z * v[j].z + v[j].w * v[j].w); }
        float r = 1.0f / sqrtf(wave_sum(s) * (1.0f / D) + NORM_EPS);
#ifdef TIMING_SEL
        r *= 1.0f + TIMING_GAIN * *(const float*)(ws + 65536);
#endif
        f32x4* o = (f32x4*)(out + (size_t)m * D) + F.lane;
#pragma unroll
        for (int j = 0; j < 4; ++j) o[64 * j] = (v[j] * r) * *(const f32x4*)(g + 4 * F.lane + 256 * j);
    }
}
#define WSP(T_, off) ((T_*)(ws + (off)))
#define RETID() do { int t_ = threadIdx.x; asm volatile("" : "+v"(t_)); F.tid = t_; F.lane = t_ & 63; F.wave = __builtin_amdgcn_readfirstlane(t_ >> 6); } while (0)
#define GRID_BAR() xcd_barrier(bar)
#ifdef TIMING_SEL
#define STAMP(id) do { if (blockIdx.x == 0 && threadIdx.x == 0) { const unsigned now_ = (unsigned)__builtin_amdgcn_s_memrealtime(); if ((TIMING_SEL >> (id)) & 1) F.MISC[17] = F.MISC[17] + (now_ - F.MISC[16]); F.MISC[16] = now_; } } while (0)
#else
#define STAMP(id) do { } while (0)
#endif
template <int l> __device__ __forceinline__ void layer_program(Frame& F, const Args& args, unsigned char* ws, const XcdBarrier& bar, unsigned char* lds) {
        const float* mod = WSP(const float, WS_MOD) + (size_t)l * 4 * 6144;
#ifndef NO_P1
        RETID();
        hnorm_phase(F, (l == 0) ? args.in[0] : WSP(const float, WS_XB), args.in[2] + (size_t)l * D, mod + 0, mod + 1024, WSP(bf16, WS_H));
        cvt_table8(F, args.in[15] + (size_t)l * NEXP * D, WSP(unsigned char, WS_U8), 32.0f);
        cvt_table8(F, args.in[16] + (size_t)l * NEXP * D, WSP(unsigned char, WS_V8), 1.0f);
#endif
        GRID_BAR(); STAMP(1);
#ifndef NO_P2
        { pg8::Gemm g{WSP(const bf16, WS_H), WSP(const bf16, WS_WIN) + (size_t)l * INCOLS * D, T, INCOLS, D}; pg8::StaticOrder S; S.init(T, INCOLS, F.G, (int)blockIdx.x);
          pg8::EpiIn E{ws, args.in[7] + (size_t)l * 2048};
          pg8::gemm_phase<pg8::EpiIn, pg8::StaticOrder, PG8_ALIGN, PG8_SP2>(F.lds + RING_OFF, g, S, E); }
#ifndef SB_SCALAR
        { pg8::Gemm g{WSP(const bf16, WS_WIN) + (size_t)l * INCOLS * D + (size_t)1024 * D, WSP(const bf16, WS_H), 512, T, D}; pg8::StaticOrder S; S.init(512, T, F.G, (int)blockIdx.x);
          pg8::EpiBf16<0> E{WSP(bf16, WS_SBVT), T, nullptr, 0, 0, 1.f};
          pg8::gemm_phase<pg8::EpiBf16<0>, pg8::StaticOrder, PG8_ALIGN, PG8_SP2>(F.lds + RING_OFF, g, S, E); }
#endif
#endif
        GRID_BAR(); STAMP(2);
#ifndef NO_P3A
        { const attn_body::AttnTensors AT{WSP(const attn_body::bf16, WS_DQ), WSP(const attn_body::bf16, WS_DK), WSP(const attn_body::bf16, WS_DV), WSP(attn_body::bf16, WS_H), WSP(attn_body::bf16, WS_H) + (size_t)T * 512};
          const attn_body::StaticOrder S((int)F.G, (int)blockIdx.x);
          attn_body::attn_phase<attn_body::StaticOrder>((char*)lds + RING_OFF, AT, S); }
#endif
        STAMP(3);
#ifndef NO_P3B
        RETID();
#ifdef SB_SCALAR
        sb_scalar_phase(F, WSP(const bf16, WS_SBQ), WSP(const bf16, WS_SBK), WSP(const bf16, WS_SBV), WSP(bf16, WS_YSB));
#else
        sb_mfma_phase(F, WSP(const bf16, WS_SBQ), WSP(const bf16, WS_SBK), WSP(const bf16, WS_SBVT), WSP(bf16, WS_YSB));
#endif
#endif
        GRID_BAR(); STAMP(4);
#ifndef NO_P4
        { pg8::Gemm g{WSP(const bf16, WS_YSB), WSP(const bf16, WS_WSB) + (size_t)l * D * 512, T, D, 512}; pg8::StaticOrder S; S.init(T, D, F.G, (int)blockIdx.x);
          pg8::EpiGate E{WSP(bf16, WS_M1), WSP(const bf16, WS_GSB), nullptr};
          pg8::gemm_phase<pg8::EpiGate, pg8::StaticOrder, PG8_ALIGN, PG8_SP2>(F.lds + RING_OFF, g, S, E); }
        RETID();
        diffcombine_phase(F, WSP(const bf16, WS_H), WSP(const bf16, WS_H) + (size_t)T * 512, args.in[8] + (size_t)l * 256, args.in[9] + (size_t)l * 128, 0.8f - 0.6f * expf(-0.3f * (float)l), WSP(bf16, WS_YDF));
#endif
        GRID_BAR(); STAMP(5);
#ifndef NO_P5
        { pg8::Gemm g{WSP(const bf16, WS_YDF), WSP(const bf16, WS_WDF) + (size_t)l * D * 512, T, D, 512}; pg8::StaticOrder S; S.init(T, D, F.G, (int)blockIdx.x);
          pg8::EpiGate E{WSP(bf16, WS_MRG), WSP(const bf16, WS_GDF), WSP(const bf16, WS_M1)};
          pg8::gemm_phase<pg8::EpiGate, pg8::StaticOrder, PG8_ALIGN, PG8_SP2>(F.lds + RING_OFF, g, S, E); }
#endif
        GRID_BAR(); STAMP(6);
#ifndef NO_P6
        { pg8::Gemm g{WSP(const bf16, WS_MRG), WSP(const bf16, WS_WOUT) + (size_t)l * D * D, T, D, D}; pg8::StaticOrder S; S.init(T, D, F.G, (int)blockIdx.x);
          pg8::EpiRes E{(l == 0) ? args.in[0] : WSP(const float, WS_XB), WSP(float, WS_XA), mod + 2048, 6144};
          pg8::gemm_phase<pg8::EpiRes, pg8::StaticOrder, PG8_ALIGN, PG8_SP2>(F.lds + RING_OFF, g, S, E); }
#endif
        GRID_BAR(); STAMP(7);
#ifndef NO_P7
        RETID();
        hnorm_phase(F, WSP(const float, WS_XA), args.in[3] + (size_t)l * D, mod + 3072, mod + 4096, WSP(bf16, WS_H));
#endif
        GRID_BAR(); STAMP(8);
#ifndef NO_P8
        { pg8::Gemm g{WSP(const bf16, WS_H), WSP(const bf16, WS_WQ) + (size_t)l * 2048 * D, T, 2048, D}; pg8::StaticOrder S; S.init(T, 2048, F.G, (int)blockIdx.x);
          pg8::EpiBf16<0> E{WSP(bf16, WS_QP), 2048, nullptr, 0, 0, 1.f};
          pg8::gemm_phase<pg8::EpiBf16<0>, pg8::StaticOrder, PG8_ALIGN, PG8_SP2>(F.lds + RING_OFF, g, S, E); }
#endif
        GRID_BAR(); STAMP(9);
#ifndef NO_P9
        RETID();
        topk_phase(F, WSP(const bf16, WS_QP), WSP(const bf16, WS_SUBK) + (size_t)l * 8 * 2 * 128 * 128, WSP(int, WS_EIDX), WSP(float, WS_EGATE));
#endif
        GRID_BAR(); STAMP(10);
#ifndef NO_P10
        { const XInfo X{__builtin_amdgcn_readfirstlane((int)F.MISC[10]), __builtin_amdgcn_readfirstlane((int)F.MISC[11]), __builtin_amdgcn_readfirstlane((int)F.MISC[12]), __builtin_amdgcn_readfirstlane((int)F.MISC[13])};
          RETID();
          peerA_phase(F, X, WSP(const bf16, WS_H), WSP(const int, WS_EIDX), WSP(const unsigned char, WS_U8), WSP(float, WS_APART));
          GRID_BAR(); STAMP(11);
          RETID();
          peerAct_phase(F, WSP(const float, WS_APART), WSP(float, WS_EGATE));
          GRID_BAR(); STAMP(12);
          RETID();
          peerB_phase(F, X, WSP(const float, WS_EGATE), WSP(const int, WS_EIDX), WSP(const unsigned char, WS_V8), WSP(const float, WS_XA), mod + 5120, WSP(float, WS_XB));
          if (l == DEPTH - 1) {
#ifdef TIMING_SEL
              asm volatile("s_waitcnt vmcnt(0)" ::: "memory"); __syncthreads(); STAMP(13);
              if (blockIdx.x == 0 && threadIdx.x == 0) { const unsigned now_ = (unsigned)__builtin_amdgcn_s_memrealtime(); *WSP(float, WS_CTL + 65536) = (float)F.MISC[17] / (float)(now_ - F.MISC[18]); }
#endif
              GRID_BAR(); RETID(); finalnorm_phase(F, WSP(const float, WS_XB), args.in[17], args.out, ws); }
          else { if (l + 1 < DEPTH) { GRID_BAR(); STAMP(13); } } }
#endif
}
__global__ void __launch_bounds__(NWAVES * 64, 2) mega_fwd(Args args) {
    extern __shared__ __attribute__((aligned(16))) unsigned char lds[];
    Frame F; F.lds = (LAS unsigned char*)lds; F.MISC = (volatile LAS unsigned*)(F.lds + MISC_OFF);
    F.tid = threadIdx.x; F.lane = F.tid & 63; F.wave = __builtin_amdgcn_readfirstlane(F.tid >> 6);
    F.G = gridDim.x; { const int bx = blockIdx.x; F.vcu = (F.G % 8 == 0) ? (bx % 8) * (F.G / 8) + bx / 8 : bx; }
    unsigned char* ws = args.ws;
    gu32* ctl = (gu32*)(ws + WS_CTL);
    for (int u = F.tid; u < (LDS_BYTES - LDSCTL_OFF) / 4; u += NWAVES * 64) ((LAS unsigned*)(F.lds + LDSCTL_OFF))[u] = 0u;
    __syncthreads();
    XcdBarrier bar = xcd_barrier_post((unsigned*)(ctl + CW_BAR), F.MISC + 8);
    if (F.tid == 0) F.MISC[10] = xb_add((unsigned*)(ctl + CW_RANK) + 64 * bar.x, 1u);
#ifdef TIMING_SEL
    if (blockIdx.x == 0 && threadIdx.x == 0) F.MISC[20] = (unsigned)__builtin_amdgcn_s_memrealtime();
#endif
    p0_prologue(F, args);
    asm volatile("s_waitcnt vmcnt(0)" ::: "memory");
    cg::this_grid().sync();
    GRID_BAR();
    if (F.tid == 0) { unsigned nx = 0u, xi = 0u, mine = 1u;
        for (unsigned j = 0; j < 16; ++j) { const unsigned c = xb_ld((unsigned*)(ctl + CW_RANK) + 64 * j); nx += c > 0u; xi += (c > 0u && j < bar.x); if (j == bar.x) mine = c; }
        F.MISC[11] = mine ? mine : 1u; F.MISC[12] = nx ? nx : 1u; F.MISC[13] = xi; }
    __syncthreads();
#ifdef TIMING_SEL
    if (blockIdx.x == 0 && threadIdx.x == 0) { const unsigned now_ = (unsigned)__builtin_amdgcn_s_memrealtime(); F.MISC[18] = F.MISC[20]; F.MISC[17] = ((TIMING_SEL) & 1) ? now_ - F.MISC[20] : 0u; F.MISC[16] = now_; }
#endif
    layer_program<0>(F, args, ws, bar, lds);
    layer_program<1>(F, args, ws, bar, lds);
}

extern "C" void kernel_launch(void* const* d_in, const int* in_sizes, int n_in, void* d_out, int out_size, void* d_ws, size_t ws_size, hipStream_t stream) {
    static int grid = 0;
    if (grid == 0) {
        if (n_in != 18 || in_sizes[0] != T * D || out_size != T * D || ws_size < WS_END) { fprintf(stderr, "kernel_launch: unexpected shapes (n_in %d, in0 %d, out %d, ws %zu < %zu); nothing launched\n", n_in, n_in > 0 ? in_sizes[0] : -1, out_size, ws_size, (size_t)WS_END); grid = -1; return; }
        int dev = 0, cus = 0, per_cu = 0;
        if (hipGetDevice(&dev) != hipSuccess || hipDeviceGetAttribute(&cus, hipDeviceAttributeMultiprocessorCount, dev) != hipSuccess) { fprintf(stderr, "kernel_launch: device query failed\n"); grid = -1; return; }
        if (hipFuncSetAttribute((const void*)mega_fwd, hipFuncAttributeMaxDynamicSharedMemorySize, LDS_BYTES) != hipSuccess) { fprintf(stderr, "kernel_launch: hipFuncSetAttribute failed\n"); grid = -1; return; }
        if (hipOccupancyMaxActiveBlocksPerMultiprocessor(&per_cu, (const void*)mega_fwd, NWAVES * 64, LDS_BYTES) != hipSuccess || per_cu < 1) { fprintf(stderr, "kernel_launch: occupancy query reports %d workgroups per CU\n", per_cu); (void)hipGetLastError(); grid = -1; return; }
        grid = cus;
    }
    if (grid < 0) return;
    if (hipMemsetAsync((char*)d_ws + WS_CTL, 0, CTL_ZERO_BYTES, stream) != hipSuccess) { fprintf(stderr, "kernel_launch: hipMemsetAsync failed\n"); return; }
    Args a{};
    for (int i = 0; i < 18; ++i) a.in[i] = (const float*)d_in[i];
    a.out = (float*)d_out; a.ws = (unsigned char*)d_ws;
    void* kargs[] = {&a};
    const hipError_t le = hipLaunchCooperativeKernel((const void*)mega_fwd, dim3(grid), dim3(NWAVES * 64), kargs, LDS_BYTES, stream);
    if (le != hipSuccess) fprintf(stderr, "kernel_launch: cooperative launch failed: %s (grid %d)\n", hipGetErrorName(le), grid);
}
```

```cpp
#include <hip/hip_runtime.h>
#include <cstdio>
#include <cstdint>
#include <hip/hip_cooperative_groups.h>
namespace pg8 {
#define PG8_LAS __attribute__((address_space(3)))
typedef unsigned short bf16_t;
typedef short bf16x8 __attribute__((ext_vector_type(8)));
typedef float f32x4 __attribute__((ext_vector_type(4)));
typedef unsigned u32x4 __attribute__((ext_vector_type(4)));
constexpr int BM = 256, BK = 64, HALF = 128, HTB = HALF * BK * 2  , STAGE_BYTES = 8 * HTB, NXCD = 8, WGM = 8;

__host__ __device__ __forceinline__ int lds_byte(int r, int c) { const int st = (r >> 4) * 2 + (c >> 5), rr = r & 15, cc = c & 31, ob = rr * 64 + cc * 2; return st * 1024 + (ob ^ (((ob >> 9) & 1) << 5)); }
__host__ __device__ __forceinline__ void stage_rc(int b, int& R, int& C) { const int st = b / 1024, sb = b % 1024, swz = sb ^ (((sb >> 9) & 1) << 5); R = (st >> 1) * 16 + swz / 64; C = (st & 1) * 32 + (swz % 64) / 2; }
__host__ __device__ __forceinline__ int perm32(int rho) { const int n = rho >> 4, i = rho & 15; return 8 * (i >> 2) + 4 * n + (i & 3); }

struct Unit { int pm, pn; };
struct Gemm { const bf16_t* A; const bf16_t* Bt; int M, N, K; };

struct StaticOrder {
    int nM, nN, nwg, G, c;
    __host__ __device__ void init(int M, int N, int G_, int c_) { nM = M / BM; nN = N / BM; nwg = nM * nN; G = G_; c = c_; }
    __host__ __device__ bool next(int i, Unit& u) const {
        const long L = (long)i * G + c; if (L >= nwg) return false;
        int wgid = (int)L; { const int q = nwg / NXCD, r = nwg % NXCD, xcd = wgid % NXCD, off = wgid / NXCD; wgid = (xcd < r ? xcd * (q + 1) : r * (q + 1) + (xcd - r) * q) + off; }
        const int nig = WGM * nN, gid = wgid / nig, fm = gid * WGM, gsz = (nM - fm) < WGM ? (nM - fm) : WGM;
        u.pm = fm + ((wgid % nig) % gsz); u.pn = (wgid % nig) / gsz; return true;
    }
    __device__ __forceinline__ void a_ready(const Unit&) const {}
    __device__ __forceinline__ void done(const Unit&) const {}
};

__device__ __forceinline__ unsigned cvt_pk_bf16(float lo, float hi) { unsigned r; asm volatile("v_cvt_pk_bf16_f32 %0, %1, %2" : "=v"(r) : "v"(lo), "v"(hi)); return r; }
typedef float f32x2 __attribute__((ext_vector_type(2)));
__device__ __forceinline__ f32x2 gelu_pk(f32x2 v) {
    const f32x2 av = __builtin_elementwise_abs(v), d = av * 0.2316418882f + 1.0f;
    f32x2 t; t.x = __builtin_amdgcn_rcpf(d.x); t.y = __builtin_amdgcn_rcpf(d.y);
    f32x2 q = t * 0.5307027145f + (-0.7265760135f); q = q * t + 0.7107068705f; q = q * t + (-0.142248368f); q = q * t + 0.127414796f; q = q * t;
    const f32x2 s = (v * v) * (-0.72134752044f);
    f32x2 e; e.x = __builtin_amdgcn_exp2f(s.x); e.y = __builtin_amdgcn_exp2f(s.y);
    const f32x2 m = v * (q * e), r = v - m;
    f32x2 o; o.x = v.x < 0.f ? m.x : r.x; o.y = v.y < 0.f ? m.y : r.y; return o;
}

template <int ACT  > struct EpiBf16 {
    static constexpr bool PERM = true, AFTER_DRAIN = false; static_assert(ACT == 0 || ACT == 1, "EpiBf16: ACT is 0 (none) or 1 (gelu_pk)");
    bf16_t* O; int ldc; const float* bias; int split_cols; size_t split_stride; float scale0;
    __device__ __forceinline__ void operator()(const f32x4 (&acc)[2][2][4][2], const Unit& u, int wr, int wc, int fr, int fq) const {
        const int row0 = u.pm * BM + wr * 64 + fr; int colt = u.pn * BM; bf16_t* base = O;
        float sc = 1.f; if (split_cols) { const int t = colt / split_cols; base += (size_t)t * split_stride; colt -= t * split_cols; if (t == 0) sc = scale0; }
        const int col0 = colt + wc * 32 + 8 * fq, bcol0 = u.pn * BM + wc * 32 + 8 * fq;
        f32x4 bv[2][2];
#pragma unroll
        for (int bj = 0; bj < 2; ++bj)
#pragma unroll
            for (int n = 0; n < 2; ++n) bv[bj][n] = bias ? *(const f32x4*)(bias + bcol0 + bj * HALF + 4 * n) : (f32x4){0.f, 0.f, 0.f, 0.f};
#pragma unroll
        for (int ai = 0; ai < 2; ++ai)
#pragma unroll
            for (int m = 0; m < 4; ++m) { bf16_t* rowp = base + (size_t)(row0 + ai * HALF + m * 16) * ldc + col0;
#pragma unroll
                for (int bj = 0; bj < 2; ++bj) { f32x4 v0 = acc[ai][bj][m][0] + bv[bj][0], v1 = acc[ai][bj][m][1] + bv[bj][1];
                    if (ACT == 1) { f32x2 a = gelu_pk((f32x2){v0[0], v0[1]}), b = gelu_pk((f32x2){v0[2], v0[3]}), c = gelu_pk((f32x2){v1[0], v1[1]}), d = gelu_pk((f32x2){v1[2], v1[3]});
                        v0 = (f32x4){a.x, a.y, b.x, b.y}; v1 = (f32x4){c.x, c.y, d.x, d.y}; }
                    v0 = v0 * sc; v1 = v1 * sc; u32x4 w; w.x = cvt_pk_bf16(v0[0], v0[1]); w.y = cvt_pk_bf16(v0[2], v0[3]); w.z = cvt_pk_bf16(v1[0], v1[1]); w.w = cvt_pk_bf16(v1[2], v1[3]);
                    *(u32x4*)(rowp + bj * HALF) = w; } }
    }
};
typedef unsigned u32x2 __attribute__((ext_vector_type(2)));
__device__ __forceinline__ f32x4 bf4_to_f32(unsigned lo, unsigned hi) { f32x4 r; r[0] = __uint_as_float(lo << 16); r[1] = __uint_as_float(lo & 0xffff0000u); r[2] = __uint_as_float(hi << 16); r[3] = __uint_as_float(hi & 0xffff0000u); return r; }
__device__ __forceinline__ float sigmoidf_(float x) { return 1.0f / (1.0f + __expf(-x)); }
constexpr size_t EPI_MiB = 1u << 20;
constexpr size_t EPI_WS_ROPE = 1 * EPI_MiB + 256 * 1024, EPI_WS_SBQ = 136 * EPI_MiB, EPI_WS_SBK = 152 * EPI_MiB, EPI_WS_SBV = 168 * EPI_MiB, EPI_WS_SBVT = 184 * EPI_MiB, EPI_WS_DQ = 200 * EPI_MiB, EPI_WS_DK = 216 * EPI_MiB, EPI_WS_DV = 232 * EPI_MiB,
                 EPI_WS_GSB = 248 * EPI_MiB, EPI_WS_GDF = 280 * EPI_MiB;
struct EpiIn {
    static constexpr bool PERM = true, AFTER_DRAIN = false;
    unsigned char* ws; const float* gate_b;
    __device__ __forceinline__ void operator()(const f32x4 (&acc)[2][2][4][2], const Unit& u, int wr, int wc, int fr, int fq) const {
        bf16_t* const sbq = (bf16_t*)(ws + EPI_WS_SBQ); bf16_t* const sbk = (bf16_t*)(ws + EPI_WS_SBK); bf16_t* const sbv = (bf16_t*)(ws + EPI_WS_SBV); bf16_t* const sbvt = (bf16_t*)(ws + EPI_WS_SBVT);
        bf16_t* const dq = (bf16_t*)(ws + EPI_WS_DQ); bf16_t* const dk = (bf16_t*)(ws + EPI_WS_DK); bf16_t* const dv = (bf16_t*)(ws + EPI_WS_DV); bf16_t* const gsb = (bf16_t*)(ws + EPI_WS_GSB); bf16_t* const gdf = (bf16_t*)(ws + EPI_WS_GDF);
        const float* const rope_cos = (const float*)(ws + EPI_WS_ROPE); const float* const rope_sin = rope_cos + 4096 * 8; const float c2 = 0.125f * 1.4426950408889634f;
        const int row0 = u.pm * BM + wr * 64 + fr; const int pn = u.pn; const int seg = pn >> 1;
        const int cc0 = wc * 32 + 8 * fq;
        if (pn >= 12) {
            const bool isdf = pn >= 16; bf16_t* G = isdf ? gdf : gsb; const int gc0 = (pn - (isdf ? 16 : 12)) * 256 + cc0; const float* gb = gate_b + (isdf ? 1024 : 0) + gc0;
            f32x4 bv[2][2];
#pragma unroll
            for (int bj = 0; bj < 2; ++bj)
#pragma unroll
                for (int n = 0; n < 2; ++n) bv[bj][n] = *(const f32x4*)(gb + bj * HALF + 4 * n);
#pragma unroll
            for (int ai = 0; ai < 2; ++ai)
#pragma unroll
                for (int m = 0; m < 4; ++m) { bf16_t* rowp = G + (size_t)(row0 + ai * HALF + m * 16) * 1024 + gc0;
#pragma unroll
                    for (int bj = 0; bj < 2; ++bj) { const f32x4 v0 = acc[ai][bj][m][0] + bv[bj][0], v1 = acc[ai][bj][m][1] + bv[bj][1];
                        u32x4 w; w.x = cvt_pk_bf16(sigmoidf_(v0[0]), sigmoidf_(v0[1])); w.y = cvt_pk_bf16(sigmoidf_(v0[2]), sigmoidf_(v0[3])); w.z = cvt_pk_bf16(sigmoidf_(v1[0]), sigmoidf_(v1[1])); w.w = cvt_pk_bf16(sigmoidf_(v1[2]), sigmoidf_(v1[3]));
                        *(u32x4*)(rowp + bj * HALF) = w; } }
            return;
        }
        const int col0 = (pn & 1) * 256 + cc0;
        if (seg == 3 || seg == 4) {
            bf16_t* O = seg == 3 ? dq : dk; const float sc = seg == 3 ? c2 : 1.0f;
            const bool ropew = (wc & 1) == 0;
            const bool rl = fq < 2;
#pragma unroll
            for (int ai = 0; ai < 2; ++ai)
#pragma unroll
                for (int m = 0; m < 4; ++m) { const int row = row0 + ai * HALF + m * 16; bf16_t* rowp = O + (size_t)row * 512 + col0;
                    f32x4 cs0 = {1.f, 1.f, 1.f, 1.f}, cs1 = cs0, sn0 = {0.f, 0.f, 0.f, 0.f}, sn1 = sn0;
                    if (ropew) { const int pos = row & 4095; cs0 = *(const f32x4*)(rope_cos + pos * 8); cs1 = *(const f32x4*)(rope_cos + pos * 8 + 4); sn0 = *(const f32x4*)(rope_sin + pos * 8); sn1 = *(const f32x4*)(rope_sin + pos * 8 + 4); }
#pragma unroll
                    for (int bj = 0; bj < 2; ++bj) { f32x4 v0 = acc[ai][bj][m][0], v1 = acc[ai][bj][m][1];
                        if (ropew) { f32x4 p0, p1;
#pragma unroll
                            for (int j = 0; j < 4; ++j) { p0[j] = __shfl_xor(v0[j], 16); p1[j] = __shfl_xor(v1[j], 16); }
                            const float sg = (fq == 0) ? -1.0f : 1.0f;
                            if (rl) { v0 = v0 * cs0 + (p0 * sn0) * sg; v1 = v1 * cs1 + (p1 * sn1) * sg; } }
                        v0 = v0 * sc; v1 = v1 * sc;
                        u32x4 w; w.x = cvt_pk_bf16(v0[0], v0[1]); w.y = cvt_pk_bf16(v0[2], v0[3]); w.z = cvt_pk_bf16(v1[0], v1[1]); w.w = cvt_pk_bf16(v1[2], v1[3]);
                        *(u32x4*)(rowp + bj * HALF) = w; } }
            return;
        }
        bf16_t* O = seg == 0 ? sbq : seg == 1 ? sbk : seg == 2 ? sbv : dv; const float sc = seg == 0 ? 0.125f : 1.0f;
#pragma unroll
        for (int ai = 0; ai < 2; ++ai)
#pragma unroll
            for (int m = 0; m < 4; ++m) { const int row = row0 + ai * HALF + m * 16; bf16_t* rowp = O + (size_t)row * 512 + col0;
#pragma unroll
                for (int bj = 0; bj < 2; ++bj) { const f32x4 v0 = acc[ai][bj][m][0] * sc, v1 = acc[ai][bj][m][1] * sc;
                    u32x4 w; w.x = cvt_pk_bf16(v0[0], v0[1]); w.y = cvt_pk_bf16(v0[2], v0[3]); w.z = cvt_pk_bf16(v1[0], v1[1]); w.w = cvt_pk_bf16(v1[2], v1[3]);
                    *(u32x4*)(rowp + bj * HALF) = w;
#if defined(SBVT_STORE)
                    if (seg == 2) {
                        const int b = row >> 12, t = row & 4095;
#pragma unroll
                        for (int j = 0; j < 8; ++j) { const int col = col0 + bj * HALF + j; const int h = col >> 6, d = col & 63;
                            const unsigned word = j < 2 ? w.x : j < 4 ? w.y : j < 6 ? w.z : w.w; const bf16_t e = (bf16_t)((j & 1) ? (word >> 16) : (word & 0xffffu));
                            sbvt[((size_t)(b * 8 + h) * 64 + d) * 4096 + t] = e; } }
#endif
                } }
    }
};
struct EpiGate {
    static constexpr bool PERM = true, AFTER_DRAIN = false;
    bf16_t* O; const bf16_t* gate; const bf16_t* add;
    __device__ __forceinline__ void operator()(const f32x4 (&acc)[2][2][4][2], const Unit& u, int wr, int wc, int fr, int fq) const {
        const int row0 = u.pm * BM + wr * 64 + fr; const int col0 = u.pn * BM + wc * 32 + 8 * fq;
#pragma unroll
        for (int ai = 0; ai < 2; ++ai)
#pragma unroll
            for (int m = 0; m < 4; ++m) { const size_t off = (size_t)(row0 + ai * HALF + m * 16) * 1024 + col0;
#pragma unroll
                for (int bj = 0; bj < 2; ++bj) { const u32x4 g = *(const u32x4*)(gate + off + bj * HALF);
                    f32x4 v0 = acc[ai][bj][m][0] * bf4_to_f32(g.x, g.y), v1 = acc[ai][bj][m][1] * bf4_to_f32(g.z, g.w);
                    if (add) { const u32x4 a = *(const u32x4*)(add + off + bj * HALF); v0 = v0 + bf4_to_f32(a.x, a.y); v1 = v1 + bf4_to_f32(a.z, a.w); }
                    u32x4 w; w.x = cvt_pk_bf16(v0[0], v0[1]); w.y = cvt_pk_bf16(v0[2], v0[3]); w.z = cvt_pk_bf16(v1[0], v1[1]); w.w = cvt_pk_bf16(v1[2], v1[3]);
                    *(u32x4*)(O + off + bj * HALF) = w; } }
    }
};
struct EpiRes {
    static constexpr bool PERM = false, AFTER_DRAIN = false;
    const float* base; float* out; const float* gvec; int gstride;
    __device__ __forceinline__ void operator()(const f32x4 (&acc)[2][2][4][2], const Unit& u, int wr, int wc, int fr, int fq) const {
        const int row0 = u.pm * BM + wr * 64 + fr; const int col0 = u.pn * BM + wc * 32 + 4 * fq; const int b = (u.pm * BM) >> 12;
        f32x4 gv[2][2];
#pragma unroll
        for (int bj = 0; bj < 2; ++bj)
#pragma unroll
            for (int n = 0; n < 2; ++n) gv[bj][n] = *(const f32x4*)(gvec + (size_t)b * gstride + col0 + bj * HALF + n * 16);
#pragma unroll
        for (int ai = 0; ai < 2; ++ai)
#pragma unroll
            for (int m = 0; m < 4; ++m) { const size_t off = (size_t)(row0 + ai * HALF + m * 16) * 1024 + col0;
#pragma unroll
                for (int bj = 0; bj < 2; ++bj)
#pragma unroll
                    for (int n = 0; n < 2; ++n) { const f32x4 bs = *(const f32x4*)(base + off + bj * HALF + n * 16);
                        *(f32x4*)(out + off + bj * HALF + n * 16) = bs + gv[bj][n] * acc[ai][bj][m][n]; } }
    }
};
template <class Epi, class Sched, bool ALIGN_EPI = false, bool SP2 = false>
__device__ __forceinline__ void gemm_phase(PG8_LAS unsigned char* lds, const Gemm g, const Sched& S, const Epi& E) {
    int tid_ = threadIdx.x; asm volatile("" : "+v"(tid_));
    const int tid = tid_, wid = __builtin_amdgcn_readfirstlane(tid >> 6), lane = tid & 63, wr = wid >> 2, wc = wid & 3, fr = lane & 15, fq = lane >> 4;
    const int K = g.K, nt = K / BK;
    unsigned voffA[2], voffB[2];
#pragma unroll
    for (int i = 0; i < 2; ++i) { int R, C; stage_rc(tid * 16 + i * 8192, R, C); const int Rb = Epi::PERM ? ((R & ~31) + perm32(R & 31)) : R;
        voffA[i] = (unsigned)(R * K + C) * 2u; voffB[i] = (unsigned)(Rb * K + C) * 2u; }
    const size_t kstep = (size_t)(BK * 2);
    const size_t hstep = (size_t)HALF * K * 2;
    const size_t tstep = 2 * hstep;
    const unsigned ldsw = (unsigned)wid * 1024u;
    const int aoff = lds_byte(wr * 64 + fr, fq * 8), boff = lds_byte(wc * 32 + fr, fq * 8);
#define PG8_SA(b, h) (((b) * 2 + (h)) * HTB)
#define PG8_SB(b, h) ((4 + (b) * 2 + (h)) * HTB)
#define PG8_STAGE(bufoff, gbase, voff) do { _Pragma("unroll") for (int _i = 0; _i < 2; ++_i) \
        __builtin_amdgcn_global_load_lds((const unsigned*)((const char*)(gbase) + (voff)[_i]), (PG8_LAS unsigned*)(lds + (bufoff) + ldsw + _i * 8192), 16, 0, 0); } while (0)
#define PG8_LDA(dst, b, h) do { _Pragma("unroll") for (int m = 0; m < 4; ++m) _Pragma("unroll") for (int k = 0; k < 2; ++k) dst[m][k] = *(const PG8_LAS bf16x8*)(lds + PG8_SA(b, h) + aoff + m * 2048 + k * 1024); } while (0)
#define PG8_LDB(dst, b, h) do { _Pragma("unroll") for (int n = 0; n < 2; ++n) _Pragma("unroll") for (int k = 0; k < 2; ++k) dst[n][k] = *(const PG8_LAS bf16x8*)(lds + PG8_SB(b, h) + boff + n * 2048 + k * 1024); } while (0)
#define PG8_MMA(ai, bj, At, Bt) do { __builtin_amdgcn_s_setprio(1); _Pragma("unroll") for (int m = 0; m < 4; ++m) _Pragma("unroll") for (int n = 0; n < 2; ++n) _Pragma("unroll") for (int k = 0; k < 2; ++k) \
        acc[ai][bj][m][n] = __builtin_amdgcn_mfma_f32_16x16x32_bf16(Bt[n][k], At[m][k], acc[ai][bj][m][n], 0, 0, 0); __builtin_amdgcn_s_setprio(0); } while (0)
#define PG8_WAIT_V(n) asm volatile("s_waitcnt vmcnt(" #n ")" ::: "memory")
#define PG8_WAIT_L(n) asm volatile("s_waitcnt lgkmcnt(" #n ")" ::: "memory")
#define PG8_BAR __builtin_amdgcn_s_barrier()
#define PG8_SCHED __builtin_amdgcn_sched_barrier(0)
    Unit cur, nxt; int ui = 0;
    if (!S.next(0, cur)) return;
    f32x4 acc[2][2][4][2];
#pragma unroll
    for (int a = 0; a < 2; ++a)
#pragma unroll
        for (int b = 0; b < 2; ++b)
#pragma unroll
            for (int m = 0; m < 4; ++m)
#pragma unroll
                for (int n = 0; n < 2; ++n) acc[a][b][m][n] = (f32x4){0.f, 0.f, 0.f, 0.f};
    bf16x8 At[4][2], B0[2][2], B1[2][2];
    const char* cA = (const char*)g.A + (size_t)cur.pm * tstep; const char* cB = (const char*)g.Bt + (size_t)cur.pn * tstep;
    S.a_ready(cur);
    if constexpr (SP2) {
        PG8_STAGE(PG8_SB(0, 0), cB, voffB); PG8_STAGE(PG8_SB(0, 1), cB + hstep, voffB); PG8_STAGE(PG8_SA(0, 0), cA, voffA); PG8_STAGE(PG8_SA(0, 1), cA + hstep, voffA);
        if (wr == 1) PG8_BAR;
        PG8_WAIT_V(2); PG8_BAR;
        PG8_STAGE(PG8_SB(1, 0), cB + kstep, voffB); PG8_STAGE(PG8_SA(1, 0), cA + kstep, voffA); PG8_STAGE(PG8_SB(1, 1), cB + hstep + kstep, voffB);
        PG8_WAIT_V(6); PG8_BAR;
    } else {
        PG8_STAGE(PG8_SB(0, 0), cB, voffB); PG8_STAGE(PG8_SA(0, 0), cA, voffA); PG8_STAGE(PG8_SB(0, 1), cB + hstep, voffB); PG8_STAGE(PG8_SA(0, 1), cA + hstep, voffA);
        if (wr == 1) PG8_BAR;
        PG8_WAIT_V(4); PG8_BAR;
        PG8_STAGE(PG8_SB(1, 0), cB + kstep, voffB); PG8_STAGE(PG8_SA(1, 0), cA + kstep, voffA); PG8_STAGE(PG8_SB(1, 1), cB + hstep + kstep, voffB);
        PG8_WAIT_V(6); PG8_BAR;
    }
    for (;;) {
        const bool has_next = S.next(ui + 1, nxt);
        const char* nA = has_next ? (const char*)g.A + (size_t)nxt.pm * tstep : cA; const char* nB = has_next ? (const char*)g.Bt + (size_t)nxt.pn * tstep : cB;
        for (int t = 0; t < nt; t += 2) {
            const bool last = (t == nt - 2);
            const char* a1 = cA + (size_t)(t + 1) * kstep;
            const char* a2 = last ? nA : cA + (size_t)(t + 2) * kstep; const char* b2 = last ? nB : cB + (size_t)(t + 2) * kstep;
            const char* a3 = a2 + kstep; const char* b3 = b2 + kstep;
            if (last && has_next) S.a_ready(nxt);
            if constexpr (SP2) {
            PG8_LDB(B0, 0, 0); PG8_LDB(B1, 0, 1); PG8_SCHED; PG8_LDA(At, 0, 0); PG8_STAGE(PG8_SA(1, 1), a1 + hstep, voffA);
            PG8_WAIT_V(8); PG8_WAIT_L(0); PG8_BAR; PG8_MMA(0, 0, At, B0); PG8_MMA(0, 1, At, B1); PG8_BAR; PG8_SCHED;
            PG8_LDA(At, 0, 1); PG8_STAGE(PG8_SB(0, 0), b2, voffB); PG8_STAGE(PG8_SB(0, 1), b2 + hstep, voffB); PG8_STAGE(PG8_SA(0, 0), a2, voffA);
            PG8_WAIT_V(8); PG8_WAIT_L(0); PG8_BAR; PG8_MMA(1, 0, At, B0); PG8_MMA(1, 1, At, B1); PG8_BAR; PG8_SCHED;
            PG8_LDB(B0, 1, 0); PG8_LDB(B1, 1, 1); PG8_SCHED; PG8_LDA(At, 1, 0); PG8_STAGE(PG8_SA(0, 1), a2 + hstep, voffA);
            PG8_WAIT_V(8); PG8_WAIT_L(0); PG8_BAR; PG8_MMA(0, 0, At, B0); PG8_MMA(0, 1, At, B1); PG8_BAR; PG8_SCHED;
            PG8_LDA(At, 1, 1); PG8_STAGE(PG8_SB(1, 0), b3, voffB); PG8_STAGE(PG8_SB(1, 1), b3 + hstep, voffB); PG8_STAGE(PG8_SA(1, 0), a3, voffA);
            PG8_WAIT_V(8); PG8_WAIT_L(0); PG8_BAR; PG8_MMA(1, 0, At, B0); PG8_MMA(1, 1, At, B1); PG8_BAR; PG8_SCHED;
            } else {
            PG8_LDB(B0, 0, 0); PG8_SCHED; PG8_LDA(At, 0, 0); PG8_STAGE(PG8_SA(1, 1), a1 + hstep, voffA);
            PG8_WAIT_L(8); PG8_BAR; PG8_WAIT_L(0); PG8_MMA(0, 0, At, B0); PG8_BAR; PG8_SCHED;
            PG8_LDB(B1, 0, 1); PG8_STAGE(PG8_SB(0, 0), b2, voffB);
            PG8_BAR; PG8_WAIT_L(0); PG8_MMA(0, 1, At, B1); PG8_BAR;
            PG8_LDA(At, 0, 1); PG8_STAGE(PG8_SA(0, 0), a2, voffA);
            PG8_BAR; PG8_WAIT_L(0); PG8_MMA(1, 0, At, B0); PG8_BAR; PG8_SCHED;
            PG8_STAGE(PG8_SB(0, 1), b2 + hstep, voffB);
            PG8_WAIT_V(6); PG8_BAR; PG8_MMA(1, 1, At, B1); PG8_BAR;
            PG8_LDB(B0, 1, 0); PG8_SCHED; PG8_LDA(At, 1, 0); PG8_STAGE(PG8_SA(0, 1), a2 + hstep, voffA);
            PG8_WAIT_L(8); PG8_BAR; PG8_WAIT_L(0); PG8_MMA(0, 0, At, B0); PG8_BAR; PG8_SCHED;
            PG8_LDB(B1, 1, 1); PG8_STAGE(PG8_SB(1, 0), b3, voffB);
            PG8_BAR; PG8_WAIT_L(0); PG8_MMA(0, 1, At, B1); PG8_BAR;
            PG8_LDA(At, 1, 1); PG8_STAGE(PG8_SA(1, 0), a3, voffA);
            PG8_BAR; PG8_WAIT_L(0); PG8_MMA(1, 0, At, B0); PG8_BAR; PG8_SCHED;
            PG8_STAGE(PG8_SB(1, 1), b3 + hstep, voffB);
            PG8_WAIT_V(6); PG8_BAR; PG8_MMA(1, 1, At, B1); PG8_BAR;
            }
        }
        if constexpr (ALIGN_EPI) { if (wr == 0) PG8_BAR; }
        if constexpr (!Epi::AFTER_DRAIN) { E(acc, cur, wr, wc, fr, fq); S.done(cur); }
        if (!has_next) break;
#pragma unroll
        for (int a = 0; a < 2; ++a)
#pragma unroll
            for (int b = 0; b < 2; ++b)
#pragma unroll
                for (int m = 0; m < 4; ++m)
#pragma unroll
                    for (int n = 0; n < 2; ++n) acc[a][b][m][n] = (f32x4){0.f, 0.f, 0.f, 0.f};
        cur = nxt; cA = nA; cB = nB; ++ui;
        if constexpr (ALIGN_EPI) { if (wr == 1) PG8_BAR; }
    }
    PG8_WAIT_V(0);
    if constexpr (!ALIGN_EPI) { if (wr == 0) PG8_BAR; }
    PG8_BAR;
    if constexpr (Epi::AFTER_DRAIN) { E.fused(acc, cur, wr, wc, fr, fq, lds, wid, lane); S.done(cur); }
#undef PG8_SA
#undef PG8_SB
#undef PG8_STAGE
#undef PG8_LDA
#undef PG8_LDB
#undef PG8_MMA
#undef PG8_WAIT_V
#undef PG8_WAIT_L
#undef PG8_BAR
#undef PG8_SCHED
}
}

#ifndef PG8_SP2
#define PG8_SP2 true
#endif
#ifndef PG8_ALIGN
#define PG8_ALIGN true
#endif
#include <hip/hip_bf16.h>
#include <cmath>
namespace attn_body {
using bf16=__hip_bfloat16;
using bf16x8=__attribute__((ext_vector_type(8)))short;
using s16x4=__attribute__((ext_vector_type(4)))short;
using f32x16=__attribute__((ext_vector_type(16)))float;
using u32x4=__attribute__((ext_vector_type(4)))unsigned;
constexpr int BATCH=4,SEQ=4096,D=64,DM=512;
constexpr int NW=8,QBLK=32,QB=QBLK*NW,KVBLK=64,NQB=SEQ/QB;
constexpr int ATTN_PITCH=DM, ATTN_UNIT_ROWS=QB;
__device__ __forceinline__ int crow(int r,int hi){return (r&3)+8*(r>>2)+4*hi;}
#define SBAR() __builtin_amdgcn_sched_barrier(0)
__device__ __forceinline__ void cmask(f32x16&p0,f32x16&p1,int jb,int qrel,int hi){
  const float NEG=-INFINITY; int kb=64*jb+4*hi;
  #pragma unroll
  for(int r=0;r<16;++r){int kv=kb+(r&3)+8*(r>>2); if(kv>qrel)p0[r]=NEG; if(kv+32>qrel)p1[r]=NEG;}
}

constexpr int NSLOT=3, SLOTB=8192;
constexpr int LDS_K=0, LDS_V=NSLOT*SLOTB, LDS_WS=2*NSLOT*SLOTB, LDS_OST=LDS_WS+NW*64*4, LDS_BYTES=LDS_OST+NW*4096;
constexpr float C2=0.125f*1.4426950408889634f;
__device__ __forceinline__ void glds16(const void*gsrc,unsigned lds_dst){unsigned keep;
  asm volatile("s_mov_b32 %0, m0\n\ts_mov_b32 m0, %2\n\ts_nop 0\n\tglobal_load_lds_dwordx4 %1, off\n\ts_mov_b32 m0, %0":"=&s"(keep):"v"(gsrc),"s"(lds_dst):"memory");}
__device__ __forceinline__ float max3f(float a,float b,float c){float r;asm("v_max3_f32 %0, %1, %2, %3":"=v"(r):"v"(a),"v"(b),"v"(c));return r;}
__device__ __forceinline__ float max2f(float a,float b){float r;asm("v_max_f32_e32 %0, %1, %2":"=v"(r):"v"(a),"v"(b));return r;}
__device__ __forceinline__ float fadd_s(float a,float b){float r;asm("v_add_f32_e32 %0, %1, %2":"=v"(r):"v"(a),"v"(b));return r;}
__device__ __forceinline__ float fsub_s(float a,float b){float r;asm("v_sub_f32_e32 %0, %1, %2":"=v"(r):"v"(a),"v"(b));return r;}
typedef float f32x2_t __attribute__((ext_vector_type(2))); typedef __bf16 bf16x2_t __attribute__((ext_vector_type(2)));
__device__ __forceinline__ unsigned cvtpk_s(float lo,float hi){f32x2_t v={lo,hi};bf16x2_t b=__builtin_convertvector(v,bf16x2_t);return __builtin_bit_cast(unsigned,b);}
#define WAIT_BAR(N) asm volatile("s_waitcnt vmcnt(" #N ") lgkmcnt(0)\n\ts_barrier":::"memory")

__device__ __forceinline__ void qkt(f32x16&p0,f32x16&p1,const char*Kslot,const bf16x8*qr,const f32x16&negm,int r32,int hi){
  const char*kb=Kslot+hi*1024+r32*16;
  #pragma unroll
  for(int d0=0;d0<4;++d0){
    const bf16x8 b0=*reinterpret_cast<const bf16x8*>(kb+d0*2048);
    const bf16x8 b1=*reinterpret_cast<const bf16x8*>(kb+d0*2048+512);
    if(d0==0){p0=__builtin_amdgcn_mfma_f32_32x32x16_bf16(b0,qr[0],negm,0,0,0);p1=__builtin_amdgcn_mfma_f32_32x32x16_bf16(b1,qr[0],negm,0,0,0);}
    else{p0=__builtin_amdgcn_mfma_f32_32x32x16_bf16(b0,qr[d0],p0,0,0,0);p1=__builtin_amdgcn_mfma_f32_32x32x16_bf16(b1,qr[d0],p1,0,0,0);}}
}
typedef __attribute__((address_space(3))) const char* lds_cptr;
typedef short v4i16_t __attribute__((ext_vector_type(4)));
__device__ __forceinline__ void kload8(bf16x8*kf,lds_cptr kp){
  kf[0]=*(const __attribute__((address_space(3))) bf16x8*)(kp);      kf[1]=*(const __attribute__((address_space(3))) bf16x8*)(kp+512);
  kf[2]=*(const __attribute__((address_space(3))) bf16x8*)(kp+2048); kf[3]=*(const __attribute__((address_space(3))) bf16x8*)(kp+2560);
  kf[4]=*(const __attribute__((address_space(3))) bf16x8*)(kp+4096); kf[5]=*(const __attribute__((address_space(3))) bf16x8*)(kp+4608);
  kf[6]=*(const __attribute__((address_space(3))) bf16x8*)(kp+6144); kf[7]=*(const __attribute__((address_space(3))) bf16x8*)(kp+6656);
}
__device__ __forceinline__ void kload2(bf16x8*kf,lds_cptr kp,int j){ kf[2*j]=*(const __attribute__((address_space(3))) bf16x8*)(kp+j*2048); kf[2*j+1]=*(const __attribute__((address_space(3))) bf16x8*)(kp+j*2048+512); }
__device__ __forceinline__ s16x4 vtr(lds_cptr p){ return __builtin_bit_cast(s16x4,__builtin_amdgcn_ds_read_tr16_b64_v4i16((__attribute__((address_space(3))) v4i16_t*)p)); }
__device__ __forceinline__ float rowmax(const f32x16&p0,const f32x16&p1){
  float a=max3f(p0[0],p0[1],p1[0]),b=max3f(p0[2],p0[3],p1[1]);a=max3f(a,p1[2],p1[3]);
  #pragma unroll
  for(int r=4;r<16;r+=4){a=max3f(a,p0[r],p0[r+1]);b=max3f(b,p0[r+2],p0[r+3]);a=max3f(a,p1[r],p1[r+1]);b=max3f(b,p1[r+2],p1[r+3]);}
  const float m=max2f(a,b);
  auto rr=__builtin_amdgcn_permlane32_swap(__float_as_uint(m),__float_as_uint(m),false,false);
  return max2f(__uint_as_float(rr[0]),__uint_as_float(rr[1]));
}
__device__ __forceinline__ void pv(f32x16*o,int vb,bf16x8 pa0,bf16x8 pa1,bf16x8 pa2,bf16x8 pa3){
  #pragma unroll
  for(int d0=0;d0<2;++d0){s16x4 lo[4],hi[4];
    #pragma unroll
    for(int ks=0;ks<4;++ks){
      asm volatile("ds_read_b64_tr_b16 %0,%1 offset:%c2":"=&v"(lo[ks]):"v"(vb),"i"(d0*4096+ks*1024):"memory");
      asm volatile("ds_read_b64_tr_b16 %0,%1 offset:%c2":"=&v"(hi[ks]):"v"(vb),"i"(d0*4096+ks*1024+512):"memory");}
    asm volatile("s_waitcnt lgkmcnt(0)":::"memory");SBAR();
    #define PK(k) (bf16x8){lo[k][0],lo[k][1],lo[k][2],lo[k][3],hi[k][0],hi[k][1],hi[k][2],hi[k][3]}
    o[d0]=__builtin_amdgcn_mfma_f32_32x32x16_bf16(pa0,PK(0),o[d0],0,0,0);
    o[d0]=__builtin_amdgcn_mfma_f32_32x32x16_bf16(pa1,PK(1),o[d0],0,0,0);
    o[d0]=__builtin_amdgcn_mfma_f32_32x32x16_bf16(pa2,PK(2),o[d0],0,0,0);
    o[d0]=__builtin_amdgcn_mfma_f32_32x32x16_bf16(pa3,PK(3),o[d0],0,0,0);
    #undef PK
  }
}

#ifndef ATTN_STORE16
#define ATTN_STORE16(p,v) (*(u32x4*)(p)=(v))
#endif
template<int THRL> __device__ __forceinline__ void attn_unit(int b,int qcol,int vcol,int ocol,int qb,const bf16*Q,const bf16*__restrict__ K,const bf16*__restrict__ V,bf16*O,char*shm){
  int tid_=threadIdx.x; asm volatile("":"+v"(tid_)); const int tid=tid_,lane=tid&63,r32=lane&31,hi=lane>>5; const int wid=__builtin_amdgcn_readfirstlane(tid>>6);
  const long rowbase=(long)b*SEQ; const int q0=qb*QB;
  const bf16*Qw=Q+(rowbase+q0+wid*QBLK)*DM+qcol;
  const bf16*Kh=K+rowbase*DM+qcol,*Vh=V+rowbase*DM+vcol;
  const unsigned lds0=(unsigned)(uintptr_t)shm;
  float*wsf=(float*)(shm+LDS_WS)+wid*64;
  const bf16*ksrc=Kh+(long)lane*DM+wid*8;
  const bf16*vsrc=Vh+(long)(16*(wid&3)+(lane>>2))*DM+(wid>>2)*32+(lane&3)*8;
  const unsigned kdst=lds0+LDS_K+wid*1024, vdst=lds0+LDS_V+wid*1024;
  #define DMA_K(t,slot) glds16(ksrc+(long)(t)*KVBLK*DM,(unsigned)__builtin_amdgcn_readfirstlane(kdst+(slot)))
  #define DMA_V(t,slot) glds16(vsrc+(long)(t)*KVBLK*DM,(unsigned)__builtin_amdgcn_readfirstlane(vdst+(slot)))
  const int vb0=(int)(lds0+LDS_V)+((lane>>4)&1)*32+(lane&3)*8+(4*hi+((lane&15)>>2))*64;
  const char*Kbase=shm+LDS_K; bf16x8 kf[8];
  const lds_cptr shm3=(lds_cptr)shm; const lds_cptr kp0=shm3+LDS_K+hi*1024+r32*16; const lds_cptr vp0=shm3+LDS_V+((lane>>4)&1)*32+(lane&3)*8+(4*hi+((lane&15)>>2))*64;
  const int NT=(q0+QB)/KVBLK;
  DMA_K(0,0);DMA_V(0,0);DMA_K(1,SLOTB);
  bf16x8 qr[4];
  #pragma unroll
  for(int d0=0;d0<4;++d0)qr[d0]=*reinterpret_cast<const bf16x8*>(&Qw[(long)r32*DM+d0*16+hi*8]);
  float mhat=0.f,l_reg=0.f;f32x16 o[2];o[0]=f32x16{};o[1]=f32x16{};f32x16 negm=f32x16{};asm volatile("":"+v"(negm));
  const int qrel=wid*QBLK+r32;
  #define CMASK(P0,P1,t) do{int jb_=(t)-(NT-4); if(jb_>=0)cmask(P0,P1,jb_,qrel,hi);}while(0)
  bool resc=false;
  #define START(P0,P1) do{ const float rm=rowmax(P0,P1); resc=false; \
    { const float dl=rm; mhat=fadd_s(mhat,dl); \
      _Pragma("unroll") for(int r=0;r<16;++r){P0[r]=fsub_s(P0[r],dl);P1[r]=fsub_s(P1[r],dl);} \
      _Pragma("unroll") for(int r=0;r<16;++r)negm[r]=-mhat; asm volatile("":"+v"(negm)); } \
    _Pragma("unroll") for(int r=0;r<16;++r)P0[r]=__builtin_amdgcn_exp2f(P0[r]); }while(0)
  #define RESC() do{ if(resc){ asm volatile("s_waitcnt lgkmcnt(0)":::"memory"); \
      _Pragma("unroll") for(int d_=0;d_<2;++d_) _Pragma("unroll") for(int r=0;r<16;++r)o[d_][r]*=wsf[crow(r,hi)]; } }while(0)
  f32x16 pA0,pA1,pB0,pB1;
  int sl_prev=0,sl_cur=0,sl_next=SLOTB;
  #define ROT() do{sl_prev=sl_cur;sl_cur=sl_next;sl_next=(sl_next==(NSLOT-1)*SLOTB)?0:sl_next+SLOTB;}while(0)
  DMA_K(2,2*SLOTB);
  WAIT_BAR(3);
  qkt(pA0,pA1,Kbase,qr,negm,r32,hi);asm volatile("s_nop 15\n\ts_nop 7":"+v"(pA0),"+v"(pA1));CMASK(pA0,pA1,0);
  START(pA0,pA1);
  _Pragma("unroll") for(int r=0;r<16;++r)pA1[r]=__builtin_amdgcn_exp2f(pA1[r]);
  WAIT_BAR(0);
  DMA_K(3,0);DMA_V(1,SLOTB);
  ROT();
  kload8(kf,kp0+sl_cur);
  WAIT_BAR(2);
  s16x4 vlo[8],vhi[8]; u32x4 pw0,pw1,pw2,pw3;
  #define PKW(P,B) cvtpk_s(P[B],P[B+1])
  #define PAF(k) __builtin_bit_cast(bf16x8,pw##k)
  #define VFR(i) (bf16x8){vlo[i][0],vlo[i][1],vlo[i][2],vlo[i][3],vhi[i][0],vhi[i][1],vhi[i][2],vhi[i][3]}
  #define PIN(x) asm volatile("":"+v"(x))
  #define MX3(a,b,c) __builtin_fmaxf(__builtin_fmaxf((a),(b)),(c))
  #define GAPA(MF,A0,A1,A2,A3,W0,W1,PW) do{ MF; sacc+=A0; sacc+=A1; sacc+=A2; sacc+=A3; PIN(sacc); W0; W1; PIN(PW); SBAR(); }while(0)
  #define EX(v) __builtin_amdgcn_exp2f(v)
  #define GAPB(MF,X,B) do{ MF; X[B]=EX(X[B]); X[B+1]=EX(X[B+1]); X[B+2]=EX(X[B+2]); X[B+3]=EX(X[B+3]); PIN(X); SBAR(); }while(0)
  #define VRD(i) do{ vlo[i]=vtr(vp_+(((i)>>2)*4096+((i)&3)*1024)); vhi[i]=vtr(vp_+(((i)>>2)*4096+((i)&3)*1024+512)); }while(0)
  #define KRD(G,j) do{ if(G){ kload2(kf,kp0+sl_next,j); SBAR(); } }while(0)
  #define STEP(C0,C1,P0,P1,t,GK,GV,GL) do{ SBAR(); \
    const lds_cptr vp_=vp0+sl_prev; \
    VRD(0); SBAR(); float sacc=(P0[0]+P0[1]); \
    GAPA(C0=__builtin_amdgcn_mfma_f32_32x32x16_bf16(kf[0],qr[0],negm,0,0,0), P0[2],P0[3],P0[4],P0[5],     pw0[0]=PKW(P0,0), pw0[1]=PKW(P0,2), pw0); \
    VRD(4); SBAR(); GAPA(C1=__builtin_amdgcn_mfma_f32_32x32x16_bf16(kf[1],qr[0],negm,0,0,0), P0[6],P0[7],P0[8],P0[9],     pw0[2]=PKW(P0,4), pw0[3]=PKW(P0,6), pw0); \
    VRD(1); SBAR(); GAPA(C0=__builtin_amdgcn_mfma_f32_32x32x16_bf16(kf[2],qr[1],C0,0,0,0),   P0[10],P0[11],P0[12],P0[13], pw1[0]=PKW(P0,8), pw1[1]=PKW(P0,10), pw1); \
    VRD(5); SBAR(); GAPA(C1=__builtin_amdgcn_mfma_f32_32x32x16_bf16(kf[3],qr[1],C1,0,0,0),   P0[14],P0[15],P1[0],P1[1],   pw1[2]=PKW(P0,12),pw1[3]=PKW(P0,14), pw1); \
    VRD(2); SBAR(); GAPA(C0=__builtin_amdgcn_mfma_f32_32x32x16_bf16(kf[4],qr[2],C0,0,0,0),   P1[2],P1[3],P1[4],P1[5],     pw2[0]=PKW(P1,0), pw2[1]=PKW(P1,2), pw2); \
    VRD(6); SBAR(); GAPA(C1=__builtin_amdgcn_mfma_f32_32x32x16_bf16(kf[5],qr[2],C1,0,0,0),   P1[6],P1[7],P1[8],P1[9],     pw2[2]=PKW(P1,4), pw2[3]=PKW(P1,6), pw2); \
    VRD(3); SBAR(); GAPA(C0=__builtin_amdgcn_mfma_f32_32x32x16_bf16(kf[6],qr[3],C0,0,0,0),   P1[10],P1[11],P1[12],P1[13], pw3[0]=PKW(P1,8), pw3[1]=PKW(P1,10), pw3); \
    VRD(7); SBAR(); GAPA(C1=__builtin_amdgcn_mfma_f32_32x32x16_bf16(kf[7],qr[3],C1,0,0,0),   P1[14],P1[15],0.f,0.f,       pw3[2]=PKW(P1,12),pw3[3]=PKW(P1,14), pw3); \
    l_reg+=sacc; \
    if(GK){DMA_K((t)+3,sl_cur);} if(GV){DMA_V((t)+1,sl_next);} \
    CMASK(C0,C1,t); \
    { float a=MX3(C0[0],C0[1],C1[0]),b=MX3(C0[2],C0[3],C1[1]); a=MX3(a,C1[2],C1[3]); \
      _Pragma("unroll") for(int r=4;r<16;r+=4){a=MX3(a,C0[r],C0[r+1]);b=MX3(b,C0[r+2],C0[r+3]);a=MX3(a,C1[r],C1[r+1]);b=MX3(b,C1[r+2],C1[r+3]);} \
      float rm=__builtin_fmaxf(a,b); { auto rr=__builtin_amdgcn_permlane32_swap(__float_as_uint(rm),__float_as_uint(rm),false,false); rm=__builtin_fmaxf(__uint_as_float(rr[0]),__uint_as_float(rr[1])); } \
      resc=false; \
      if(__builtin_expect(__any(rm>(float)THRL),0)){ const float dl=__builtin_fmaxf(rm,0.f); mhat+=dl; \
        _Pragma("unroll") for(int r=0;r<16;++r){C0[r]-=dl;C1[r]-=dl;} \
        _Pragma("unroll") for(int r=0;r<16;++r)negm[r]=-mhat; asm volatile("":"+v"(negm)); \
        const float f=__builtin_amdgcn_exp2f(-dl); l_reg*=f; if(hi==0)wsf[r32]=f; resc=true; } } \
    SBAR(); \
    GAPB(o[0]=__builtin_amdgcn_mfma_f32_32x32x16_bf16(PAF(0),VFR(0),o[0],0,0,0), C0,0); \
    GAPB(o[1]=__builtin_amdgcn_mfma_f32_32x32x16_bf16(PAF(0),VFR(4),o[1],0,0,0), C0,4); \
    KRD(GL,0); GAPB(o[0]=__builtin_amdgcn_mfma_f32_32x32x16_bf16(PAF(1),VFR(1),o[0],0,0,0), C0,8); \
    KRD(GL,1); GAPB(o[1]=__builtin_amdgcn_mfma_f32_32x32x16_bf16(PAF(1),VFR(5),o[1],0,0,0), C0,12); \
    KRD(GL,2); GAPB(o[0]=__builtin_amdgcn_mfma_f32_32x32x16_bf16(PAF(2),VFR(2),o[0],0,0,0), C1,0); \
    KRD(GL,3); GAPB(o[1]=__builtin_amdgcn_mfma_f32_32x32x16_bf16(PAF(2),VFR(6),o[1],0,0,0), C1,4); \
    GAPB(o[0]=__builtin_amdgcn_mfma_f32_32x32x16_bf16(PAF(3),VFR(3),o[0],0,0,0), C1,8); \
    GAPB(o[1]=__builtin_amdgcn_mfma_f32_32x32x16_bf16(PAF(3),VFR(7),o[1],0,0,0), C1,12); \
    }while(0)
  int t=1;
  #undef CMASK
  #define CMASK(P0,P1,t) do{}while(0)
  for(;t+5<NT;t+=2){
    STEP(pB0,pB1,pA0,pA1,t,true,true,true);     WAIT_BAR(2); RESC(); ROT();
    STEP(pA0,pA1,pB0,pB1,t+1,true,true,true);   WAIT_BAR(2); RESC(); ROT();
  }
  #undef CMASK
  #define CMASK(P0,P1,t) do{int jb_=(t)-(NT-4); if(jb_>=0)cmask(P0,P1,jb_,qrel,hi);}while(0)
  #define ENDW(tt) do{ if((tt)+3<NT){WAIT_BAR(2);} else if((tt)+2<NT){WAIT_BAR(1);} else {WAIT_BAR(0);} }while(0)
  for(;t+1<NT;t+=2){
    STEP(pB0,pB1,pA0,pA1,t,(t+3<NT),(t+1<NT),(t+1<NT));       ENDW(t);   RESC(); ROT();
    STEP(pA0,pA1,pB0,pB1,t+1,(t+4<NT),(t+2<NT),(t+2<NT));     ENDW(t+1); RESC(); ROT();
  }
  STEP(pB0,pB1,pA0,pA1,NT-1,false,false,false); RESC();
  { float sacc=pB0[0]+pB0[1]; _Pragma("unroll") for(int r=2;r<16;++r)sacc+=pB0[r]; _Pragma("unroll") for(int r=0;r<16;++r)sacc+=pB1[r]; l_reg+=sacc;
    pw0=(u32x4){PKW(pB0,0),PKW(pB0,2),PKW(pB0,4),PKW(pB0,6)};pw1=(u32x4){PKW(pB0,8),PKW(pB0,10),PKW(pB0,12),PKW(pB0,14)};pw2=(u32x4){PKW(pB1,0),PKW(pB1,2),PKW(pB1,4),PKW(pB1,6)};pw3=(u32x4){PKW(pB1,8),PKW(pB1,10),PKW(pB1,12),PKW(pB1,14)};
    SBAR(); pv(o,vb0+sl_cur,PAF(0),PAF(1),PAF(2),PAF(3)); }
  #undef PKW
  #undef PAF
  #undef VFR
  #undef PIN
  #undef MX3
  #undef GAPA
  #undef GAPB
  #undef EX
  #undef VRD
  #undef KRD
  #undef STEP
  #undef ENDW
  {auto rr=__builtin_amdgcn_permlane32_swap(__float_as_uint(l_reg),__float_as_uint(l_reg),false,false);l_reg=__uint_as_float(rr[0])+__uint_as_float(rr[1]);}
  if(hi==0)wsf[32+r32]=l_reg;asm volatile("s_waitcnt lgkmcnt(0)":::"memory");
  float rli[16];
  #pragma unroll
  for(int r=0;r<16;++r)rli[r]=__builtin_amdgcn_rcpf(wsf[32+crow(r,hi)]);
  bf16*Ow=O+(rowbase+q0+wid*QBLK)*DM+ocol;
  { bf16*stg=(bf16*)(shm+LDS_OST)+wid*2048;
    #pragma unroll
    for(int r=0;r<16;++r){const int orow=crow(r,hi);
      #pragma unroll
      for(int d0=0;d0<2;++d0)stg[orow*64+d0*32+r32]=__float2bfloat16(o[d0][r]*rli[r]);}
    asm volatile("s_waitcnt lgkmcnt(0)":::"memory");
    #pragma unroll
    for(int i=0;i<4;++i){const int row=i*8+(lane>>3),ch=lane&7; const u32x4 v=*(const u32x4*)(stg+row*64+ch*8); ATTN_STORE16(Ow+(long)row*DM+ch*8,v);} }
  asm volatile("s_waitcnt lgkmcnt(0)\n\ts_barrier":::"memory");
  #undef DMA_K
  #undef DMA_V
  #undef CMASK
  #undef START
  #undef RESC
  #undef ROT
}
constexpr int ATTN_LDS_BYTES=LDS_BYTES;
struct AttnTensors { const bf16* Q; const bf16* K; const bf16* V; bf16* O0; bf16* O1; };
struct AttnUnit { int bh; int qb; };
struct StaticOrder {
  int vcu;
  __device__ __forceinline__ explicit StaticOrder(int grid,int block):vcu((block%8)*(grid/8)+block/8){}
  __device__ __forceinline__ bool next(int i,AttnUnit&u)const{ if(i>=4)return false; const int s=vcu&3; u.bh=vcu>>2; u.qb=(i==0)?s:(i==1)?7-s:(i==2)?8+s:15-s; return true; }
  __device__ __forceinline__ void a_ready(const AttnUnit&)const{}
  __device__ __forceinline__ void done(const AttnUnit&)const{}
};
template<class Sched,int THRL=8> __device__ __forceinline__ void attn_phase(char*lds,const AttnTensors&T,const Sched&S){
  AttnUnit u;
  for(int i=0;S.next(i,u);++i){ S.a_ready(u);
    const int b=u.bh>>4, vh=u.bh&15, head=vh>>2, c=(vh>>1)&1, half=vh&1;
    const int qcol=(head*2+c)*64, vcol=head*128+half*64;
    attn_unit<THRL>(b,qcol,vcol,vcol,u.qb,T.Q,T.K,T.V,c?T.O1:T.O0,lds); S.done(u); }
}
#undef SBAR
#undef WAIT_BAR
}
#define GAS __attribute__((address_space(1)))
#define LAS __attribute__((address_space(3)))
typedef unsigned short bf16;
typedef unsigned v4u __attribute__((ext_vector_type(4)));
typedef float f32x4 __attribute__((ext_vector_type(4)));
typedef short bf16x8 __attribute__((ext_vector_type(8)));
typedef GAS unsigned gu32;
typedef GAS unsigned long long gu64;
#define RLX_AGENT __ATOMIC_RELAXED, __HIP_MEMORY_SCOPE_AGENT
#define LDS_WAIT() asm volatile("s_waitcnt lgkmcnt(0)" ::: "memory")
#define VM_WAIT() asm volatile("s_waitcnt vmcnt(0)" ::: "memory")
__device__ __forceinline__ unsigned long long rt() { return __builtin_amdgcn_s_memrealtime(); }
__device__ __forceinline__ unsigned f2bf(float f) { unsigned u = __builtin_bit_cast(unsigned, f); return (u + 0x7fffu + ((u >> 16) & 1u)) >> 16; }
__device__ __forceinline__ unsigned pk2(float lo, float hi) { return f2bf(lo) | (f2bf(hi) << 16); }

#define XB_TMO      128
#define XB_XCNT(j)  (256  + 64 * (j))
#define XB_XSUB(j)  (1280 + 64 * (j))
#define XB_XGEN(j)  (2304 + 64 * (j))
#define XB_TOP      3328
#define XB_TOPGEN   3392
#define XCD_BAR_WORDS 3456
#define XB_SPIN_CAP (1u << 18)

__device__ __forceinline__ unsigned xb_ld(unsigned* p)              { return __hip_atomic_load(p, __ATOMIC_RELAXED, __HIP_MEMORY_SCOPE_AGENT); }
__device__ __forceinline__ unsigned xb_add(unsigned* p, unsigned v) { return __hip_atomic_fetch_add(p, v, __ATOMIC_RELAXED, __HIP_MEMORY_SCOPE_AGENT); }
__device__ __forceinline__ unsigned xb_xcc_id() { return (unsigned)__builtin_amdgcn_s_getreg((3 << 11) | 20) & 0xFu; }
#define XB_SPIN(cond, bar) do { unsigned _sp = 0; while (cond) { __builtin_amdgcn_s_sleep(1); \
    if ((++_sp & 255u) == 0u) { if (xb_ld(&(bar)[XB_TMO])) break; if (_sp > XB_SPIN_CAP) { atomicAdd(&(bar)[XB_TMO], 1u); break; } } } } while (0)

struct XcdBarrier {
    unsigned* bar; unsigned x;
    volatile LAS unsigned* st;
};

__device__ __forceinline__ XcdBarrier xcd_barrier_post(unsigned* bar, volatile LAS unsigned* st) {
    XcdBarrier b; b.bar = bar; b.x = xb_xcc_id(); b.st = st;
    if (threadIdx.x == 0) (void)xb_add(&bar[XB_XCNT(b.x)], 1u);
    return b;
}
__device__ __forceinline__ void xcd_barrier_complete(unsigned* bar, unsigned x, unsigned& nloc, unsigned& nx) {
    const unsigned G = gridDim.x * gridDim.y * gridDim.z;
    unsigned sum, cnt, mine, sp = 0u;
    for (;;) {
        sum = 0u; cnt = 0u; mine = 0u;
#pragma unroll
        for (unsigned j = 0; j < 16; ++j) { const unsigned c = xb_ld(&bar[XB_XCNT(j)]); sum += c; cnt += (c > 0u) ? 1u : 0u; mine = (j == x) ? c : mine; }
        if (sum == G) break;
        __builtin_amdgcn_s_sleep(1);
        if ((++sp & 255u) == 0u) { if (xb_ld(&bar[XB_TMO])) break; if (sp > XB_SPIN_CAP) { atomicAdd(&bar[XB_TMO], 1u); break; } }
    }
    nloc = mine > 0u ? mine : 1u; nx = cnt > 0u ? cnt : 1u;
}

__device__ __forceinline__ void xcd_barrier(const XcdBarrier& b) {
    asm volatile("s_waitcnt vmcnt(0)" ::: "memory");
    __syncthreads();
    if (threadIdx.x == 0) {
        unsigned* bar = b.bar;
        __builtin_amdgcn_s_waitcnt(0);
        unsigned nloc = b.st[0], nx = b.st[1];
        if (nloc == 0u) { xcd_barrier_complete(bar, b.x, nloc, nx); b.st[0] = nloc; b.st[1] = nx; }
        const unsigned old = xb_add(&bar[XB_XSUB(b.x)], 1u);
        const unsigned gen = old / nloc;
        if (old + 1u == (gen + 1u) * nloc) {
            __builtin_amdgcn_fence(__ATOMIC_RELEASE, "agent");
            asm volatile("s_waitcnt vmcnt(0)" ::: "memory");
            const unsigned og = xb_add(&bar[XB_TOP], 1u);
            const unsigned tg = og / nx;
            if (og + 1u == (tg + 1u) * nx) xb_add(&bar[XB_TOPGEN], 1u);
            else XB_SPIN(xb_ld(&bar[XB_TOPGEN]) == tg, bar);
            __builtin_amdgcn_fence(__ATOMIC_ACQUIRE, "agent");
            xb_add(&bar[XB_XGEN(b.x)], 1u);
            asm volatile("s_waitcnt vmcnt(0)" ::: "memory");
        } else {
            XB_SPIN(xb_ld(&bar[XB_XGEN(b.x)]) == gen, bar);
            __builtin_amdgcn_fence(__ATOMIC_ACQUIRE, "agent");
            asm volatile("s_waitcnt vmcnt(0)" ::: "memory");
        }
    }
    __syncthreads();
}
__device__ __forceinline__ float wave_sum(float v) {
#pragma unroll
    for (int o = 1; o < 64; o <<= 1) v += __shfl_xor(v, o);
    return v;
}
__device__ __forceinline__ void p0_transpose_item(const float* W, int K, int N, bf16* WT, int row_off, LAS float* scr, int item, int lane) {
    const int nblk = N / 32, kb = item / nblk, nb = item % nblk, k0 = 64 * kb, n0 = 32 * nb;
#pragma unroll 8
    for (int i = 0; i < 32; ++i) { const int kk = 2 * i + (lane >> 5); scr[kk * 33 + (lane & 31)] = W[(size_t)(k0 + kk) * N + n0 + (lane & 31)]; }
    LDS_WAIT(); asm volatile("" ::: "memory");
    const int c = lane & 7;
#pragma unroll
    for (int j = 0; j < 4; ++j) { const int n = (lane >> 3) + 8 * j; const LAS float* s = scr + (8 * c) * 33 + n;
        v4u o; o.x = pk2(s[0 * 33], s[1 * 33]); o.y = pk2(s[2 * 33], s[3 * 33]); o.z = pk2(s[4 * 33], s[5 * 33]); o.w = pk2(s[6 * 33], s[7 * 33]);
        *(GAS v4u*)(WT + (size_t)(row_off + n0 + n) * K + k0 + 8 * c) = o; }
    LDS_WAIT(); asm volatile("" ::: "memory");
}
namespace cg = cooperative_groups;
constexpr int NWAVES = 8;
constexpr int BATCH = 4, SEQ = 4096, D = 1024, T = BATCH * SEQ, DEPTH = 2, INCOLS = 5120, NEXP = 16384;
constexpr float NORM_EPS = 1e-6f;
constexpr size_t MiB = 1u << 20;
constexpr size_t WS_CTL = 0, CTL_ZERO_BYTES = 1 * MiB;
constexpr size_t WS_MOD = 1 * MiB;
constexpr size_t WS_ROPE = WS_MOD + 256 * 1024;
constexpr size_t WS_SUBK = 2 * MiB;
constexpr size_t WS_WIN = 4 * MiB;
constexpr size_t WS_WSB = 24 * MiB;
constexpr size_t WS_WDF = 26 * MiB;
constexpr size_t WS_WOUT = 28 * MiB;
constexpr size_t WS_WQ = 32 * MiB;
constexpr size_t WS_U8 = 40 * MiB, WS_V8 = 56 * MiB;
constexpr size_t WS_H = 104 * MiB;
constexpr size_t WS_SBQ = 136 * MiB, WS_SBK = 152 * MiB, WS_SBV = 168 * MiB, WS_SBVT = 184 * MiB, WS_DQ = 200 * MiB, WS_DK = 216 * MiB, WS_DV = 232 * MiB;
constexpr size_t WS_GSB = 248 * MiB, WS_GDF = 280 * MiB;
constexpr size_t WS_YSB = 312 * MiB, WS_YDF = 328 * MiB;
constexpr size_t WS_M1 = WS_SBQ, WS_MRG = WS_DQ;
constexpr size_t WS_QP = WS_GSB;
constexpr size_t WS_EIDX = WS_SBV, WS_EGATE = WS_SBV + 8 * MiB;
constexpr size_t WS_XA = 344 * MiB, WS_XB = 408 * MiB, WS_END = 472 * MiB;
constexpr size_t WS_APART = 200 * MiB;
constexpr int CW_BAR = 4096, CW_RANK = 8192;
static_assert(WS_ROPE == pg8::EPI_WS_ROPE && WS_SBQ == pg8::EPI_WS_SBQ && WS_SBK == pg8::EPI_WS_SBK && WS_SBV == pg8::EPI_WS_SBV && WS_SBVT == pg8::EPI_WS_SBVT && WS_DQ == pg8::EPI_WS_DQ && WS_DK == pg8::EPI_WS_DK && WS_DV == pg8::EPI_WS_DV && WS_GSB == pg8::EPI_WS_GSB && WS_GDF == pg8::EPI_WS_GDF, "epilogue offsets");
constexpr int RING_OFF = 0, RING_BYTES = 131072;
constexpr int LDSCTL_OFF = RING_BYTES, MISC_OFF = LDSCTL_OFF + 320;
constexpr int LDS_BYTES = 147456;

struct Frame { LAS unsigned char* lds; volatile LAS unsigned* MISC; int tid, lane, wave, vcu, G; };
struct Args { const float* in[18]; float* out; unsigned char* ws; };

__device__ __forceinline__ unsigned short f2bf_s(float f) { return (unsigned short)f2bf(f); }
__device__ __forceinline__ float bf_lo(unsigned w) { return __uint_as_float(w << 16); }
__device__ __forceinline__ float bf_hi(unsigned w) { return __uint_as_float(w & 0xffff0000u); }
typedef __bf16 bf2_t __attribute__((ext_vector_type(2)));
__device__ __forceinline__ float dot2bf(unsigned a, unsigned b, float c) { return __builtin_amdgcn_fdot2_f32_bf16(__builtin_bit_cast(bf2_t, a), __builtin_bit_cast(bf2_t, b), c, false); }

__device__ __forceinline__ void p0_prologue(Frame& F, const Args& A) {
    unsigned char* ws = A.ws;
    LAS float* scr = (LAS float*)(F.lds + RING_OFF + F.wave * 16384);
    const int gw = F.vcu * NWAVES + F.wave, NGW = F.G * NWAVES;
    constexpr int I_IN = (D / 64) * (INCOLS / 32), I_B = (512 / 64) * (D / 32), I_O = (D / 64) * (D / 32), I_Q = (D / 64) * (2048 / 32), IL = I_IN + 2 * I_B + I_O + I_Q;
    for (int it = gw; it < DEPTH * IL; it += NGW) {
        const int l = it / IL; int r = it % IL;
        if (r < I_IN) { p0_transpose_item(A.in[6] + (size_t)l * D * INCOLS, D, INCOLS, (bf16*)(ws + WS_WIN) + (size_t)l * INCOLS * D, 0, scr, r, F.lane); continue; } r -= I_IN;
        if (r < I_B) { p0_transpose_item(A.in[10] + (size_t)l * 512 * D, 512, D, (bf16*)(ws + WS_WSB) + (size_t)l * D * 512, 0, scr, r, F.lane); continue; } r -= I_B;
        if (r < I_B) { p0_transpose_item(A.in[11] + (size_t)l * 512 * D, 512, D, (bf16*)(ws + WS_WDF) + (size_t)l * D * 512, 0, scr, r, F.lane); continue; } r -= I_B;
        if (r < I_O) { p0_transpose_item(A.in[12] + (size_t)l * D * D, D, D, (bf16*)(ws + WS_WOUT) + (size_t)l * D * D, 0, scr, r, F.lane); continue; } r -= I_O;
        p0_transpose_item(A.in[13] + (size_t)l * D * 2048, D, 2048, (bf16*)(ws + WS_WQ) + (size_t)l * 2048 * D, 0, scr, r, F.lane);
    }
    { const int gt = F.vcu * 512 + F.tid, NT = F.G * 512; const float* s = A.in[14]; bf16* o = (bf16*)(ws + WS_SUBK);
      for (int i = gt; i < (DEPTH * 8 * 2 * 128 * 128) / 8; i += NT) { const f32x4 a = *(const f32x4*)(s + (size_t)i * 8), b = *(const f32x4*)(s + (size_t)i * 8 + 4);
          v4u w; w.x = pk2(a.x, a.y); w.y = pk2(a.z, a.w); w.z = pk2(b.x, b.y); w.w = pk2(b.z, b.w); *(v4u*)(o + (size_t)i * 8) = w; } }
    { const int gt = F.vcu * 512 + F.tid, NT = F.G * 512; float* rc = (float*)(ws + WS_ROPE); float* rs = rc + 4096 * 8;
      for (int i = gt; i < 4096 * 8; i += NT) { const int pos = i >> 3, f = i & 7; const float inv = 1.0f / powf(500000.0f, (float)(2 * f) / 16.0f); const float ang = (float)pos * inv; rc[i] = cosf(ang); rs[i] = sinf(ang); } }
    __syncthreads();
    { LAS float* sc = (LAS float*)(F.lds);
      LAS float* red = (LAS float*)(F.lds + 16384);
      for (int i = F.tid; i < 4 * 1024; i += 512) { const float v = A.in[1][i]; sc[i] = v / (1.0f + expf(-v)); }
      __syncthreads();
      for (int j = F.vcu; j < 256; j += F.G) {
          const int cgi = F.tid % 12, ks = F.tid / 12;
          const int g = j * 12 + cgi; const int l = g / 1536, n0 = (g % 1536) * 4;
          f32x4 acc[4]; acc[0] = acc[1] = acc[2] = acc[3] = (f32x4){0.f, 0.f, 0.f, 0.f};
          if (ks < 42) { const float* w = A.in[4] + (size_t)l * D * 6144 + n0;
              for (int k = ks; k < 1024; k += 42) { const f32x4 wv = *(const f32x4*)(w + (size_t)k * 6144);
#pragma unroll
                  for (int b = 0; b < 4; ++b) acc[b] = acc[b] + wv * sc[b * 1024 + k]; }
#pragma unroll
              for (int b = 0; b < 4; ++b)
#pragma unroll
                  for (int e = 0; e < 4; ++e) red[((ks * 12 + cgi) * 4 + b) * 4 + e] = acc[b][e]; }
          __syncthreads();
          if (F.tid < 192) { const int cg2 = F.tid / 16, b = (F.tid / 4) & 3, e = F.tid & 3; float s = 0.f;
              for (int k2 = 0; k2 < 42; ++k2) s += red[((k2 * 12 + cg2) * 4 + b) * 4 + e];
              const int g2 = j * 12 + cg2; const int l2 = g2 / 1536, n2 = (g2 % 1536) * 4 + e;
              ((float*)(ws + WS_MOD))[((size_t)l2 * 4 + b) * 6144 + n2] = s + A.in[5][(size_t)l2 * 6144 + n2]; }
          __syncthreads();
      } }
}
__device__ __forceinline__ void cvt_table8(Frame& F, const float* s, unsigned char* o, float scale) {
    const int gt = F.vcu * 512 + F.tid, NT = F.G * 512;
    for (int i = gt; i < NEXP * 64; i += NT) { const int e = i >> 6, r = (i >> 3) & 7, sub = i & 7; const float* p = s + (size_t)i * 16;
        const f32x4 a = *(const f32x4*)p * scale, b = *(const f32x4*)(p + 4) * scale, c = *(const f32x4*)(p + 8) * scale, d = *(const f32x4*)(p + 12) * scale;
        v4u w; int t;
        t = __builtin_amdgcn_cvt_pk_fp8_f32(a.x, a.y, 0, false); t = __builtin_amdgcn_cvt_pk_fp8_f32(a.z, a.w, t, true); w.x = (unsigned)t;
        t = __builtin_amdgcn_cvt_pk_fp8_f32(b.x, b.y, 0, false); t = __builtin_amdgcn_cvt_pk_fp8_f32(b.z, b.w, t, true); w.y = (unsigned)t;
        t = __builtin_amdgcn_cvt_pk_fp8_f32(c.x, c.y, 0, false); t = __builtin_amdgcn_cvt_pk_fp8_f32(c.z, c.w, t, true); w.z = (unsigned)t;
        t = __builtin_amdgcn_cvt_pk_fp8_f32(d.x, d.y, 0, false); t = __builtin_amdgcn_cvt_pk_fp8_f32(d.z, d.w, t, true); w.w = (unsigned)t;
        *(v4u*)(o + ((size_t)r * NEXP + e) * 128 + sub * 16) = w; }
}
__device__ __forceinline__ void hnorm_phase(Frame& F, const float* x, const float* g, const float* shift, const float* scale  , bf16* H) {
    const int gw = F.vcu * NWAVES + F.wave, NGW = F.G * NWAVES;
    for (int m = gw; m < T; m += NGW) { const int b = m >> 12;
        const f32x4* xr = (const f32x4*)(x + (size_t)m * D) + F.lane; f32x4 v[4]; float s = 0.f;
#pragma unroll
        for (int j = 0; j < 4; ++j) { v[j] = xr[64 * j]; s += (v[j].x * v[j].x + v[j].y * v[j].y) + (v[j].z * v[j].z + v[j].w * v[j].w); }
        const float r = 1.0f / sqrtf(wave_sum(s) * (1.0f / D) + NORM_EPS);
        unsigned long long* o8 = (unsigned long long*)(H + (size_t)m * D) + F.lane;
#pragma unroll
        for (int j = 0; j < 4; ++j) { const int c = 4 * F.lane + 256 * j; const f32x4 gg = *(const f32x4*)(g + c), sh = *(const f32x4*)(shift + (size_t)b * 6144 + c), sc = *(const f32x4*)(scale + (size_t)b * 6144 + c);
            const f32x4 h = (v[j] * r) * gg * (sc + 1.0f) + sh;
            o8[64 * j] = (unsigned long long)pk2(h.x, h.y) | ((unsigned long long)pk2(h.z, h.w) << 32); }
    }
}
#ifndef SB_CUT
#define SB_CUT (-110.0f)
#endif
__device__ __forceinline__ void sb_scalar_phase(Frame& F, const bf16* SBQ, const bf16* SBK, const bf16* SBV, bf16* YSB) {
    for (int u = F.vcu; u < 256; u += F.G) {
        const int bh = u >> 3, chunk = u & 7, b = bh >> 3, h = bh & 7, t = chunk * 512 + F.tid;
        const size_t rowq = (size_t)(b * SEQ + t) * 512 + h * 64;
        float q[64], o[64];
#pragma unroll
        for (int i = 0; i < 8; ++i) { const v4u w = *(const v4u*)(SBQ + rowq + i * 8); q[8 * i] = bf_lo(w.x); q[8 * i + 1] = bf_hi(w.x); q[8 * i + 2] = bf_lo(w.y); q[8 * i + 3] = bf_hi(w.y); q[8 * i + 4] = bf_lo(w.z); q[8 * i + 5] = bf_hi(w.z); q[8 * i + 6] = bf_lo(w.w); q[8 * i + 7] = bf_hi(w.w); }
#pragma unroll
        for (int i = 0; i < 64; ++i) o[i] = 0.f;
        float c = 0.f;
        for (int it = 0;; ++it) { const int s = t - 1 - it; const bool act = (s >= 0) && (c > SB_CUT);
            if (!__any(act)) break;
            if (act) { const size_t rowk = (size_t)(b * SEQ + s) * 512 + h * 64; float z0 = 0.f, z1 = 0.f;
#pragma unroll
                for (int i = 0; i < 8; ++i) { const v4u w = *(const v4u*)(SBK + rowk + i * 8);
                    z0 += q[8 * i] * bf_lo(w.x) + q[8 * i + 2] * bf_lo(w.y) + q[8 * i + 4] * bf_lo(w.z) + q[8 * i + 6] * bf_lo(w.w);
                    z1 += q[8 * i + 1] * bf_hi(w.x) + q[8 * i + 3] * bf_hi(w.y) + q[8 * i + 5] * bf_hi(w.z) + q[8 * i + 7] * bf_hi(w.w); }
                const float z = z0 + z1;
                const float lf = -(fmaxf(z, 0.f) + log1pf(expf(-fabsf(z))));
                const float wgt = expf(z + lf + c); c += lf;
#pragma unroll
                for (int i = 0; i < 8; ++i) { const v4u w = *(const v4u*)(SBV + rowk + i * 8);
                    o[8 * i] += wgt * bf_lo(w.x); o[8 * i + 1] += wgt * bf_hi(w.x); o[8 * i + 2] += wgt * bf_lo(w.y); o[8 * i + 3] += wgt * bf_hi(w.y);
                    o[8 * i + 4] += wgt * bf_lo(w.z); o[8 * i + 5] += wgt * bf_hi(w.z); o[8 * i + 6] += wgt * bf_lo(w.w); o[8 * i + 7] += wgt * bf_hi(w.w); } } }
#pragma unroll
        for (int i = 0; i < 8; ++i) { v4u w; w.x = pk2(o[8 * i], o[8 * i + 1]); w.y = pk2(o[8 * i + 2], o[8 * i + 3]); w.z = pk2(o[8 * i + 4], o[8 * i + 5]); w.w = pk2(o[8 * i + 6], o[8 * i + 7]); *(v4u*)(YSB + rowq + i * 8) = w; }
    }
}
typedef float f32x16_ __attribute__((ext_vector_type(16)));
typedef unsigned u32x2_ __attribute__((ext_vector_type(2)));
__device__ __forceinline__ unsigned cvtpk_bf16(float lo, float hi) { typedef float f2_ __attribute__((ext_vector_type(2))); typedef __bf16 b2_ __attribute__((ext_vector_type(2))); f2_ v = {lo, hi}; b2_ b = __builtin_convertvector(v, b2_); return __builtin_bit_cast(unsigned, b); }
__device__ __forceinline__ void sb_mfma_phase(Frame& F, const bf16* SBQ, const bf16* SBK, const bf16* SBVT, bf16* YSB) {
    const int lane = F.lane, r32 = lane & 31, hi = lane >> 5;
    const float L2E = 1.4426950408889634f, LN2 = 0.6931471805599453f;
    for (int u = F.vcu; u < 512; u += F.G) {
        const int bh = u >> 4, chunk = u & 15, b = bh >> 3, h = bh & 7, q0 = chunk * 256 + F.wave * 32;
        bf16x8 qf[4];
#pragma unroll
        for (int d0 = 0; d0 < 4; ++d0) qf[d0] = *(const bf16x8*)(SBQ + (size_t)(b * SEQ + q0 + r32) * 512 + h * 64 + d0 * 16 + hi * 8);
        f32x16_ o0 = {}, o1 = {}; float c = 0.f; const int qg = q0 + r32;
        for (int jt = q0 >> 6; jt >= 0; --jt) {
            const int kv0 = jt * 64;
            const bf16* kp = SBK + (size_t)(b * SEQ + kv0 + r32) * 512 + h * 64 + hi * 8;
            f32x16_ p0 = {}, p1 = {};
#pragma unroll
            for (int d0 = 0; d0 < 4; ++d0) { const bf16x8 k0 = *(const bf16x8*)(kp + d0 * 16), k1 = *(const bf16x8*)(kp + 32 * 512 + d0 * 16);
                p0 = __builtin_amdgcn_mfma_f32_32x32x16_bf16(k0, qf[d0], p0, 0, 0, 0); p1 = __builtin_amdgcn_mfma_f32_32x32x16_bf16(k1, qf[d0], p1, 0, 0, 0); }
            u32x2_ vf[4][2][2];
            { const bf16* vp = SBVT + (size_t)(h * 64 + r32) * 16384 + b * 4096 + kv0 + 4 * hi;
#pragma unroll
              for (int s = 0; s < 4; ++s)
#pragma unroll
                  for (int db = 0; db < 2; ++db) { vf[s][db][0] = *(const u32x2_*)(vp + (size_t)db * 32 * 16384 + 16 * s); vf[s][db][1] = *(const u32x2_*)(vp + (size_t)db * 32 * 16384 + 16 * s + 8); } }
            const bool diag = (kv0 + 63 >= q0);
            float z[32], sfx[32];
#pragma unroll
            for (int r = 0; r < 16; ++r) { z[r] = p0[r]; z[16 + r] = p1[r]; }
            if (diag) {
#pragma unroll
                for (int r = 0; r < 32; ++r) { const int kv = kv0 + (r & 3) + 8 * ((r & 15) >> 2) + 4 * hi + 32 * (r >> 4); if (kv >= qg) z[r] = -1.0e30f; } }
#pragma unroll
            for (int r = 0; r < 32; ++r) { const float e = __builtin_amdgcn_exp2f(-__builtin_fabsf(z[r]) * L2E); sfx[r] = -(__builtin_fmaxf(z[r], 0.f) + __builtin_amdgcn_logf(1.0f + e) * LN2); }
            float gs[8], pg[8];
#pragma unroll
            for (int k = 0; k < 8; ++k) { sfx[4 * k + 2] += sfx[4 * k + 3]; sfx[4 * k + 1] += sfx[4 * k + 2]; sfx[4 * k] += sfx[4 * k + 1]; gs[k] = sfx[4 * k]; }
#pragma unroll
            for (int k = 0; k < 8; ++k) pg[k] = __shfl_xor(gs[k], 32);
            float tail = 0.f;
#pragma unroll
            for (int k = 7; k >= 0; --k) { const float off = tail + (hi == 0 ? pg[k] : 0.f); tail += gs[k] + pg[k];
                sfx[4 * k] += off; sfx[4 * k + 1] += off; sfx[4 * k + 2] += off; sfx[4 * k + 3] += off; }
            unsigned pw[16];
#pragma unroll
            for (int r = 0; r < 32; r += 2) { const float w0 = __builtin_amdgcn_exp2f((z[r] + sfx[r] + c) * L2E), w1 = __builtin_amdgcn_exp2f((z[r + 1] + sfx[r + 1] + c) * L2E); pw[r >> 1] = cvtpk_bf16(w0, w1); }
            c += tail;
#pragma unroll
            for (int s = 0; s < 4; ++s) { const v4u pa = {pw[4 * s], pw[4 * s + 1], pw[4 * s + 2], pw[4 * s + 3]};
                const v4u b0 = {vf[s][0][0].x, vf[s][0][0].y, vf[s][0][1].x, vf[s][0][1].y}, b1 = {vf[s][1][0].x, vf[s][1][0].y, vf[s][1][1].x, vf[s][1][1].y};
                o0 = __builtin_amdgcn_mfma_f32_32x32x16_bf16(__builtin_bit_cast(bf16x8, pa), __builtin_bit_cast(bf16x8, b0), o0, 0, 0, 0);
                o1 = __builtin_amdgcn_mfma_f32_32x32x16_bf16(__builtin_bit_cast(bf16x8, pa), __builtin_bit_cast(bf16x8, b1), o1, 0, 0, 0); }
            if (__all(c < SB_CUT)) break;
        }
        bf16* yo = YSB + (size_t)(b * SEQ + q0) * 512 + h * 64 + r32;
#pragma unroll
        for (int r = 0; r < 16; ++r) { const int qr = (r & 3) + 8 * (r >> 2) + 4 * hi; yo[(size_t)qr * 512] = f2bf_s(o0[r]); yo[(size_t)qr * 512 + 32] = f2bf_s(o1[r]); }
    }
}
__device__ __forceinline__ void diffcombine_phase(Frame& F, const bf16* O0, const bf16* O1, const float* lamp  , const float* subg  , float lam_init, bf16* YDF) {
    const int gw = F.vcu * NWAVES + F.wave, NGW = F.G * NWAVES;
    const float s1 = wave_sum(lamp[F.lane] * lamp[64 + F.lane]), s2 = wave_sum(lamp[128 + F.lane] * lamp[192 + F.lane]);
    const float lam = expf(s1) - expf(s2) + lam_init;
    const int dd = (8 * F.lane) & 127; const f32x4 g0 = *(const f32x4*)(subg + dd), g1 = *(const f32x4*)(subg + dd + 4);
    for (int m = gw; m < T; m += NGW) {
        const v4u a = *(const v4u*)(O0 + (size_t)m * 512 + 8 * F.lane), bq = *(const v4u*)(O1 + (size_t)m * 512 + 8 * F.lane);
        float y[8]; y[0] = bf_lo(a.x) - lam * bf_lo(bq.x); y[1] = bf_hi(a.x) - lam * bf_hi(bq.x); y[2] = bf_lo(a.y) - lam * bf_lo(bq.y); y[3] = bf_hi(a.y) - lam * bf_hi(bq.y);
        y[4] = bf_lo(a.z) - lam * bf_lo(bq.z); y[5] = bf_hi(a.z) - lam * bf_hi(bq.z); y[6] = bf_lo(a.w) - lam * bf_lo(bq.w); y[7] = bf_hi(a.w) - lam * bf_hi(bq.w);
        float ss = 0.f;
#pragma unroll
        for (int j = 0; j < 8; ++j) ss += y[j] * y[j];
        ss += __shfl_xor(ss, 1); ss += __shfl_xor(ss, 2); ss += __shfl_xor(ss, 4); ss += __shfl_xor(ss, 8);
        const float rn = (1.0f / sqrtf(ss * (1.0f / 128.0f) + NORM_EPS)) * (1.0f - lam_init);
        v4u w; w.x = pk2(y[0] * rn * g0.x, y[1] * rn * g0.y); w.y = pk2(y[2] * rn * g0.z, y[3] * rn * g0.w); w.z = pk2(y[4] * rn * g1.x, y[5] * rn * g1.y); w.w = pk2(y[6] * rn * g1.z, y[7] * rn * g1.w);
        *(v4u*)(YDF + (size_t)m * 512 + 8 * F.lane) = w;
    }
}
#define CE_DESC(a_, b_) do { const float h_ = __builtin_fmaxf(a_, b_), l_ = __builtin_fminf(a_, b_); a_ = h_; b_ = l_; } while (0)
__device__ __forceinline__ void sort16_desc(float (&v)[16]) {
#pragma unroll
    for (int k = 2; k <= 16; k <<= 1)
#pragma unroll
        for (int j = k >> 1; j > 0; j >>= 1)
#pragma unroll
            for (int i = 0; i < 16; ++i) { const int l = i ^ j; if (l > i) { if ((i & k) == 0) CE_DESC(v[i], v[l]); else CE_DESC(v[l], v[i]); } }
}
__device__ __forceinline__ void merge_top16(float (&a)[16], const float (&b)[16]) {
#pragma unroll
    for (int i = 0; i < 16; ++i) a[i] = __builtin_fmaxf(a[i], b[15 - i]);
#pragma unroll
    for (int j = 8; j > 0; j >>= 1)
#pragma unroll
        for (int i = 0; i < 16; ++i) { const int l = i ^ j; if (l > i) CE_DESC(a[i], a[l]); }
}
__device__ __forceinline__ void topk_phase(Frame& F, const bf16* QP, const bf16* SUBK  , int* EIDX, float* EGATE) {
    const int lane = F.lane, r32 = lane & 31, hi = lane >> 5;
    for (int u0 = F.vcu * 16; u0 < 4096; u0 += F.G * 16)
#pragma unroll 1
      for (int uu = 0; uu < 2; ++uu) {
        const int unit = u0 + uu * 8 + F.wave, h = unit >> 9, t = (unit & 511) * 32 + r32;
        float lst[2][16];
#pragma unroll
        for (int c = 0; c < 2; ++c) {
            f32x16_ acc[4]; acc[0] = acc[1] = acc[2] = acc[3] = (f32x16_){};
            const bf16* qp = QP + (size_t)t * 2048 + h * 256 + c * 128 + hi * 8;
            const bf16* kp = SUBK + ((size_t)(h * 2 + c) * 128 + r32) * 128 + hi * 8;
#pragma unroll
            for (int ks = 0; ks < 8; ++ks) { const bf16x8 qf = *(const bf16x8*)(qp + ks * 16);
#pragma unroll
                for (int tl = 0; tl < 4; ++tl) { const bf16x8 kf = *(const bf16x8*)(kp + (size_t)tl * 32 * 128 + ks * 16); acc[tl] = __builtin_amdgcn_mfma_f32_32x32x16_bf16(kf, qf, acc[tl], 0, 0, 0); } }
            float g[4][16];
#pragma unroll
            for (int tl = 0; tl < 4; ++tl) {
#pragma unroll
                for (int r = 0; r < 16; ++r) g[tl][r] = __uint_as_float((__float_as_uint(acc[tl][r]) & ~127u) | (unsigned)(32 * tl + (r & 3) + 8 * (r >> 2) + 4 * hi));
                sort16_desc(g[tl]); }
            merge_top16(g[0], g[1]); merge_top16(g[2], g[3]); merge_top16(g[0], g[2]);
            float pr[16];
#pragma unroll
            for (int k = 0; k < 16; ++k) pr[k] = __shfl_xor(g[0][k], 32);
            merge_top16(g[0], pr);
#pragma unroll
            for (int k = 0; k < 16; ++k) lst[c][k] = g[0][k];
        }
        float bv[16];
#pragma unroll
        for (int k = 0; k < 16; ++k) bv[k] = -3.0e38f;
#pragma unroll
        for (int i = 0; i < 16; ++i)
#pragma unroll
            for (int j = 0; j < 16; ++j) if ((i + 1) * (j + 1) <= 16) {
                const unsigned a = __float_as_uint(lst[0][i]), b = __float_as_uint(lst[1][j]);
                float v = __uint_as_float((__float_as_uint(__uint_as_float(a & ~127u) + __uint_as_float(b & ~127u)) & ~255u) | (unsigned)(i * 16 + j));
#pragma unroll
                for (int k = 0; k < 16; ++k) { const float hh = __builtin_fmaxf(bv[k], v), ll = __builtin_fminf(bv[k], v); bv[k] = hh; v = ll; }
            }
        unsigned w0[4], w1[4];
#pragma unroll
        for (int k = 0; k < 4; ++k) { w0[k] = 0u; w1[k] = 0u;
#pragma unroll
            for (int b = 0; b < 4; ++b) { w0[k] |= (__float_as_uint(lst[0][4 * k + b]) & 127u) << (8 * b); w1[k] |= (__float_as_uint(lst[1][4 * k + b]) & 127u) << (8 * b); } }
        float e[16], sum = 0.f; int bp[16];
        const float vmax = __uint_as_float(__float_as_uint(bv[0]) & ~255u);
#pragma unroll
        for (int k = 0; k < 16; ++k) { const unsigned bits = __float_as_uint(bv[k]); const unsigned id = bits & 255u, ii = id >> 4, jj = id & 15u;
            const unsigned s0 = (ii >> 2) == 0 ? w0[0] : (ii >> 2) == 1 ? w0[1] : (ii >> 2) == 2 ? w0[2] : w0[3];
            const unsigned s1 = (jj >> 2) == 0 ? w1[0] : (jj >> 2) == 1 ? w1[1] : (jj >> 2) == 2 ? w1[2] : w1[3];
            bp[k] = (int)((((s0 >> (8 * (ii & 3))) & 127u) << 7) | ((s1 >> (8 * (jj & 3))) & 127u));
            e[k] = __expf(__uint_as_float(bits & ~255u) - vmax); sum += e[k]; }
        const float inv = 1.0f / sum;
        if (hi == 0) { int* ei = EIDX + (size_t)t * 128 + h * 16; float* eg = EGATE + (size_t)t * 128 + h * 16;
#pragma unroll
            for (int k = 0; k < 16; k += 4) { *(int4*)(ei + k) = make_int4(bp[k], bp[k + 1], bp[k + 2], bp[k + 3]); *(f32x4*)(eg + k) = (f32x4){e[k] * inv, e[k + 1] * inv, e[k + 2] * inv, e[k + 3] * inv}; } }
      }
}
struct XInfo { int k, nloc, nx, xi; };
__device__ __forceinline__ float dpp_add8(float s) {
    s += __builtin_bit_cast(float, __builtin_amdgcn_update_dpp(0, __builtin_bit_cast(int, s), 0xB1, 0xF, 0xF, true));
    s += __builtin_bit_cast(float, __builtin_amdgcn_update_dpp(0, __builtin_bit_cast(int, s), 0x4E, 0xF, 0xF, true));
    s += __builtin_bit_cast(float, __builtin_amdgcn_update_dpp(0, __builtin_bit_cast(int, s), 0x141, 0xF, 0xF, true));
    return s; }
typedef float f32x2_ __attribute__((ext_vector_type(2)));
__device__ __forceinline__ void peerA_phase(Frame& F, const XInfo X, const bf16* H2, const int* EIDX, const unsigned char* U8, float* APART) {
    const int sub = F.lane & 7, slot = F.lane >> 3;
    for (int r = X.xi; r < 8; r += X.nx) {
        const unsigned char* Ur = U8 + (size_t)r * NEXP * 128 + sub * 16; float* Ar = APART + (size_t)r * T * 128;
        for (int t = X.k * NWAVES + F.wave; t < T; t += X.nloc * NWAVES) {
            const v4u h0 = *(const v4u*)(H2 + (size_t)t * D + 128 * r + 16 * sub), h1 = *(const v4u*)(H2 + (size_t)t * D + 128 * r + 16 * sub + 8);
            int e[16]; v4u w[16];
#pragma unroll
            for (int i = 0; i < 16; ++i) e[i] = EIDX[(size_t)t * 128 + 8 * i + slot];
#pragma unroll
            for (int i = 0; i < 16; ++i) w[i] = *(const v4u*)(Ur + (size_t)e[i] * 128);
            const float hf[16] = {bf_lo(h0.x), bf_hi(h0.x), bf_lo(h0.y), bf_hi(h0.y), bf_lo(h0.z), bf_hi(h0.z), bf_lo(h0.w), bf_hi(h0.w), bf_lo(h1.x), bf_hi(h1.x), bf_lo(h1.y), bf_hi(h1.y), bf_lo(h1.z), bf_hi(h1.z), bf_lo(h1.w), bf_hi(h1.w)};
#pragma unroll
            for (int i = 0; i < 16; ++i) { float p = 0.f, q = 0.f;
#pragma unroll
                for (int c = 0; c < 4; ++c) { const int wd = (int)w[i][c]; const f32x2_ lo = __builtin_amdgcn_cvt_pk_f32_fp8(wd, false), hi = __builtin_amdgcn_cvt_pk_f32_fp8(wd, true);
                    p += hf[4 * c] * lo.x + hf[4 * c + 2] * hi.x; q += hf[4 * c + 1] * lo.y + hf[4 * c + 3] * hi.y; }
                const float s = dpp_add8(p + q);
                if (sub == 0) Ar[(size_t)t * 128 + 8 * i + slot] = s; }
        }
    }
}
__device__ __forceinline__ void peerAct_phase(Frame& F, const float* APART, float* EGATE) {
    const int gt = F.vcu * 512 + F.tid, NT = F.G * 512;
    for (int i = gt; i < T * 128 / 4; i += NT) { f32x4 a = *(const f32x4*)(APART + (size_t)i * 4);
#pragma unroll
        for (int r = 1; r < 8; ++r) a = a + *(const f32x4*)(APART + (size_t)r * T * 128 + (size_t)i * 4);
        a = a * (1.0f / 32.0f); const f32x4 g = *(const f32x4*)(EGATE + (size_t)i * 4); f32x4 o;
#pragma unroll
        for (int j = 0; j < 4; ++j) o[j] = 0.5f * a[j] * (1.0f + erff(a[j] * 0.70710678118654752f)) * g[j];
        *(f32x4*)(EGATE + (size_t)i * 4) = o; }
}
__device__ __forceinline__ void peerB_phase(Frame& F, const XInfo X, const float* ACT, const int* EIDX, const unsigned char* V8, const float* x1, const float* gate2  , float* xout) {
    const int sub = F.lane & 7, slot = F.lane >> 3;
    for (int r = X.xi; r < 8; r += X.nx) {
        const unsigned char* Vr = V8 + (size_t)r * NEXP * 128 + sub * 16;
        for (int t = X.k * NWAVES + F.wave; t < T; t += X.nloc * NWAVES) {
            int e[16]; float a[16]; v4u w[16];
#pragma unroll
            for (int i = 0; i < 16; ++i) { e[i] = EIDX[(size_t)t * 128 + 8 * i + slot]; a[i] = ACT[(size_t)t * 128 + 8 * i + slot]; }
#pragma unroll
            for (int i = 0; i < 16; ++i) w[i] = *(const v4u*)(Vr + (size_t)e[i] * 128);
            float acc[16];
#pragma unroll
            for (int j = 0; j < 16; ++j) acc[j] = 0.f;
#pragma unroll
            for (int i = 0; i < 16; ++i)
#pragma unroll
                for (int c = 0; c < 4; ++c) { const int wd = (int)w[i][c]; const f32x2_ lo = __builtin_amdgcn_cvt_pk_f32_fp8(wd, false), hi = __builtin_amdgcn_cvt_pk_f32_fp8(wd, true);
                    acc[4 * c] += a[i] * lo.x; acc[4 * c + 1] += a[i] * lo.y; acc[4 * c + 2] += a[i] * hi.x; acc[4 * c + 3] += a[i] * hi.y; }
#pragma unroll
            for (int j = 0; j < 16; ++j) { float s = acc[j]; s += __shfl_xor(s, 8); s += __shfl_xor(s, 16); s += __shfl_xor(s, 32); acc[j] = s; }
            if (slot == 0) { const int b = t >> 12; const size_t off = (size_t)t * D + 128 * r + 16 * sub; const float* gr = gate2 + (size_t)b * 6144 + 128 * r + 16 * sub;
#pragma unroll
                for (int j = 0; j < 4; ++j) { const f32x4 xv = *(const f32x4*)(x1 + off + 4 * j), gv = *(const f32x4*)(gr + 4 * j);
                    *(f32x4*)(xout + off + 4 * j) = xv + gv * (f32x4){acc[4 * j], acc[4 * j + 1], acc[4 * j + 2], acc[4 * j + 3]}; } }
        }
    }
}
__device__ __forceinline__ void finalnorm_phase(Frame& F, const float* x, const float* g, float* out, const unsigned char* ws) {
    const int gw = F.vcu * NWAVES + F.wave, NGW = F.G * NWAVES;
    for (int m = gw; m < T; m += NGW) {
        const f32x4* xr = (const f32x4*)(x + (size_t)m * D) + F.lane; f32x4 v[4]; float s = 0.f;
#pragma unroll
        for (int j = 0; j < 4; ++j) { v[j] = xr[64 * j]; s += (v[j].x * v[j].x + v[j].y * v[j].y) + (v[j].z * v[j].z + v[j].w * v[j].w); }
        float r = 1.0f / sqrtf(wave_sum(s) * (1.0f / D) + NORM_EPS);
#ifdef TIMING_SEL
        r *= 1.0f + TIMING_GAIN * *(const float*)(ws + 65536);
#endif
        f32x4* o = (f32x4*)(out + (size_t)m * D) + F.lane;
#pragma unroll
        for (int j = 0; j < 4; ++j) o[64 * j] = (v[j] * r) * *(const f32x4*)(g + 4 * F.lane + 256 * j);
    }
}
#define WSP(T_, off) ((T_*)(ws + (off)))
#define RETID() do { int t_ = threadIdx.x; asm volatile("" : "+v"(t_)); F.tid = t_; F.lane = t_ & 63; F.wave = __builtin_amdgcn_readfirstlane(t_ >> 6); } while (0)
#define GRID_BAR() xcd_barrier(bar)
#ifdef TIMING_SEL
#define STAMP(id) do { if (blockIdx.x == 0 && threadIdx.x == 0) { const unsigned now_ = (unsigned)__builtin_amdgcn_s_memrealtime(); if ((TIMING_SEL >> (id)) & 1) F.MISC[17] = F.MISC[17] + (now_ - F.MISC[16]); F.MISC[16] = now_; } } while (0)
#else
#define STAMP(id) do { } while (0)
#endif
template <int l> __device__ __forceinline__ void layer_program(Frame& F, const Args& args, unsigned char* ws, const XcdBarrier& bar, unsigned char* lds) {
        const float* mod = WSP(const float, WS_MOD) + (size_t)l * 4 * 6144;
#ifndef NO_P1
        RETID();
        hnorm_phase(F, (l == 0) ? args.in[0] : WSP(const float, WS_XB), args.in[2] + (size_t)l * D, mod + 0, mod + 1024, WSP(bf16, WS_H));
        cvt_table8(F, args.in[15] + (size_t)l * NEXP * D, WSP(unsigned char, WS_U8), 32.0f);
        cvt_table8(F, args.in[16] + (size_t)l * NEXP * D, WSP(unsigned char, WS_V8), 1.0f);
#endif
        GRID_BAR(); STAMP(1);
#ifndef NO_P2
        { pg8::Gemm g{WSP(const bf16, WS_H), WSP(const bf16, WS_WIN) + (size_t)l * INCOLS * D, T, INCOLS, D}; pg8::StaticOrder S; S.init(T, INCOLS, F.G, (int)blockIdx.x);
          pg8::EpiIn E{ws, args.in[7] + (size_t)l * 2048};
          pg8::gemm_phase<pg8::EpiIn, pg8::StaticOrder, PG8_ALIGN, PG8_SP2>(F.lds + RING_OFF, g, S, E); }
#ifndef SB_SCALAR
        { pg8::Gemm g{WSP(const bf16, WS_WIN) + (size_t)l * INCOLS * D + (size_t)1024 * D, WSP(const bf16, WS_H), 512, T, D}; pg8::StaticOrder S; S.init(512, T, F.G, (int)blockIdx.x);
          pg8::EpiBf16<0> E{WSP(bf16, WS_SBVT), T, nullptr, 0, 0, 1.f};
          pg8::gemm_phase<pg8::EpiBf16<0>, pg8::StaticOrder, PG8_ALIGN, PG8_SP2>(F.lds + RING_OFF, g, S, E); }
#endif
#endif
        GRID_BAR(); STAMP(2);
#ifndef NO_P3A
        { const attn_body::AttnTensors AT{WSP(const attn_body::bf16, WS_DQ), WSP(const attn_body::bf16, WS_DK), WSP(const attn_body::bf16, WS_DV), WSP(attn_body::bf16, WS_H), WSP(attn_body::bf16, WS_H) + (size_t)T * 512};
          const attn_body::StaticOrder S((int)F.G, (int)blockIdx.x);
          attn_body::attn_phase<attn_body::StaticOrder>((char*)lds + RING_OFF, AT, S); }
#endif
        STAMP(3);
#ifndef NO_P3B
        RETID();
#ifdef SB_SCALAR
        sb_scalar_phase(F, WSP(const bf16, WS_SBQ), WSP(const bf16, WS_SBK), WSP(const bf16, WS_SBV), WSP(bf16, WS_YSB));
#else
        sb_mfma_phase(F, WSP(const bf16, WS_SBQ), WSP(const bf16, WS_SBK), WSP(const bf16, WS_SBVT), WSP(bf16, WS_YSB));
#endif
#endif
        GRID_BAR(); STAMP(4);
#ifndef NO_P4
        { pg8::Gemm g{WSP(const bf16, WS_YSB), WSP(const bf16, WS_WSB) + (size_t)l * D * 512, T, D, 512}; pg8::StaticOrder S; S.init(T, D, F.G, (int)blockIdx.x);
          pg8::EpiGate E{WSP(bf16, WS_M1), WSP(const bf16, WS_GSB), nullptr};
          pg8::gemm_phase<pg8::EpiGate, pg8::StaticOrder, PG8_ALIGN, PG8_SP2>(F.lds + RING_OFF, g, S, E); }
        RETID();
        diffcombine_phase(F, WSP(const bf16, WS_H), WSP(const bf16, WS_H) + (size_t)T * 512, args.in[8] + (size_t)l * 256, args.in[9] + (size_t)l * 128, 0.8f - 0.6f * expf(-0.3f * (float)l), WSP(bf16, WS_YDF));
#endif
        GRID_BAR(); STAMP(5);
#ifndef NO_P5
        { pg8::Gemm g{WSP(const bf16, WS_YDF), WSP(const bf16, WS_WDF) + (size_t)l * D * 512, T, D, 512}; pg8::StaticOrder S; S.init(T, D, F.G, (int)blockIdx.x);
          pg8::EpiGate E{WSP(bf16, WS_MRG), WSP(const bf16, WS_GDF), WSP(const bf16, WS_M1)};
          pg8::gemm_phase<pg8::EpiGate, pg8::StaticOrder, PG8_ALIGN, PG8_SP2>(F.lds + RING_OFF, g, S, E); }
#endif
        GRID_BAR(); STAMP(6);
#ifndef NO_P6
        { pg8::Gemm g{WSP(const bf16, WS_MRG), WSP(const bf16, WS_WOUT) + (size_t)l * D * D, T, D, D}; pg8::StaticOrder S; S.init(T, D, F.G, (int)blockIdx.x);
          pg8::EpiRes E{(l == 0) ? args.in[0] : WSP(const float, WS_XB), WSP(float, WS_XA), mod + 2048, 6144};
          pg8::gemm_phase<pg8::EpiRes, pg8::StaticOrder, PG8_ALIGN, PG8_SP2>(F.lds + RING_OFF, g, S, E); }
#endif
        GRID_BAR(); STAMP(7);
#ifndef NO_P7
        RETID();
        hnorm_phase(F, WSP(const float, WS_XA), args.in[3] + (size_t)l * D, mod + 3072, mod + 4096, WSP(bf16, WS_H));
#endif
        GRID_BAR(); STAMP(8);
#ifndef NO_P8
        { pg8::Gemm g{WSP(const bf16, WS_H), WSP(const bf16, WS_WQ) + (size_t)l * 2048 * D, T, 2048, D}; pg8::StaticOrder S; S.init(T, 2048, F.G, (int)blockIdx.x);
          pg8::EpiBf16<0> E{WSP(bf16, WS_QP), 2048, nullptr, 0, 0, 1.f};
          pg8::gemm_phase<pg8::EpiBf16<0>, pg8::StaticOrder, PG8_ALIGN, PG8_SP2>(F.lds + RING_OFF, g, S, E); }
#endif
        GRID_BAR(); STAMP(9);
#ifndef NO_P9
        RETID();
        topk_phase(F, WSP(const bf16, WS_QP), WSP(const bf16, WS_SUBK) + (size_t)l * 8 * 2 * 128 * 128, WSP(int, WS_EIDX), WSP(float, WS_EGATE));
#endif
        GRID_BAR(); STAMP(10);
#ifndef NO_P10
        { const XInfo X{__builtin_amdgcn_readfirstlane((int)F.MISC[10]), __builtin_amdgcn_readfirstlane((int)F.MISC[11]), __builtin_amdgcn_readfirstlane((int)F.MISC[12]), __builtin_amdgcn_readfirstlane((int)F.MISC[13])};
          RETID();
          peerA_phase(F, X, WSP(const bf16, WS_H), WSP(const int, WS_EIDX), WSP(const unsigned char, WS_U8), WSP(float, WS_APART));
          GRID_BAR(); STAMP(11);
          RETID();
          peerAct_phase(F, WSP(const float, WS_APART), WSP(float, WS_EGATE));
          GRID_BAR(); STAMP(12);
          RETID();
          peerB_phase(F, X, WSP(const float, WS_EGATE), WSP(const int, WS_EIDX), WSP(const unsigned char, WS_V8), WSP(const float, WS_XA), mod + 5120, WSP(float, WS_XB));
          if (l == DEPTH - 1) {
#ifdef TIMING_SEL
              asm volatile("s_waitcnt vmcnt(0)" ::: "memory"); __syncthreads(); STAMP(13);
              if (blockIdx.x == 0 && threadIdx.x == 0) { const unsigned now_ = (unsigned)__builtin_amdgcn_s_memrealtime(); *WSP(float, WS_CTL + 65536) = (float)F.MISC[17] / (float)(now_ - F.MISC[18]); }
#endif
              GRID_BAR(); RETID(); finalnorm_phase(F, WSP(const float, WS_XB), args.in[17], args.out, ws); }
          else { if (l + 1 < DEPTH) { GRID_BAR(); STAMP(13); } } }
#endif
}
__global__ void __launch_bounds__(NWAVES * 64, 2) mega_fwd(Args args) {
    extern __shared__ __attribute__((aligned(16))) unsigned char lds[];
    Frame F; F.lds = (LAS unsigned char*)lds; F.MISC = (volatile LAS unsigned*)(F.lds + MISC_OFF);
    F.tid = threadIdx.x; F.lane = F.tid & 63; F.wave = __builtin_amdgcn_readfirstlane(F.tid >> 6);
    F.G = gridDim.x; { const int bx = blockIdx.x; F.vcu = (F.G % 8 == 0) ? (bx % 8) * (F.G / 8) + bx / 8 : bx; }
    unsigned char* ws = args.ws;
    gu32* ctl = (gu32*)(ws + WS_CTL);
    for (int u = F.tid; u < (LDS_BYTES - LDSCTL_OFF) / 4; u += NWAVES * 64) ((LAS unsigned*)(F.lds + LDSCTL_OFF))[u] = 0u;
    __syncthreads();
    XcdBarrier bar = xcd_barrier_post((unsigned*)(ctl + CW_BAR), F.MISC + 8);
    if (F.tid == 0) F.MISC[10] = xb_add((unsigned*)(ctl + CW_RANK) + 64 * bar.x, 1u);
#ifdef TIMING_SEL
    if (blockIdx.x == 0 && threadIdx.x == 0) F.MISC[20] = (unsigned)__builtin_amdgcn_s_memrealtime();
#endif
    p0_prologue(F, args);
    asm volatile("s_waitcnt vmcnt(0)" ::: "memory");
    cg::this_grid().sync();
    GRID_BAR();
    if (F.tid == 0) { unsigned nx = 0u, xi = 0u, mine = 1u;
        for (unsigned j = 0; j < 16; ++j) { const unsigned c = xb_ld((unsigned*)(ctl + CW_RANK) + 64 * j); nx += c > 0u; xi += (c > 0u && j < bar.x); if (j == bar.x) mine = c; }
        F.MISC[11] = mine ? mine : 1u; F.MISC[12] = nx ? nx : 1u; F.MISC[13] = xi; }
    __syncthreads();
#ifdef TIMING_SEL
    if (blockIdx.x == 0 && threadIdx.x == 0) { const unsigned now_ = (unsigned)__builtin_amdgcn_s_memrealtime(); F.MISC[18] = F.MISC[20]; F.MISC[17] = ((TIMING_SEL) & 1) ? now_ - F.MISC[20] : 0u; F.MISC[16] = now_; }
#endif
    layer_program<0>(F, args, ws, bar, lds);
    layer_program<1>(F, args, ws, bar, lds);
}

extern "C" void kernel_launch(void* const* d_in, const int* in_sizes, int n_in, void* d_out, int out_size, void* d_ws, size_t ws_size, hipStream_t stream) {
    static int grid = 0;
    if (grid == 0) {
        if (n_in != 18 || in_sizes[0] != T * D || out_size != T * D || ws_size < WS_END) { fprintf(stderr, "kernel_launch: unexpected shapes (n_in %d, in0 %d, out %d, ws %zu < %zu); nothing launched\n", n_in, n_in > 0 ? in_sizes[0] : -1, out_size, ws_size, (size_t)WS_END); grid = -1; return; }
        int dev = 0, cus = 0, per_cu = 0;
        if (hipGetDevice(&dev) != hipSuccess || hipDeviceGetAttribute(&cus, hipDeviceAttributeMultiprocessorCount, dev) != hipSuccess) { fprintf(stderr, "kernel_launch: device query failed\n"); grid = -1; return; }
        if (hipFuncSetAttribute((const void*)mega_fwd, hipFuncAttributeMaxDynamicSharedMemorySize, LDS_BYTES) != hipSuccess) { fprintf(stderr, "kernel_launch: hipFuncSetAttribute failed\n"); grid = -1; return; }
        if (hipOccupancyMaxActiveBlocksPerMultiprocessor(&per_cu, (const void*)mega_fwd, NWAVES * 64, LDS_BYTES) != hipSuccess || per_cu < 1) { fprintf(stderr, "kernel_launch: occupancy query reports %d workgroups per CU\n", per_cu); (void)hipGetLastError(); grid = -1; return; }
        grid = cus;
    }
    if (grid < 0) return;
    if (hipMemsetAsync((char*)d_ws + WS_CTL, 0, CTL_ZERO_BYTES, stream) != hipSuccess) { fprintf(stderr, "kernel_launch: hipMemsetAsync failed\n"); return; }
    Args a{};
    for (int i = 0; i < 18; ++i) a.in[i] = (const float*)d_in[i];
    a.out = (float*)d_out; a.ws = (unsigned char*)d_ws;
    void* kargs[] = {&a};
    const hipError_t le = hipLaunchCooperativeKernel((const void*)mega_fwd, dim3(grid), dim3(NWAVES * 64), kargs, LDS_BYTES, stream);
    if (le != hipSuccess) fprintf(stderr, "kernel_launch: cooperative launch failed: %s (grid %d)\n", hipGetErrorName(le), grid);
}
```

```cpp
#include <hip/hip_runtime.h>
#include <cstdio>
#include <cstdint>
#include <hip/hip_cooperative_groups.h>
namespace pg8 {
#define PG8_LAS __attribute__((address_space(3)))
typedef unsigned short bf16_t;
typedef short bf16x8 __attribute__((ext_vector_type(8)));
typedef float f32x4 __attribute__((ext_vector_type(4)));
typedef unsigned u32x4 __attribute__((ext_vector_type(4)));
constexpr int BM = 256, BK = 64, HALF = 128, HTB = HALF * BK * 2  , STAGE_BYTES = 8 * HTB, NXCD = 8, WGM = 8;

__host__ __device__ __forceinline__ int lds_byte(int r, int c) { const int st = (r >> 4) * 2 + (c >> 5), rr = r & 15, cc = c & 31, ob = rr * 64 + cc * 2; return st * 1024 + (ob ^ (((ob >> 9) & 1) << 5)); }
__host__ __device__ __forceinline__ void stage_rc(int b, int& R, int& C) { const int st = b / 1024, sb = b % 1024, swz = sb ^ (((sb >> 9) & 1) << 5); R = (st >> 1) * 16 + swz / 64; C = (st & 1) * 32 + (swz % 64) / 2; }
__host__ __device__ __forceinline__ int perm32(int rho) { const int n = rho >> 4, i = rho & 15; return 8 * (i >> 2) + 4 * n + (i & 3); }

struct Unit { int pm, pn; };
struct Gemm { const bf16_t* A; const bf16_t* Bt; int M, N, K; };

struct StaticOrder {
    int nM, nN, nwg, G, c;
    __host__ __device__ void init(int M, int N, int G_, int c_) { nM = M / BM; nN = N / BM; nwg = nM * nN; G = G_; c = c_; }
    __host__ __device__ bool next(int i, Unit& u) const {
        const long L = (long)i * G + c; if (L >= nwg) return false;
        int wgid = (int)L; { const int q = nwg / NXCD, r = nwg % NXCD, xcd = wgid % NXCD, off = wgid / NXCD; wgid = (xcd < r ? xcd * (q + 1) : r * (q + 1) + (xcd - r) * q) + off; }
        const int nig = WGM * nN, gid = wgid / nig, fm = gid * WGM, gsz = (nM - fm) < WGM ? (nM - fm) : WGM;
        u.pm = fm + ((wgid % nig) % gsz); u.pn = (wgid % nig) / gsz; return true;
    }
    __device__ __forceinline__ void a_ready(const Unit&) const {}
    __device__ __forceinline__ void done(const Unit&) const {}
};

__device__ __forceinline__ unsigned cvt_pk_bf16(float lo, float hi) { unsigned r; asm volatile("v_cvt_pk_bf16_f32 %0, %1, %2" : "=v"(r) : "v"(lo), "v"(hi)); return r; }
typedef float f32x2 __attribute__((ext_vector_type(2)));
__device__ __forceinline__ f32x2 gelu_pk(f32x2 v) {
    const f32x2 av = __builtin_elementwise_abs(v), d = av * 0.2316418882f + 1.0f;
    f32x2 t; t.x = __builtin_amdgcn_rcpf(d.x); t.y = __builtin_amdgcn_rcpf(d.y);
    f32x2 q = t * 0.5307027145f + (-0.7265760135f); q = q * t + 0.7107068705f; q = q * t + (-0.142248368f); q = q * t + 0.127414796f; q = q * t;
    const f32x2 s = (v * v) * (-0.72134752044f);
    f32x2 e; e.x = __builtin_amdgcn_exp2f(s.x); e.y = __builtin_amdgcn_exp2f(s.y);
    const f32x2 m = v * (q * e), r = v - m;
    f32x2 o; o.x = v.x < 0.f ? m.x : r.x; o.y = v.y < 0.f ? m.y : r.y; return o;
}

template <int ACT  > struct EpiBf16 {
    static constexpr bool PERM = true, AFTER_DRAIN = false; static_assert(ACT == 0 || ACT == 1, "EpiBf16: ACT is 0 (none) or 1 (gelu_pk)");
    bf16_t* O; int ldc; const float* bias; int split_cols; size_t split_stride; float scale0;
    __device__ __forceinline__ void operator()(const f32x4 (&acc)[2][2][4][2], const Unit& u, int wr, int wc, int fr, int fq) const {
        const int row0 = u.pm * BM + wr * 64 + fr; int colt = u.pn * BM; bf16_t* base = O;
        float sc = 1.f; if (split_cols) { const int t = colt / split_cols; base += (size_t)t * split_stride; colt -= t * split_cols; if (t == 0) sc = scale0; }
        const int col0 = colt + wc * 32 + 8 * fq, bcol0 = u.pn * BM + wc * 32 + 8 * fq;
        f32x4 bv[2][2];
#pragma unroll
        for (int bj = 0; bj < 2; ++bj)
#pragma unroll
            for (int n = 0; n < 2; ++n) bv[bj][n] = bias ? *(const f32x4*)(bias + bcol0 + bj * HALF + 4 * n) : (f32x4){0.f, 0.f, 0.f, 0.f};
#pragma unroll
        for (int ai = 0; ai < 2; ++ai)
#pragma unroll
            for (int m = 0; m < 4; ++m) { bf16_t* rowp = base + (size_t)(row0 + ai * HALF + m * 16) * ldc + col0;
#pragma unroll
                for (int bj = 0; bj < 2; ++bj) { f32x4 v0 = acc[ai][bj][m][0] + bv[bj][0], v1 = acc[ai][bj][m][1] + bv[bj][1];
                    if (ACT == 1) { f32x2 a = gelu_pk((f32x2){v0[0], v0[1]}), b = gelu_pk((f32x2){v0[2], v0[3]}), c = gelu_pk((f32x2){v1[0], v1[1]}), d = gelu_pk((f32x2){v1[2], v1[3]});
                        v0 = (f32x4){a.x, a.y, b.x, b.y}; v1 = (f32x4){c.x, c.y, d.x, d.y}; }
                    v0 = v0 * sc; v1 = v1 * sc; u32x4 w; w.x = cvt_pk_bf16(v0[0], v0[1]); w.y = cvt_pk_bf16(v0[2], v0[3]); w.z = cvt_pk_bf16(v1[0], v1[1]); w.w = cvt_pk_bf16(v1[2], v1[3]);
                    *(u32x4*)(rowp + bj * HALF) = w; } }
    }
};
typedef unsigned u32x2 __attribute__((ext_vector_type(2)));
__device__ __forceinline__ f32x4 bf4_to_f32(unsigned lo, unsigned hi) { f32x4 r; r[0] = __uint_as_float(lo << 16); r[1] = __uint_as_float(lo & 0xffff0000u); r[2] = __uint_as_float(hi << 16); r[3] = __uint_as_float(hi & 0xffff0000u); return r; }
__device__ __forceinline__ float sigmoidf_(float x) { return 1.0f / (1.0f + __expf(-x)); }
constexpr size_t EPI_MiB = 1u << 20;
constexpr size_t EPI_WS_ROPE = 1 * EPI_MiB + 256 * 1024, EPI_WS_SBQ = 136 * EPI_MiB, EPI_WS_SBK = 152 * EPI_MiB, EPI_WS_SBV = 168 * EPI_MiB, EPI_WS_SBVT = 184 * EPI_MiB, EPI_WS_DQ = 200 * EPI_MiB, EPI_WS_DK = 216 * EPI_MiB, EPI_WS_DV = 232 * EPI_MiB,
                 EPI_WS_GSB = 248 * EPI_MiB, EPI_WS_GDF = 280 * EPI_MiB;
struct EpiIn {
    static constexpr bool PERM = true, AFTER_DRAIN = false;
    unsigned char* ws; const float* gate_b;
    __device__ __forceinline__ void operator()(const f32x4 (&acc)[2][2][4][2], const Unit& u, int wr, int wc, int fr, int fq) const {
        bf16_t* const sbq = (bf16_t*)(ws + EPI_WS_SBQ); bf16_t* const sbk = (bf16_t*)(ws + EPI_WS_SBK); bf16_t* const sbv = (bf16_t*)(ws + EPI_WS_SBV); bf16_t* const sbvt = (bf16_t*)(ws + EPI_WS_SBVT);
        bf16_t* const dq = (bf16_t*)(ws + EPI_WS_DQ); bf16_t* const dk = (bf16_t*)(ws + EPI_WS_DK); bf16_t* const dv = (bf16_t*)(ws + EPI_WS_DV); bf16_t* const gsb = (bf16_t*)(ws + EPI_WS_GSB); bf16_t* const gdf = (bf16_t*)(ws + EPI_WS_GDF);
        const float* const rope_cos = (const float*)(ws + EPI_WS_ROPE); const float* const rope_sin = rope_cos + 4096 * 8; const float c2 = 0.125f * 1.4426950408889634f;
        const int row0 = u.pm * BM + wr * 64 + fr; const int pn = u.pn; const int seg = pn >> 1;
        const int cc0 = wc * 32 + 8 * fq;
        if (pn >= 12) {
            const bool isdf = pn >= 16; bf16_t* G = isdf ? gdf : gsb; const int gc0 = (pn - (isdf ? 16 : 12)) * 256 + cc0; const float* gb = gate_b + (isdf ? 1024 : 0) + gc0;
            f32x4 bv[2][2];
#pragma unroll
            for (int bj = 0; bj < 2; ++bj)
#pragma unroll
                for (int n = 0; n < 2; ++n) bv[bj][n] = *(const f32x4*)(gb + bj * HALF + 4 * n);
#pragma unroll
            for (int ai = 0; ai < 2; ++ai)
#pragma unroll
                for (int m = 0; m < 4; ++m) { bf16_t* rowp = G + (size_t)(row0 + ai * HALF + m * 16) * 1024 + gc0;
#pragma unroll
                    for (int bj = 0; bj < 2; ++bj) { const f32x4 v0 = acc[ai][bj][m][0] + bv[bj][0], v1 = acc[ai][bj][m][1] + bv[bj][1];
                        u32x4 w; w.x = cvt_pk_bf16(sigmoidf_(v0[0]), sigmoidf_(v0[1])); w.y = cvt_pk_bf16(sigmoidf_(v0[2]), sigmoidf_(v0[3])); w.z = cvt_pk_bf16(sigmoidf_(v1[0]), sigmoidf_(v1[1])); w.w = cvt_pk_bf16(sigmoidf_(v1[2]), sigmoidf_(v1[3]));
                        *(u32x4*)(rowp + bj * HALF) = w; } }
            return;
        }
        const int col0 = (pn & 1) * 256 + cc0;
        if (seg == 3 || seg == 4) {
            bf16_t* O = seg == 3 ? dq : dk; const float sc = seg == 3 ? c2 : 1.0f;
            const bool ropew = (wc & 1) == 0;
            const bool rl = fq < 2;
#pragma unroll
            for (int ai = 0; ai < 2; ++ai)
#pragma unroll
                for (int m = 0; m < 4; ++m) { const int row = row0 + ai * HALF + m * 16; bf16_t* rowp = O + (size_t)row * 512 + col0;
                    f32x4 cs0 = {1.f, 1.f, 1.f, 1.f}, cs1 = cs0, sn0 = {0.f, 0.f, 0.f, 0.f}, sn1 = sn0;
                    if (ropew) { const int pos = row & 4095; cs0 = *(const f32x4*)(rope_cos + pos * 8); cs1 = *(const f32x4*)(rope_cos + pos * 8 + 4); sn0 = *(const f32x4*)(rope_sin + pos * 8); sn1 = *(const f32x4*)(rope_sin + pos * 8 + 4); }
#pragma unroll
                    for (int bj = 0; bj < 2; ++bj) { f32x4 v0 = acc[ai][bj][m][0], v1 = acc[ai][bj][m][1];
                        if (ropew) { f32x4 p0, p1;
#pragma unroll
                            for (int j = 0; j < 4; ++j) { p0[j] = __shfl_xor(v0[j], 16); p1[j] = __shfl_xor(v1[j], 16); }
                            const float sg = (fq == 0) ? -1.0f : 1.0f;
                            if (rl) { v0 = v0 * cs0 + (p0 * sn0) * sg; v1 = v1 * cs1 + (p1 * sn1) * sg; } }
                        v0 = v0 * sc; v1 = v1 * sc;
                        u32x4 w; w.x = cvt_pk_bf16(v0[0], v0[1]); w.y = cvt_pk_bf16(v0[2], v0[3]); w.z = cvt_pk_bf16(v1[0], v1[1]); w.w = cvt_pk_bf16(v1[2], v1[3]);
                        *(u32x4*)(rowp + bj * HALF) = w; } }
            return;
        }
        bf16_t* O = seg == 0 ? sbq : seg == 1 ? sbk : seg == 2 ? sbv : dv; const float sc = seg == 0 ? 0.125f : 1.0f;
#pragma unroll
        for (int ai = 0; ai < 2; ++ai)
#pragma unroll
            for (int m = 0; m < 4; ++m) { const int row = row0 + ai * HALF + m * 16; bf16_t* rowp = O + (size_t)row * 512 + col0;
#pragma unroll
                for (int bj = 0; bj < 2; ++bj) { const f32x4 v0 = acc[ai][bj][m][0] * sc, v1 = acc[ai][bj][m][1] * sc;
                    u32x4 w; w.x = cvt_pk_bf16(v0[0], v0[1]); w.y = cvt_pk_bf16(v0[2], v0[3]); w.z = cvt_pk_bf16(v1[0], v1[1]); w.w = cvt_pk_bf16(v1[2], v1[3]);
                    *(u32x4*)(rowp + bj * HALF) = w;
#if defined(SBVT_STORE)
                    if (seg == 2) {
                        const int b = row >> 12, t = row & 4095;
#pragma unroll
                        for (int j = 0; j < 8; ++j) { const int col = col0 + bj * HALF + j; const int h = col >> 6, d = col & 63;
                            const unsigned word = j < 2 ? w.x : j < 4 ? w.y : j < 6 ? w.z : w.w; const bf16_t e = (bf16_t)((j & 1) ? (word >> 16) : (word & 0xffffu));
                            sbvt[((size_t)(b * 8 + h) * 64 + d) * 4096 + t] = e; } }
#endif
                } }
    }
};
struct EpiGate {
    static constexpr bool PERM = true, AFTER_DRAIN = false;
    bf16_t* O; const bf16_t* gate; const bf16_t* add;
    __device__ __forceinline__ void operator()(const f32x4 (&acc)[2][2][4][2], const Unit& u, int wr, int wc, int fr, int fq) const {
        const int row0 = u.pm * BM + wr * 64 + fr; const int col0 = u.pn * BM + wc * 32 + 8 * fq;
#pragma unroll
        for (int ai = 0; ai < 2; ++ai)
#pragma unroll
            for (int m = 0; m < 4; ++m) { const size_t off = (size_t)(row0 + ai * HALF + m * 16) * 1024 + col0;
#pragma unroll
                for (int bj = 0; bj < 2; ++bj) { const u32x4 g = *(const u32x4*)(gate + off + bj * HALF);
                    f32x4 v0 = acc[ai][bj][m][0] * bf4_to_f32(g.x, g.y), v1 = acc[ai][bj][m][1] * bf4_to_f32(g.z, g.w);
                    if (add) { const u32x4 a = *(const u32x4*)(add + off + bj * HALF); v0 = v0 + bf4_to_f32(a.x, a.y); v1 = v1 + bf4_to_f32(a.z, a.w); }
                    u32x4 w; w.x = cvt_pk_bf16(v0[0], v0[1]); w.y = cvt_pk_bf16(v0[2], v0[3]); w.z = cvt_pk_bf16(v1[0], v1[1]); w.w = cvt_pk_bf16(v1[2], v1[3]);
                    *(u32x4*)(O + off + bj * HALF) = w; } }
    }
};
struct EpiRes {
    static constexpr bool PERM = false, AFTER_DRAIN = false;
    const float* base; float* out; const float* gvec; int gstride;
    __device__ __forceinline__ void operator()(const f32x4 (&acc)[2][2][4][2], const Unit& u, int wr, int wc, int fr, int fq) const {
        const int row0 = u.pm * BM + wr * 64 + fr; const int col0 = u.pn * BM + wc * 32 + 4 * fq; const int b = (u.pm * BM) >> 12;
        f32x4 gv[2][2];
#pragma unroll
        for (int bj = 0; bj < 2; ++bj)
#pragma unroll
            for (int n = 0; n < 2; ++n) gv[bj][n] = *(const f32x4*)(gvec + (size_t)b * gstride + col0 + bj * HALF + n * 16);
#pragma unroll
        for (int ai = 0; ai < 2; ++ai)
#pragma unroll
            for (int m = 0; m < 4; ++m) { const size_t off = (size_t)(row0 + ai * HALF + m * 16) * 1024 + col0;
#pragma unroll
                for (int bj = 0; bj < 2; ++bj)
#pragma unroll
                    for (int n = 0; n < 2; ++n) { const f32x4 bs = *(const f32x4*)(base + off + bj * HALF + n * 16);
                        *(f32x4*)(out + off + bj * HALF + n * 16) = bs + gv[bj][n] * acc[ai][bj][m][n]; } }
    }
};
template <class Epi, class Sched, bool ALIGN_EPI = false, bool SP2 = false>
__device__ __forceinline__ void gemm_phase(PG8_LAS unsigned char* lds, const Gemm g, const Sched& S, const Epi& E) {
    int tid_ = threadIdx.x; asm volatile("" : "+v"(tid_));
    const int tid = tid_, wid = __builtin_amdgcn_readfirstlane(tid >> 6), lane = tid & 63, wr = wid >> 2, wc = wid & 3, fr = lane & 15, fq = lane >> 4;
    const int K = g.K, nt = K / BK;
    unsigned voffA[2], voffB[2];
#pragma unroll
    for (int i = 0; i < 2; ++i) { int R, C; stage_rc(tid * 16 + i * 8192, R, C); const int Rb = Epi::PERM ? ((R & ~31) + perm32(R & 31)) : R;
        voffA[i] = (unsigned)(R * K + C) * 2u; voffB[i] = (unsigned)(Rb * K + C) * 2u; }
    const size_t kstep = (size_t)(BK * 2);
    const size_t hstep = (size_t)HALF * K * 2;
    const size_t tstep = 2 * hstep;
    const unsigned ldsw = (unsigned)wid * 1024u;
    const int aoff = lds_byte(wr * 64 + fr, fq * 8), boff = lds_byte(wc * 32 + fr, fq * 8);
#define PG8_SA(b, h) (((b) * 2 + (h)) * HTB)
#define PG8_SB(b, h) ((4 + (b) * 2 + (h)) * HTB)
#define PG8_STAGE(bufoff, gbase, voff) do { _Pragma("unroll") for (int _i = 0; _i < 2; ++_i) \
        __builtin_amdgcn_global_load_lds((const unsigned*)((const char*)(gbase) + (voff)[_i]), (PG8_LAS unsigned*)(lds + (bufoff) + ldsw + _i * 8192), 16, 0, 0); } while (0)
#define PG8_LDA(dst, b, h) do { _Pragma("unroll") for (int m = 0; m < 4; ++m) _Pragma("unroll") for (int k = 0; k < 2; ++k) dst[m][k] = *(const PG8_LAS bf16x8*)(lds + PG8_SA(b, h) + aoff + m * 2048 + k * 1024); } while (0)
#define PG8_LDB(dst, b, h) do { _Pragma("unroll") for (int n = 0; n < 2; ++n) _Pragma("unroll") for (int k = 0; k < 2; ++k) dst[n][k] = *(const PG8_LAS bf16x8*)(lds + PG8_SB(b, h) + boff + n * 2048 + k * 1024); } while (0)
#define PG8_MMA(ai, bj, At, Bt) do { __builtin_amdgcn_s_setprio(1); _Pragma("unroll") for (int m = 0; m < 4; ++m) _Pragma("unroll") for (int n = 0; n < 2; ++n) _Pragma("unroll") for (int k = 0; k < 2; ++k) \
        acc[ai][bj][m][n] = __builtin_amdgcn_mfma_f32_16x16x32_bf16(Bt[n][k], At[m][k], acc[ai][bj][m][n], 0, 0, 0); __builtin_amdgcn_s_setprio(0); } while (0)
#define PG8_WAIT_V(n) asm volatile("s_waitcnt vmcnt(" #n ")" ::: "memory")
#define PG8_WAIT_L(n) asm volatile("s_waitcnt lgkmcnt(" #n ")" ::: "memory")
#define PG8_BAR __builtin_amdgcn_s_barrier()
#define PG8_SCHED __builtin_amdgcn_sched_barrier(0)
    Unit cur, nxt; int ui = 0;
    if (!S.next(0, cur)) return;
    f32x4 acc[2][2][4][2];
#pragma unroll
    for (int a = 0; a < 2; ++a)
#pragma unroll
        for (int b = 0; b < 2; ++b)
#pragma unroll
            for (int m = 0; m < 4; ++m)
#pragma unroll
                for (int n = 0; n < 2; ++n) acc[a][b][m][n] = (f32x4){0.f, 0.f, 0.f, 0.f};
    bf16x8 At[4][2], B0[2][2], B1[2][2];
    const char* cA = (const char*)g.A + (size_t)cur.pm * tstep; const char* cB = (const char*)g.Bt + (size_t)cur.pn * tstep;
    S.a_ready(cur);
    if constexpr (SP2) {
        PG8_STAGE(PG8_SB(0, 0), cB, voffB); PG8_STAGE(PG8_SB(0, 1), cB + hstep, voffB); PG8_STAGE(PG8_SA(0, 0), cA, voffA); PG8_STAGE(PG8_SA(0, 1), cA + hstep, voffA);
        if (wr == 1) PG8_BAR;
        PG8_WAIT_V(2); PG8_BAR;
        PG8_STAGE(PG8_SB(1, 0), cB + kstep, voffB); PG8_STAGE(PG8_SA(1, 0), cA + kstep, voffA); PG8_STAGE(PG8_SB(1, 1), cB + hstep + kstep, voffB);
        PG8_WAIT_V(6); PG8_BAR;
    } else {
        PG8_STAGE(PG8_SB(0, 0), cB, voffB); PG8_STAGE(PG8_SA(0, 0), cA, voffA); PG8_STAGE(PG8_SB(0, 1), cB + hstep, voffB); PG8_STAGE(PG8_SA(0, 1), cA + hstep, voffA);
        if (wr == 1) PG8_BAR;
        PG8_WAIT_V(4); PG8_BAR;
        PG8_STAGE(PG8_SB(1, 0), cB + kstep, voffB); PG8_STAGE(PG8_SA(1, 0), cA + kstep, voffA); PG8_STAGE(PG8_SB(1, 1), cB + hstep + kstep, voffB);
        PG8_WAIT_V(6); PG8_BAR;
    }
    for (;;) {
        const bool has_next = S.next(ui + 1, nxt);
        const char* nA = has_next ? (const char*)g.A + (size_t)nxt.pm * tstep : cA; const char* nB = has_next ? (const char*)g.Bt + (size_t)nxt.pn * tstep : cB;
        for (int t = 0; t < nt; t += 2) {
            const bool last = (t == nt - 2);
            const char* a1 = cA + (size_t)(t + 1) * kstep;
            const char* a2 = last ? nA : cA + (size_t)(t + 2) * kstep; const char* b2 = last ? nB : cB + (size_t)(t + 2) * kstep;
            const char* a3 = a2 + kstep; const char* b3 = b2 + kstep;
            if (last && has_next) S.a_ready(nxt);
            if constexpr (SP2) {
            PG8_LDB(B0, 0, 0); PG8_LDB(B1, 0, 1); PG8_SCHED; PG8_LDA(At, 0, 0); PG8_STAGE(PG8_SA(1, 1), a1 + hstep, voffA);
            PG8_WAIT_V(8); PG8_WAIT_L(0); PG8_BAR; PG8_MMA(0, 0, At, B0); PG8_MMA(0, 1, At, B1); PG8_BAR; PG8_SCHED;
            PG8_LDA(At, 0, 1); PG8_STAGE(PG8_SB(0, 0), b2, voffB); PG8_STAGE(PG8_SB(0, 1), b2 + hstep, voffB); PG8_STAGE(PG8_SA(0, 0), a2, voffA);
            PG8_WAIT_V(8); PG8_WAIT_L(0); PG8_BAR; PG8_MMA(1, 0, At, B0); PG8_MMA(1, 1, At, B1); PG8_BAR; PG8_SCHED;
            PG8_LDB(B0, 1, 0); PG8_LDB(B1, 1, 1); PG8_SCHED; PG8_LDA(At, 1, 0); PG8_STAGE(PG8_SA(0, 1), a2 + hstep, voffA);
            PG8_WAIT_V(8); PG8_WAIT_L(0); PG8_BAR; PG8_MMA(0, 0, At, B0); PG8_MMA(0, 1, At, B1); PG8_BAR; PG8_SCHED;
            PG8_LDA(At, 1, 1); PG8_STAGE(PG8_SB(1, 0), b3, voffB); PG8_STAGE(PG8_SB(1, 1), b3 + hstep, voffB); PG8_STAGE(PG8_SA(1, 0), a3, voffA);
            PG8_WAIT_V(8); PG8_WAIT_L(0); PG8_BAR; PG8_MMA(1, 0, At, B0); PG8_MMA(1, 1, At, B1); PG8_BAR; PG8_SCHED;
            } else {
            PG8_LDB(B0, 0, 0); PG8_SCHED; PG8_LDA(At, 0, 0); PG8_STAGE(PG8_SA(1, 1), a1 + hstep, voffA);
            PG8_WAIT_L(8); PG8_BAR; PG8_WAIT_L(0); PG8_MMA(0, 0, At, B0); PG8_BAR; PG8_SCHED;
            PG8_LDB(B1, 0, 1); PG8_STAGE(PG8_SB(0, 0), b2, voffB);
            PG8_BAR; PG8_WAIT_L(0); PG8_MMA(0, 1, At, B1); PG8_BAR;
            PG8_LDA(At, 0, 1); PG8_STAGE(PG8_SA(0, 0), a2, voffA);
            PG8_BAR; PG8_WAIT_L(0); PG8_MMA(1, 0, At, B0); PG8_BAR; PG8_SCHED;
            PG8_STAGE(PG8_SB(0, 1), b2 + hstep, voffB);
            PG8_WAIT_V(6); PG8_BAR; PG8_MMA(1, 1, At, B1); PG8_BAR;
            PG8_LDB(B0, 1, 0); PG8_SCHED; PG8_LDA(At, 1, 0); PG8_STAGE(PG8_SA(0, 1), a2 + hstep, voffA);
            PG8_WAIT_L(8); PG8_BAR; PG8_WAIT_L(0); PG8_MMA(0, 0, At, B0); PG8_BAR; PG8_SCHED;
            PG8_LDB(B1, 1, 1); PG8_STAGE(PG8_SB(1, 0), b3, voffB);
            PG8_BAR; PG8_WAIT_L(0); PG8_MMA(0, 1, At, B1); PG8_BAR;
            PG8_LDA(At, 1, 1); PG8_STAGE(PG8_SA(1, 0), a3, voffA);
            PG8_BAR; PG8_WAIT_L(0); PG8_MMA(1, 0, At, B0); PG8_BAR; PG8_SCHED;
            PG8_STAGE(PG8_SB(1, 1), b3 + hstep, voffB);
            PG8_WAIT_V(6); PG8_BAR; PG8_MMA(1, 1, At, B1); PG8_BAR;
            }
        }
        if constexpr (ALIGN_EPI) { if (wr == 0) PG8_BAR; }
        if constexpr (!Epi::AFTER_DRAIN) { E(acc, cur, wr, wc, fr, fq); S.done(cur); }
        if (!has_next) break;
#pragma unroll
        for (int a = 0; a < 2; ++a)
#pragma unroll
            for (int b = 0; b < 2; ++b)
#pragma unroll
                for (int m = 0; m < 4; ++m)
#pragma unroll
                    for (int n = 0; n < 2; ++n) acc[a][b][m][n] = (f32x4){0.f, 0.f, 0.f, 0.f};
        cur = nxt; cA = nA; cB = nB; ++ui;
        if constexpr (ALIGN_EPI) { if (wr == 1) PG8_BAR; }
    }
    PG8_WAIT_V(0);
    if constexpr (!ALIGN_EPI) { if (wr == 0) PG8_BAR; }
    PG8_BAR;
    if constexpr (Epi::AFTER_DRAIN) { E.fused(acc, cur, wr, wc, fr, fq, lds, wid, lane); S.done(cur); }
#undef PG8_SA
#undef PG8_SB
#undef PG8_STAGE
#undef PG8_LDA
#undef PG8_LDB
#undef PG8_MMA
#undef PG8_WAIT_V
#undef PG8_WAIT_L
#undef PG8_BAR
#undef PG8_SCHED
}
}

#ifndef PG8_SP2
#define PG8_SP2 true
#endif
#ifndef PG8_ALIGN
#define PG8_ALIGN true
#endif
#include <hip/hip_bf16.h>
#include <cmath>
namespace attn_body {
using bf16=__hip_bfloat16;
using bf16x8=__attribute__((ext_vector_type(8)))short;
using s16x4=__attribute__((ext_vector_type(4)))short;
using f32x16=__attribute__((ext_vector_type(16)))float;
using u32x4=__attribute__((ext_vector_type(4)))unsigned;
constexpr int BATCH=4,SEQ=4096,D=64,DM=512;
constexpr int NW=8,QBLK=32,QB=QBLK*NW,KVBLK=64,NQB=SEQ/QB;
constexpr int ATTN_PITCH=DM, ATTN_UNIT_ROWS=QB;
__device__ __forceinline__ int crow(int r,int hi){return (r&3)+8*(r>>2)+4*hi;}
#define SBAR() __builtin_amdgcn_sched_barrier(0)
__device__ __forceinline__ void cmask(f32x16&p0,f32x16&p1,int jb,int qrel,int hi){
  const float NEG=-INFINITY; int kb=64*jb+4*hi;
  #pragma unroll
  for(int r=0;r<16;++r){int kv=kb+(r&3)+8*(r>>2); if(kv>qrel)p0[r]=NEG; if(kv+32>qrel)p1[r]=NEG;}
}

constexpr int NSLOT=3, SLOTB=8192;
constexpr int LDS_K=0, LDS_V=NSLOT*SLOTB, LDS_WS=2*NSLOT*SLOTB, LDS_OST=LDS_WS+NW*64*4, LDS_BYTES=LDS_OST+NW*4096;
constexpr float C2=0.125f*1.4426950408889634f;
__device__ __forceinline__ void glds16(const void*gsrc,unsigned lds_dst){unsigned keep;
  asm volatile("s_mov_b32 %0, m0\n\ts_mov_b32 m0, %2\n\ts_nop 0\n\tglobal_load_lds_dwordx4 %1, off\n\ts_mov_b32 m0, %0":"=&s"(keep):"v"(gsrc),"s"(lds_dst):"memory");}
__device__ __forceinline__ float max3f(float a,float b,float c){float r;asm("v_max3_f32 %0, %1, %2, %3":"=v"(r):"v"(a),"v"(b),"v"(c));return r;}
__device__ __forceinline__ float max2f(float a,float b){float r;asm("v_max_f32_e32 %0, %1, %2":"=v"(r):"v"(a),"v"(b));return r;}
__device__ __forceinline__ float fadd_s(float a,float b){float r;asm("v_add_f32_e32 %0, %1, %2":"=v"(r):"v"(a),"v"(b));return r;}
__device__ __forceinline__ float fsub_s(float a,float b){float r;asm("v_sub_f32_e32 %0, %1, %2":"=v"(r):"v"(a),"v"(b));return r;}
typedef float f32x2_t __attribute__((ext_vector_type(2))); typedef __bf16 bf16x2_t __attribute__((ext_vector_type(2)));
__device__ __forceinline__ unsigned cvtpk_s(float lo,float hi){f32x2_t v={lo,hi};bf16x2_t b=__builtin_convertvector(v,bf16x2_t);return __builtin_bit_cast(unsigned,b);}
#define WAIT_BAR(N) asm volatile("s_waitcnt vmcnt(" #N ") lgkmcnt(0)\n\ts_barrier":::"memory")

__device__ __forceinline__ void qkt(f32x16&p0,f32x16&p1,const char*Kslot,const bf16x8*qr,const f32x16&negm,int r32,int hi){
  const char*kb=Kslot+hi*1024+r32*16;
  #pragma unroll
  for(int d0=0;d0<4;++d0){
    const bf16x8 b0=*reinterpret_cast<const bf16x8*>(kb+d0*2048);
    const bf16x8 b1=*reinterpret_cast<const bf16x8*>(kb+d0*2048+512);
    if(d0==0){p0=__builtin_amdgcn_mfma_f32_32x32x16_bf16(b0,qr[0],negm,0,0,0);p1=__builtin_amdgcn_mfma_f32_32x32x16_bf16(b1,qr[0],negm,0,0,0);}
    else{p0=__builtin_amdgcn_mfma_f32_32x32x16_bf16(b0,qr[d0],p0,0,0,0);p1=__builtin_amdgcn_mfma_f32_32x32x16_bf16(b1,qr[d0],p1,0,0,0);}}
}
typedef __attribute__((address_space(3))) const char* lds_cptr;
typedef short v4i16_t __attribute__((ext_vector_type(4)));
__device__ __forceinline__ void kload8(bf16x8*kf,lds_cptr kp){
  kf[0]=*(const __attribute__((address_space(3))) bf16x8*)(kp);      kf[1]=*(const __attribute__((address_space(3))) bf16x8*)(kp+512);
  kf[2]=*(const __attribute__((address_space(3))) bf16x8*)(kp+2048); kf[3]=*(const __attribute__((address_space(3))) bf16x8*)(kp+2560);
  kf[4]=*(const __attribute__((address_space(3))) bf16x8*)(kp+4096); kf[5]=*(const __attribute__((address_space(3))) bf16x8*)(kp+4608);
  kf[6]=*(const __attribute__((address_space(3))) bf16x8*)(kp+6144); kf[7]=*(const __attribute__((address_space(3))) bf16x8*)(kp+6656);
}
__device__ __forceinline__ void kload2(bf16x8*kf,lds_cptr kp,int j){ kf[2*j]=*(const __attribute__((address_space(3))) bf16x8*)(kp+j*2048); kf[2*j+1]=*(const __attribute__((address_space(3))) bf16x8*)(kp+j*2048+512); }
__device__ __forceinline__ s16x4 vtr(lds_cptr p){ return __builtin_bit_cast(s16x4,__builtin_amdgcn_ds_read_tr16_b64_v4i16((__attribute__((address_space(3))) v4i16_t*)p)); }
__device__ __forceinline__ float rowmax(const f32x16&p0,const f32x16&p1){
  float a=max3f(p0[0],p0[1],p1[0]),b=max3f(p0[2],p0[3],p1[1]);a=max3f(a,p1[2],p1[3]);
  #pragma unroll
  for(int r=4;r<16;r+=4){a=max3f(a,p0[r],p0[r+1]);b=max3f(b,p0[r+2],p0[r+3]);a=max3f(a,p1[r],p1[r+1]);b=max3f(b,p1[r+2],p1[r+3]);}
  const float m=max2f(a,b);
  auto rr=__builtin_amdgcn_permlane32_swap(__float_as_uint(m),__float_as_uint(m),false,false);
  return max2f(__uint_as_float(rr[0]),__uint_as_float(rr[1]));
}
__device__ __forceinline__ void pv(f32x16*o,int vb,bf16x8 pa0,bf16x8 pa1,bf16x8 pa2,bf16x8 pa3){
  #pragma unroll
  for(int d0=0;d0<2;++d0){s16x4 lo[4],hi[4];
    #pragma unroll
    for(int ks=0;ks<4;++ks){
      asm volatile("ds_read_b64_tr_b16 %0,%1 offset:%c2":"=&v"(lo[ks]):"v"(vb),"i"(d0*4096+ks*1024):"memory");
      asm volatile("ds_read_b64_tr_b16 %0,%1 offset:%c2":"=&v"(hi[ks]):"v"(vb),"i"(d0*4096+ks*1024+512):"memory");}
    asm volatile("s_waitcnt lgkmcnt(0)":::"memory");SBAR();
    #define PK(k) (bf16x8){lo[k][0],lo[k][1],lo[k][2],lo[k][3],hi[k][0],hi[k][1],hi[k][2],hi[k][3]}
    o[d0]=__builtin_amdgcn_mfma_f32_32x32x16_bf16(pa0,PK(0),o[d0],0,0,0);
    o[d0]=__builtin_amdgcn_mfma_f32_32x32x16_bf16(pa1,PK(1),o[d0],0,0,0);
    o[d0]=__builtin_amdgcn_mfma_f32_32x32x16_bf16(pa2,PK(2),o[d0],0,0,0);
    o[d0]=__builtin_amdgcn_mfma_f32_32x32x16_bf16(pa3,PK(3),o[d0],0,0,0);
    #undef PK
  }
}

#ifndef ATTN_STORE16
#define ATTN_STORE16(p,v) (*(u32x4*)(p)=(v))
#endif
template<int THRL> __device__ __forceinline__ void attn_unit(int b,int qcol,int vcol,int ocol,int qb,const bf16*Q,const bf16*__restrict__ K,const bf16*__restrict__ V,bf16*O,char*shm){
  int tid_=threadIdx.x; asm volatile("":"+v"(tid_)); const int tid=tid_,lane=tid&63,r32=lane&31,hi=lane>>5; const int wid=__builtin_amdgcn_readfirstlane(tid>>6);
  const long rowbase=(long)b*SEQ; const int q0=qb*QB;
  const bf16*Qw=Q+(rowbase+q0+wid*QBLK)*DM+qcol;
  const bf16*Kh=K+rowbase*DM+qcol,*Vh=V+rowbase*DM+vcol;
  const unsigned lds0=(unsigned)(uintptr_t)shm;
  float*wsf=(float*)(shm+LDS_WS)+wid*64;
  const bf16*ksrc=Kh+(long)lane*DM+wid*8;
  const bf16*vsrc=Vh+(long)(16*(wid&3)+(lane>>2))*DM+(wid>>2)*32+(lane&3)*8;
  const unsigned kdst=lds0+LDS_K+wid*1024, vdst=lds0+LDS_V+wid*1024;
  #define DMA_K(t,slot) glds16(ksrc+(long)(t)*KVBLK*DM,(unsigned)__builtin_amdgcn_readfirstlane(kdst+(slot)))
  #define DMA_V(t,slot) glds16(vsrc+(long)(t)*KVBLK*DM,(unsigned)__builtin_amdgcn_readfirstlane(vdst+(slot)))
  const int vb0=(int)(lds0+LDS_V)+((lane>>4)&1)*32+(lane&3)*8+(4*hi+((lane&15)>>2))*64;
  const char*Kbase=shm+LDS_K; bf16x8 kf[8];
  const lds_cptr shm3=(lds_cptr)shm; const lds_cptr kp0=shm3+LDS_K+hi*1024+r32*16; const lds_cptr vp0=shm3+LDS_V+((lane>>4)&1)*32+(lane&3)*8+(4*hi+((lane&15)>>2))*64;
  const int NT=(q0+QB)/KVBLK;
  DMA_K(0,0);DMA_V(0,0);DMA_K(1,SLOTB);
  bf16x8 qr[4];
  #pragma unroll
  for(int d0=0;d0<4;++d0)qr[d0]=*reinterpret_cast<const bf16x8*>(&Qw[(long)r32*DM+d0*16+hi*8]);
  float mhat=0.f,l_reg=0.f;f32x16 o[2];o[0]=f32x16{};o[1]=f32x16{};f32x16 negm=f32x16{};asm volatile("":"+v"(negm));
  const int qrel=wid*QBLK+r32;
  #define CMASK(P0,P1,t) do{int jb_=(t)-(NT-4); if(jb_>=0)cmask(P0,P1,jb_,qrel,hi);}while(0)
  bool resc=false;
  #define START(P0,P1) do{ const float rm=rowmax(P0,P1); resc=false; \
    { const float dl=rm; mhat=fadd_s(mhat,dl); \
      _Pragma("unroll") for(int r=0;r<16;++r){P0[r]=fsub_s(P0[r],dl);P1[r]=fsub_s(P1[r],dl);} \
      _Pragma("unroll") for(int r=0;r<16;++r)negm[r]=-mhat; asm volatile("":"+v"(negm)); } \
    _Pragma("unroll") for(int r=0;r<16;++r)P0[r]=__builtin_amdgcn_exp2f(P0[r]); }while(0)
  #define RESC() do{ if(resc){ asm volatile("s_waitcnt lgkmcnt(0)":::"memory"); \
      _Pragma("unroll") for(int d_=0;d_<2;++d_) _Pragma("unroll") for(int r=0;r<16;++r)o[d_][r]*=wsf[crow(r,hi)]; } }while(0)
  f32x16 pA0,pA1,pB0,pB1;
  int sl_prev=0,sl_cur=0,sl_next=SLOTB;
  #define ROT() do{sl_prev=sl_cur;sl_cur=sl_next;sl_next=(sl_next==(NSLOT-1)*SLOTB)?0:sl_next+SLOTB;}while(0)
  DMA_K(2,2*SLOTB);
  WAIT_BAR(3);
  qkt(pA0,pA1,Kbase,qr,negm,r32,hi);asm volatile("s_nop 15\n\ts_nop 7":"+v"(pA0),"+v"(pA1));CMASK(pA0,pA1,0);
  START(pA0,pA1);
  _Pragma("unroll") for(int r=0;r<16;++r)pA1[r]=__builtin_amdgcn_exp2f(pA1[r]);
  WAIT_BAR(0);
  DMA_K(3,0);DMA_V(1,SLOTB);
  ROT();
  kload8(kf,kp0+sl_cur);
  WAIT_BAR(2);
  s16x4 vlo[8],vhi[8]; u32x4 pw0,pw1,pw2,pw3;
  #define PKW(P,B) cvtpk_s(P[B],P[B+1])
  #define PAF(k) __builtin_bit_cast(bf16x8,pw##k)
  #define VFR(i) (bf16x8){vlo[i][0],vlo[i][1],vlo[i][2],vlo[i][3],vhi[i][0],vhi[i][1],vhi[i][2],vhi[i][3]}
  #define PIN(x) asm volatile("":"+v"(x))
  #define MX3(a,b,c) __builtin_fmaxf(__builtin_fmaxf((a),(b)),(c))
  #define GAPA(MF,A0,A1,A2,A3,W0,W1,PW) do{ MF; sacc+=A0; sacc+=A1; sacc+=A2; sacc+=A3; PIN(sacc); W0; W1; PIN(PW); SBAR(); }while(0)
  #define EX(v) __builtin_amdgcn_exp2f(v)
  #define GAPB(MF,X,B) do{ MF; X[B]=EX(X[B]); X[B+1]=EX(X[B+1]); X[B+2]=EX(X[B+2]); X[B+3]=EX(X[B+3]); PIN(X); SBAR(); }while(0)
  #define VRD(i) do{ vlo[i]=vtr(vp_+(((i)>>2)*4096+((i)&3)*1024)); vhi[i]=vtr(vp_+(((i)>>2)*4096+((i)&3)*1024+512)); }while(0)
  #define KRD(G,j) do{ if(G){ kload2(kf,kp0+sl_next,j); SBAR(); } }while(0)
  #define STEP(C0,C1,P0,P1,t,GK,GV,GL) do{ SBAR(); \
    const lds_cptr vp_=vp0+sl_prev; \
    VRD(0); SBAR(); float sacc=(P0[0]+P0[1]); \
    GAPA(C0=__builtin_amdgcn_mfma_f32_32x32x16_bf16(kf[0],qr[0],negm,0,0,0), P0[2],P0[3],P0[4],P0[5],     pw0[0]=PKW(P0,0), pw0[1]=PKW(P0,2), pw0); \
    VRD(4); SBAR(); GAPA(C1=__builtin_amdgcn_mfma_f32_32x32x16_bf16(kf[1],qr[0],negm,0,0,0), P0[6],P0[7],P0[8],P0[9],     pw0[2]=PKW(P0,4), pw0[3]=PKW(P0,6), pw0); \
    VRD(1); SBAR(); GAPA(C0=__builtin_amdgcn_mfma_f32_32x32x16_bf16(kf[2],qr[1],C0,0,0,0),   P0[10],P0[11],P0[12],P0[13], pw1[0]=PKW(P0,8), pw1[1]=PKW(P0,10), pw1); \
    VRD(5); SBAR(); GAPA(C1=__builtin_amdgcn_mfma_f32_32x32x16_bf16(kf[3],qr[1],C1,0,0,0),   P0[14],P0[15],P1[0],P1[1],   pw1[2]=PKW(P0,12),pw1[3]=PKW(P0,14), pw1); \
    VRD(2); SBAR(); GAPA(C0=__builtin_amdgcn_mfma_f32_32x32x16_bf16(kf[4],qr[2],C0,0,0,0),   P1[2],P1[3],P1[4],P1[5],     pw2[0]=PKW(P1,0), pw2[1]=PKW(P1,2), pw2); \
    VRD(6); SBAR(); GAPA(C1=__builtin_amdgcn_mfma_f32_32x32x16_bf16(kf[5],qr[2],C1,0,0,0),   P1[6],P1[7],P1[8],P1[9],     pw2[2]=PKW(P1,4), pw2[3]=PKW(P1,6), pw2); \
    VRD(3); SBAR(); GAPA(C0=__builtin_amdgcn_mfma_f32_32x32x16_bf16(kf[6],qr[3],C0,0,0,0),   P1[10],P1[11],P1[12],P1[13], pw3[0]=PKW(P1,8), pw3[1]=PKW(P1,10), pw3); \
    VRD(7); SBAR(); GAPA(C1=__builtin_amdgcn_mfma_f32_32x32x16_bf16(kf[7],qr[3],C1,0,0,0),   P1[14],P1[15],0.f,0.f,       pw3[2]=PKW(P1,12),pw3[3]=PKW(P1,14), pw3); \
    l_reg+=sacc; \
    if(GK){DMA_K((t)+3,sl_cur);} if(GV){DMA_V((t)+1,sl_next);} \
    CMASK(C0,C1,t); \
    { float a=MX3(C0[0],C0[1],C1[0]),b=MX3(C0[2],C0[3],C1[1]); a=MX3(a,C1[2],C1[3]); \
      _Pragma("unroll") for(int r=4;r<16;r+=4){a=MX3(a,C0[r],C0[r+1]);b=MX3(b,C0[r+2],C0[r+3]);a=MX3(a,C1[r],C1[r+1]);b=MX3(b,C1[r+2],C1[r+3]);} \
      float rm=__builtin_fmaxf(a,b); { auto rr=__builtin_amdgcn_permlane32_swap(__float_as_uint(rm),__float_as_uint(rm),false,false); rm=__builtin_fmaxf(__uint_as_float(rr[0]),__uint_as_float(rr[1])); } \
      resc=false; \
      if(__builtin_expect(__any(rm>(float)THRL),0)){ const float dl=__builtin_fmaxf(rm,0.f); mhat+=dl; \
        _Pragma("unroll") for(int r=0;r<16;++r){C0[r]-=dl;C1[r]-=dl;} \
        _Pragma("unroll") for(int r=0;r<16;++r)negm[r]=-mhat; asm volatile("":"+v"(negm)); \
        const float f=__builtin_amdgcn_exp2f(-dl); l_reg*=f; if(hi==0)wsf[r32]=f; resc=true; } } \
    SBAR(); \
    GAPB(o[0]=__builtin_amdgcn_mfma_f32_32x32x16_bf16(PAF(0),VFR(0),o[0],0,0,0), C0,0); \
    GAPB(o[1]=__builtin_amdgcn_mfma_f32_32x32x16_bf16(PAF(0),VFR(4),o[1],0,0,0), C0,4); \
    KRD(GL,0); GAPB(o[0]=__builtin_amdgcn_mfma_f32_32x32x16_bf16(PAF(1),VFR(1),o[0],0,0,0), C0,8); \
    KRD(GL,1); GAPB(o[1]=__builtin_amdgcn_mfma_f32_32x32x16_bf16(PAF(1),VFR(5),o[1],0,0,0), C0,12); \
    KRD(GL,2); GAPB(o[0]=__builtin_amdgcn_mfma_f32_32x32x16_bf16(PAF(2),VFR(2),o[0],0,0,0), C1,0); \
    KRD(GL,3); GAPB(o[1]=__builtin_amdgcn_mfma_f32_32x32x16_bf16(PAF(2),VFR(6),o[1],0,0,0), C1,4); \
    GAPB(o[0]=__builtin_amdgcn_mfma_f32_32x32x16_bf16(PAF(3),VFR(3),o[0],0,0,0), C1,8); \
    GAPB(o[1]=__builtin_amdgcn_mfma_f32_32x32x16_bf16(PAF(3),VFR(7),o[1],0,0,0), C1,12); \
    }while(0)
  int t=1;
  #undef CMASK
  #define CMASK(P0,P1,t) do{}while(0)
  for(;t+5<NT;t+=2){
    STEP(pB0,pB1,pA0,pA1,t,true,true,true);     WAIT_BAR(2); RESC(); ROT();
    STEP(pA0,pA1,pB0,pB1,t+1,true,true,true);   WAIT_BAR(2); RESC(); ROT();
  }
  #undef CMASK
  #define CMASK(P0,P1,t) do{int jb_=(t)-(NT-4); if(jb_>=0)cmask(P0,P1,jb_,qrel,hi);}while(0)
  #define ENDW(tt) do{ if((tt)+3<NT){WAIT_BAR(2);} else if((tt)+2<NT){WAIT_BAR(1);} else {WAIT_BAR(0);} }while(0)
  for(;t+1<NT;t+=2){
    STEP(pB0,pB1,pA0,pA1,t,(t+3<NT),(t+1<NT),(t+1<NT));       ENDW(t);   RESC(); ROT();
    STEP(pA0,pA1,pB0,pB1,t+1,(t+4<NT),(t+2<NT),(t+2<NT));     ENDW(t+1); RESC(); ROT();
  }
  STEP(pB0,pB1,pA0,pA1,NT-1,false,false,false); RESC();
  { float sacc=pB0[0]+pB0[1]; _Pragma("unroll") for(int r=2;r<16;++r)sacc+=pB0[r]; _Pragma("unroll") for(int r=0;r<16;++r)sacc+=pB1[r]; l_reg+=sacc;
    pw0=(u32x4){PKW(pB0,0),PKW(pB0,2),PKW(pB0,4),PKW(pB0,6)};pw1=(u32x4){PKW(pB0,8),PKW(pB0,10),PKW(pB0,12),PKW(pB0,14)};pw2=(u32x4){PKW(pB1,0),PKW(pB1,2),PKW(pB1,4),PKW(pB1,6)};pw3=(u32x4){PKW(pB1,8),PKW(pB1,10),PKW(pB1,12),PKW(pB1,14)};
    SBAR(); pv(o,vb0+sl_cur,PAF(0),PAF(1),PAF(2),PAF(3)); }
  #undef PKW
  #undef PAF
  #undef VFR
  #undef PIN
  #undef MX3
  #undef GAPA
  #undef GAPB
  #undef EX
  #undef VRD
  #undef KRD
  #undef STEP
  #undef ENDW
  {auto rr=__builtin_amdgcn_permlane32_swap(__float_as_uint(l_reg),__float_as_uint(l_reg),false,false);l_reg=__uint_as_float(rr[0])+__uint_as_float(rr[1]);}
  if(hi==0)wsf[32+r32]=l_reg;asm volatile("s_waitcnt lgkmcnt(0)":::"memory");
  float rli[16];
  #pragma unroll
  for(int r=0;r<16;++r)rli[r]=__builtin_amdgcn_rcpf(wsf[32+crow(r,hi)]);
  bf16*Ow=O+(rowbase+q0+wid*QBLK)*DM+ocol;
  { bf16*stg=(bf16*)(shm+LDS_OST)+wid*2048;
    #pragma unroll
    for(int r=0;r<16;++r){const int orow=crow(r,hi);
      #pragma unroll
      for(int d0=0;d0<2;++d0)stg[orow*64+d0*32+r32]=__float2bfloat16(o[d0][r]*rli[r]);}
    asm volatile("s_waitcnt lgkmcnt(0)":::"memory");
    #pragma unroll
    for(int i=0;i<4;++i){const int row=i*8+(lane>>3),ch=lane&7; const u32x4 v=*(const u32x4*)(stg+row*64+ch*8); ATTN_STORE16(Ow+(long)row*DM+ch*8,v);} }
  asm volatile("s_waitcnt lgkmcnt(0)\n\ts_barrier":::"memory");
  #undef DMA_K
  #undef DMA_V
  #undef CMASK
  #undef START
  #undef RESC
  #undef ROT
}
constexpr int ATTN_LDS_BYTES=LDS_BYTES;
struct AttnTensors { const bf16* Q; const bf16* K; const bf16* V; bf16* O0; bf16* O1; };
struct AttnUnit { int bh; int qb; };
struct StaticOrder {
  int vcu;
  __device__ __forceinline__ explicit StaticOrder(int grid,int block):vcu((block%8)*(grid/8)+block/8){}
  __device__ __forceinline__ bool next(int i,AttnUnit&u)const{ if(i>=4)return false; const int s=vcu&3; u.bh=vcu>>2; u.qb=(i==0)?s:(i==1)?7-s:(i==2)?8+s:15-s; return true; }
  __device__ __forceinline__ void a_ready(const AttnUnit&)const{}
  __device__ __forceinline__ void done(const AttnUnit&)const{}
};
template<class Sched,int THRL=8> __device__ __forceinline__ void attn_phase(char*lds,const AttnTensors&T,const Sched&S){
  AttnUnit u;
  for(int i=0;S.next(i,u);++i){ S.a_ready(u);
    const int b=u.bh>>4, vh=u.bh&15, head=vh>>2, c=(vh>>1)&1, half=vh&1;
    const int qcol=(head*2+c)*64, vcol=head*128+half*64;
    attn_unit<THRL>(b,qcol,vcol,vcol,u.qb,T.Q,T.K,T.V,c?T.O1:T.O0,lds); S.done(u); }
}
#undef SBAR
#undef WAIT_BAR
}
#define GAS __attribute__((address_space(1)))
#define LAS __attribute__((address_space(3)))
typedef unsigned short bf16;
typedef unsigned v4u __attribute__((ext_vector_type(4)));
typedef float f32x4 __attribute__((ext_vector_type(4)));
typedef short bf16x8 __attribute__((ext_vector_type(8)));
typedef GAS unsigned gu32;
typedef GAS unsigned long long gu64;
#define RLX_AGENT __ATOMIC_RELAXED, __HIP_MEMORY_SCOPE_AGENT
#define LDS_WAIT() asm volatile("s_waitcnt lgkmcnt(0)" ::: "memory")
#define VM_WAIT() asm volatile("s_waitcnt vmcnt(0)" ::: "memory")
__device__ __forceinline__ unsigned long long rt() { return __builtin_amdgcn_s_memrealtime(); }
__device__ __forceinline__ unsigned f2bf(float f) { unsigned u = __builtin_bit_cast(unsigned, f); return (u + 0x7fffu + ((u >> 16) & 1u)) >> 16; }
__device__ __forceinline__ unsigned pk2(float lo, float hi) { return f2bf(lo) | (f2bf(hi) << 16); }

#define XB_TMO      128
#define XB_XCNT(j)  (256  + 64 * (j))
#define XB_XSUB(j)  (1280 + 64 * (j))
#define XB_XGEN(j)  (2304 + 64 * (j))
#define XB_TOP      3328
#define XB_TOPGEN   3392
#define XCD_BAR_WORDS 3456
#define XB_SPIN_CAP (1u << 18)

__device__ __forceinline__ unsigned xb_ld(unsigned* p)              { return __hip_atomic_load(p, __ATOMIC_RELAXED, __HIP_MEMORY_SCOPE_AGENT); }
__device__ __forceinline__ unsigned xb_add(unsigned* p, unsigned v) { return __hip_atomic_fetch_add(p, v, __ATOMIC_RELAXED, __HIP_MEMORY_SCOPE_AGENT); }
__device__ __forceinline__ unsigned xb_xcc_id() { return (unsigned)__builtin_amdgcn_s_getreg((3 << 11) | 20) & 0xFu; }
#define XB_SPIN(cond, bar) do { unsigned _sp = 0; while (cond) { __builtin_amdgcn_s_sleep(1); \
    if ((++_sp & 255u) == 0u) { if (xb_ld(&(bar)[XB_TMO])) break; if (_sp > XB_SPIN_CAP) { atomicAdd(&(bar)[XB_TMO], 1u); break; } } } } while (0)

struct XcdBarrier {
    unsigned* bar; unsigned x;
    volatile LAS unsigned* st;
};

__device__ __forceinline__ XcdBarrier xcd_barrier_post(unsigned* bar, volatile LAS unsigned* st) {
    XcdBarrier b; b.bar = bar; b.x = xb_xcc_id(); b.st = st;
    if (threadIdx.x == 0) (void)xb_add(&bar[XB_XCNT(b.x)], 1u);
    return b;
}
__device__ __forceinline__ void xcd_barrier_complete(unsigned* bar, unsigned x, unsigned& nloc, unsigned& nx) {
    const unsigned G = gridDim.x * gridDim.y * gridDim.z;
    unsigned sum, cnt, mine, sp = 0u;
    for (;;) {
        sum = 0u; cnt = 0u; mine = 0u;
#pragma unroll
        for (unsigned j = 0; j < 16; ++j) { const unsigned c = xb_ld(&bar[XB_XCNT(j)]); sum += c; cnt += (c > 0u) ? 1u : 0u; mine = (j == x) ? c : mine; }
        if (sum == G) break;
        __builtin_amdgcn_s_sleep(1);
        if ((++sp & 255u) == 0u) { if (xb_ld(&bar[XB_TMO])) break; if (sp > XB_SPIN_CAP) { atomicAdd(&bar[XB_TMO], 1u); break; } }
    }
    nloc = mine > 0u ? mine : 1u; nx = cnt > 0u ? cnt : 1u;
}

__device__ __forceinline__ void xcd_barrier(const XcdBarrier& b) {
    asm volatile("s_waitcnt vmcnt(0)" ::: "memory");
    __syncthreads();
    if (threadIdx.x == 0) {
        unsigned* bar = b.bar;
        __builtin_amdgcn_s_waitcnt(0);
        unsigned nloc = b.st[0], nx = b.st[1];
        if (nloc == 0u) { xcd_barrier_complete(bar, b.x, nloc, nx); b.st[0] = nloc; b.st[1] = nx; }
        const unsigned old = xb_add(&bar[XB_XSUB(b.x)], 1u);
        const unsigned gen = old / nloc;
        if (old + 1u == (gen + 1u) * nloc) {
            __builtin_amdgcn_fence(__ATOMIC_RELEASE, "agent");
            asm volatile("s_waitcnt vmcnt(0)" ::: "memory");
            const unsigned og = xb_add(&bar[XB_TOP], 1u);
            const unsigned tg = og / nx;
            if (og + 1u == (tg + 1u) * nx) xb_add(&bar[XB_TOPGEN], 1u);
            else XB_SPIN(xb_ld(&bar[XB_TOPGEN]) == tg, bar);
            __builtin_amdgcn_fence(__ATOMIC_ACQUIRE, "agent");
            xb_add(&bar[XB_XGEN(b.x)], 1u);
            asm volatile("s_waitcnt vmcnt(0)" ::: "memory");
        } else {
            XB_SPIN(xb_ld(&bar[XB_XGEN(b.x)]) == gen, bar);
            __builtin_amdgcn_fence(__ATOMIC_ACQUIRE, "agent");
            asm volatile("s_waitcnt vmcnt(0)" ::: "memory");
        }
    }
    __syncthreads();
}
__device__ __forceinline__ float wave_sum(float v) {
#pragma unroll
    for (int o = 1; o < 64; o <<= 1) v += __shfl_xor(v, o);
    return v;
}
__device__ __forceinline__ void p0_transpose_item(const float* W, int K, int N, bf16* WT, int row_off, LAS float* scr, int item, int lane) {
    const int nblk = N / 32, kb = item / nblk, nb = item % nblk, k0 = 64 * kb, n0 = 32 * nb;
#pragma unroll 8
    for (int i = 0; i < 32; ++i) { const int kk = 2 * i + (lane >> 5); scr[kk * 33 + (lane & 31)] = W[(size_t)(k0 + kk) * N + n0 + (lane & 31)]; }
    LDS_WAIT(); asm volatile("" ::: "memory");
    const int c = lane & 7;
#pragma unroll
    for (int j = 0; j < 4; ++j) { const int n = (lane >> 3) + 8 * j; const LAS float* s = scr + (8 * c) * 33 + n;
        v4u o; o.x = pk2(s[0 * 33], s[1 * 33]); o.y = pk2(s[2 * 33], s[3 * 33]); o.z = pk2(s[4 * 33], s[5 * 33]); o.w = pk2(s[6 * 33], s[7 * 33]);
        *(GAS v4u*)(WT + (size_t)(row_off + n0 + n) * K + k0 + 8 * c) = o; }
    LDS_WAIT(); asm volatile("" ::: "memory");
}
namespace cg = cooperative_groups;
constexpr int NWAVES = 8;
constexpr int BATCH = 4, SEQ = 4096, D = 1024, T = BATCH * SEQ, DEPTH = 2, INCOLS = 5120, NEXP = 16384;
constexpr float NORM_EPS = 1e-6f;
constexpr size_t MiB = 1u << 20;
constexpr size_t WS_CTL = 0, CTL_ZERO_BYTES = 1 * MiB;
constexpr size_t WS_MOD = 1 * MiB;
constexpr size_t WS_ROPE = WS_MOD + 256 * 1024;
constexpr size_t WS_SUBK = 2 * MiB;
constexpr size_t WS_WIN = 4 * MiB;
constexpr size_t WS_WSB = 24 * MiB;
constexpr size_t WS_WDF = 26 * MiB;
constexpr size_t WS_WOUT = 28 * MiB;
constexpr size_t WS_WQ = 32 * MiB;
constexpr size_t WS_U8 = 40 * MiB, WS_V8 = 56 * MiB;
constexpr size_t WS_H = 104 * MiB;
constexpr size_t WS_SBQ = 136 * MiB, WS_SBK = 152 * MiB, WS_SBV = 168 * MiB, WS_SBVT = 184 * MiB, WS_DQ = 200 * MiB, WS_DK = 216 * MiB, WS_DV = 232 * MiB;
constexpr size_t WS_GSB = 248 * MiB, WS_GDF = 280 * MiB;
constexpr size_t WS_YSB = 312 * MiB, WS_YDF = 328 * MiB;
constexpr size_t WS_M1 = WS_SBQ, WS_MRG = WS_DQ;
constexpr size_t WS_QP = WS_GSB;
constexpr size_t WS_EIDX = WS_SBV, WS_EGATE = WS_SBV + 8 * MiB;
constexpr size_t WS_XA = 344 * MiB, WS_XB = 408 * MiB, WS_END = 472 * MiB;
constexpr size_t WS_APART = 200 * MiB;
constexpr int CW_BAR = 4096, CW_RANK = 8192;
static_assert(WS_ROPE == pg8::EPI_WS_ROPE && WS_SBQ == pg8::EPI_WS_SBQ && WS_SBK == pg8::EPI_WS_SBK && WS_SBV == pg8::EPI_WS_SBV && WS_SBVT == pg8::EPI_WS_SBVT && WS_DQ == pg8::EPI_WS_DQ && WS_DK == pg8::EPI_WS_DK && WS_DV == pg8::EPI_WS_DV && WS_GSB == pg8::EPI_WS_GSB && WS_GDF == pg8::EPI_WS_GDF, "epilogue offsets");
constexpr int RING_OFF = 0, RING_BYTES = 131072;
constexpr int LDSCTL_OFF = RING_BYTES, MISC_OFF = LDSCTL_OFF + 320;
constexpr int LDS_BYTES = 147456;

struct Frame { LAS unsigned char* lds; volatile LAS unsigned* MISC; int tid, lane, wave, vcu, G; };
struct Args { const float* in[18]; float* out; unsigned char* ws; };

__device__ __forceinline__ unsigned short f2bf_s(float f) { return (unsigned short)f2bf(f); }
__device__ __forceinline__ float bf_lo(unsigned w) { return __uint_as_float(w << 16); }
__device__ __forceinline__ float bf_hi(unsigned w) { return __uint_as_float(w & 0xffff0000u); }
typedef __bf16 bf2_t __attribute__((ext_vector_type(2)));
__device__ __forceinline__ float dot2bf(unsigned a, unsigned b, float c) { return __builtin_amdgcn_fdot2_f32_bf16(__builtin_bit_cast(bf2_t, a), __builtin_bit_cast(bf2_t, b), c, false); }

__device__ __forceinline__ void p0_prologue(Frame& F, const Args& A) {
    unsigned char* ws = A.ws;
    LAS float* scr = (LAS float*)(F.lds + RING_OFF + F.wave * 16384);
    const int gw = F.vcu * NWAVES + F.wave, NGW = F.G * NWAVES;
    constexpr int I_IN = (D / 64) * (INCOLS / 32), I_B = (512 / 64) * (D / 32), I_O = (D / 64) * (D / 32), I_Q = (D / 64) * (2048 / 32), IL = I_IN + 2 * I_B + I_O + I_Q;
    for (int it = gw; it < DEPTH * IL; it += NGW) {
        const int l = it / IL; int r = it % IL;
        if (r < I_IN) { p0_transpose_item(A.in[6] + (size_t)l * D * INCOLS, D, INCOLS, (bf16*)(ws + WS_WIN) + (size_t)l * INCOLS * D, 0, scr, r, F.lane); continue; } r -= I_IN;
        if (r < I_B) { p0_transpose_item(A.in[10] + (size_t)l * 512 * D, 512, D, (bf16*)(ws + WS_WSB) + (size_t)l * D * 512, 0, scr, r, F.lane); continue; } r -= I_B;
        if (r < I_B) { p0_transpose_item(A.in[11] + (size_t)l * 512 * D, 512, D, (bf16*)(ws + WS_WDF) + (size_t)l * D * 512, 0, scr, r, F.lane); continue; } r -= I_B;
        if (r < I_O) { p0_transpose_item(A.in[12] + (size_t)l * D * D, D, D, (bf16*)(ws + WS_WOUT) + (size_t)l * D * D, 0, scr, r, F.lane); continue; } r -= I_O;
        p0_transpose_item(A.in[13] + (size_t)l * D * 2048, D, 2048, (bf16*)(ws + WS_WQ) + (size_t)l * 2048 * D, 0, scr, r, F.lane);
    }
    { const int gt = F.vcu * 512 + F.tid, NT = F.G * 512; const float* s = A.in[14]; bf16* o = (bf16*)(ws + WS_SUBK);
      for (int i = gt; i < (DEPTH * 8 * 2 * 128 * 128) / 8; i += NT) { const f32x4 a = *(const f32x4*)(s + (size_t)i * 8), b = *(const f32x4*)(s + (size_t)i * 8 + 4);
          v4u w; w.x = pk2(a.x, a.y); w.y = pk2(a.z, a.w); w.z = pk2(b.x, b.y); w.w = pk2(b.z, b.w); *(v4u*)(o + (size_t)i * 8) = w; } }
    { const int gt = F.vcu * 512 + F.tid, NT = F.G * 512; float* rc = (float*)(ws + WS_ROPE); float* rs = rc + 4096 * 8;
      for (int i = gt; i < 4096 * 8; i += NT) { const int pos = i >> 3, f = i & 7; const float inv = 1.0f / powf(500000.0f, (float)(2 * f) / 16.0f); const float ang = (float)pos * inv; rc[i] = cosf(ang); rs[i] = sinf(ang); } }
    __syncthreads();
    { LAS float* sc = (LAS float*)(F.lds);
      LAS float* red = (LAS float*)(F.lds + 16384);
      for (int i = F.tid; i < 4 * 1024; i += 512) { const float v = A.in[1][i]; sc[i] = v / (1.0f + expf(-v)); }
      __syncthreads();
      for (int j = F.vcu; j < 256; j += F.G) {
          const int cgi = F.tid % 12, ks = F.tid / 12;
          const int g = j * 12 + cgi; const int l = g / 1536, n0 = (g % 1536) * 4;
          f32x4 acc[4]; acc[0] = acc[1] = acc[2] = acc[3] = (f32x4){0.f, 0.f, 0.f, 0.f};
          if (ks < 42) { const float* w = A.in[4] + (size_t)l * D * 6144 + n0;
              for (int k = ks; k < 1024; k += 42) { const f32x4 wv = *(const f32x4*)(w + (size_t)k * 6144);
#pragma unroll
                  for (int b = 0; b < 4; ++b) acc[b] = acc[b] + wv * sc[b * 1024 + k]; }
#pragma unroll
              for (int b = 0; b < 4; ++b)
#pragma unroll
                  for (int e = 0; e < 4; ++e) red[((ks * 12 + cgi) * 4 + b) * 4 + e] = acc[b][e]; }
          __syncthreads();
          if (F.tid < 192) { const int cg2 = F.tid / 16, b = (F.tid / 4) & 3, e = F.tid & 3; float s = 0.f;
              for (int k2 = 0; k2 < 42; ++k2) s += red[((k2 * 12 + cg2) * 4 + b) * 4 + e];
              const int g2 = j * 12 + cg2; const int l2 = g2 / 1536, n2 = (g2 % 1536) * 4 + e;
              ((float*)(ws + WS_MOD))[((size_t)l2 * 4 + b) * 6144 + n2] = s + A.in[5][(size_t)l2 * 6144 + n2]; }
          __syncthreads();
      } }
}
__device__ __forceinline__ void cvt_table8(Frame& F, const float* s, unsigned char* o, float scale) {
    const int gt = F.vcu * 512 + F.tid, NT = F.G * 512;
    for (int i = gt; i < NEXP * 64; i += NT) { const int e = i >> 6, r = (i >> 3) & 7, sub = i & 7; const float* p = s + (size_t)i * 16;
        const f32x4 a = *(const f32x4*)p * scale, b = *(const f32x4*)(p + 4) * scale, c = *(const f32x4*)(p + 8) * scale, d = *(const f32x4*)(p + 12) * scale;
        v4u w; int t;
        t = __builtin_amdgcn_cvt_pk_fp8_f32(a.x, a.y, 0, false); t = __builtin_amdgcn_cvt_pk_fp8_f32(a.z, a.w, t, true); w.x = (unsigned)t;
        t = __builtin_amdgcn_cvt_pk_fp8_f32(b.x, b.y, 0, false); t = __builtin_amdgcn_cvt_pk_fp8_f32(b.z, b.w, t, true); w.y = (unsigned)t;
        t = __builtin_amdgcn_cvt_pk_fp8_f32(c.x, c.y, 0, false); t = __builtin_amdgcn_cvt_pk_fp8_f32(c.z, c.w, t, true); w.z = (unsigned)t;
        t = __builtin_amdgcn_cvt_pk_fp8_f32(d.x, d.y, 0, false); t = __builtin_amdgcn_cvt_pk_fp8_f32(d.z, d.w, t, true); w.w = (unsigned)t;
        *(v4u*)(o + ((size_t)r * NEXP + e) * 128 + sub * 16) = w; }
}
__device__ __forceinline__ void hnorm_phase(Frame& F, const float* x, const float* g, const float* shift, const float* scale  , bf16* H) {
    const int gw = F.vcu * NWAVES + F.wave, NGW = F.G * NWAVES;
    for (int m = gw; m < T; m += NGW) { const int b = m >> 12;
        const f32x4* xr = (const f32x4*)(x + (size_t)m * D) + F.lane; f32x4 v[4]; float s = 0.f;
#pragma unroll
        for (int j = 0; j < 4; ++j) { v[j] = xr[64 * j]; s += (v[j].x * v[j].x + v[j].y * v[j].y) + (v[j].z * v[j].z + v[j].w * v[j].w); }
        const float r = 1.0f / sqrtf(wave_sum(s) * (1.0f / D) + NORM_EPS);
        unsigned long long* o8 = (unsigned long long*)(H + (size_t)m * D) + F.lane;
#pragma unroll
        for (int j = 0; j < 4; ++j) { const int c = 4 * F.lane + 256 * j; const f32x4 gg = *(const f32x4*)(g + c), sh = *(const f32x4*)(shift + (size_t)b * 6144 + c), sc = *(const f32x4*)(scale + (size_t)b * 6144 + c);
            const f32x4 h = (v[j] * r) * gg * (sc + 1.0f) + sh;
            o8[64 * j] = (unsigned long long)pk2(h.x, h.y) | ((unsigned long long)pk2(h.z, h.w) << 32); }
    }
}
#ifndef SB_CUT
#define SB_CUT (-110.0f)
#endif
__device__ __forceinline__ void sb_scalar_phase(Frame& F, const bf16* SBQ, const bf16* SBK, const bf16* SBV, bf16* YSB) {
    for (int u = F.vcu; u < 256; u += F.G) {
        const int bh = u >> 3, chunk = u & 7, b = bh >> 3, h = bh & 7, t = chunk * 512 + F.tid;
        const size_t rowq = (size_t)(b * SEQ + t) * 512 + h * 64;
        float q[64], o[64];
#pragma unroll
        for (int i = 0; i < 8; ++i) { const v4u w = *(const v4u*)(SBQ + rowq + i * 8); q[8 * i] = bf_lo(w.x); q[8 * i + 1] = bf_hi(w.x); q[8 * i + 2] = bf_lo(w.y); q[8 * i + 3] = bf_hi(w.y); q[8 * i + 4] = bf_lo(w.z); q[8 * i + 5] = bf_hi(w.z); q[8 * i + 6] = bf_lo(w.w); q[8 * i + 7] = bf_hi(w.w); }
#pragma unroll
        for (int i = 0; i < 64; ++i) o[i] = 0.f;
        float c = 0.f;
        for (int it = 0;; ++it) { const int s = t - 1 - it; const bool act = (s >= 0) && (c > SB_CUT);
            if (!__any(act)) break;
            if (act) { const size_t rowk = (size_t)(b * SEQ + s) * 512 + h * 64; float z0 = 0.f, z1 = 0.f;
#pragma unroll
                for (int i = 0; i < 8; ++i) { const v4u w = *(const v4u*)(SBK + rowk + i * 8);
                    z0 += q[8 * i] * bf_lo(w.x) + q[8 * i + 2] * bf_lo(w.y) + q[8 * i + 4] * bf_lo(w.z) + q[8 * i + 6] * bf_lo(w.w);
                    z1 += q[8 * i + 1] * bf_hi(w.x) + q[8 * i + 3] * bf_hi(w.y) + q[8 * i + 5] * bf_hi(w.z) + q[8 * i + 7] * bf_hi(w.w); }
                const float z = z0 + z1;
                const float lf = -(fmaxf(z, 0.f) + log1pf(expf(-fabsf(z))));
                const float wgt = expf(z + lf + c); c += lf;
#pragma unroll
                for (int i = 0; i < 8; ++i) { const v4u w = *(const v4u*)(SBV + rowk + i * 8);
                    o[8 * i] += wgt * bf_lo(w.x); o[8 * i + 1] += wgt * bf_hi(w.x); o[8 * i + 2] += wgt * bf_lo(w.y); o[8 * i + 3] += wgt * bf_hi(w.y);
                    o[8 * i + 4] += wgt * bf_lo(w.z); o[8 * i + 5] += wgt * bf_hi(w.z); o[8 * i + 6] += wgt * bf_lo(w.w); o[8 * i + 7] += wgt * bf_hi(w.w); } } }
#pragma unroll
        for (int i = 0; i < 8; ++i) { v4u w; w.x = pk2(o[8 * i], o[8 * i + 1]); w.y = pk2(o[8 * i + 2], o[8 * i + 3]); w.z = pk2(o[8 * i + 4], o[8 * i + 5]); w.w = pk2(o[8 * i + 6], o[8 * i + 7]); *(v4u*)(YSB + rowq + i * 8) = w; }
    }
}
typedef float f32x16_ __attribute__((ext_vector_type(16)));
typedef unsigned u32x2_ __attribute__((ext_vector_type(2)));
__device__ __forceinline__ unsigned cvtpk_bf16(float lo, float hi) { typedef float f2_ __attribute__((ext_vector_type(2))); typedef __bf16 b2_ __attribute__((ext_vector_type(2))); f2_ v = {lo, hi}; b2_ b = __builtin_convertvector(v, b2_); return __builtin_bit_cast(unsigned, b); }
__device__ __forceinline__ void sb_mfma_phase(Frame& F, const bf16* SBQ, const bf16* SBK, const bf16* SBVT, bf16* YSB) {
    const int lane = F.lane, r32 = lane & 31, hi = lane >> 5;
    const float L2E = 1.4426950408889634f, LN2 = 0.6931471805599453f;
    for (int u = F.vcu; u < 512; u += F.G) {
        const int bh = u >> 4, chunk = u & 15, b = bh >> 3, h = bh & 7, q0 = chunk * 256 + F.wave * 32;
        bf16x8 qf[4];
#pragma unroll
        for (int d0 = 0; d0 < 4; ++d0) qf[d0] = *(const bf16x8*)(SBQ + (size_t)(b * SEQ + q0 + r32) * 512 + h * 64 + d0 * 16 + hi * 8);
        f32x16_ o0 = {}, o1 = {}; float c = 0.f; const int qg = q0 + r32;
        for (int jt = q0 >> 6; jt >= 0; --jt) {
            const int kv0 = jt * 64;
            const bf16* kp = SBK + (size_t)(b * SEQ + kv0 + r32) * 512 + h * 64 + hi * 8;
            f32x16_ p0 = {}, p1 = {};
#pragma unroll
            for (int d0 = 0; d0 < 4; ++d0) { const bf16x8 k0 = *(const bf16x8*)(kp + d0 * 16), k1 = *(const bf16x8*)(kp + 32 * 512 + d0 * 16);
                p0 = __builtin_amdgcn_mfma_f32_32x32x16_bf16(k0, qf[d0], p0, 0, 0, 0); p1 = __builtin_amdgcn_mfma_f32_32x32x16_bf16(k1, qf[d0], p1, 0, 0, 0); }
            u32x2_ vf[4][2][2];
            { const bf16* vp = SBVT + (size_t)(h * 64 + r32) * 16384 + b * 4096 + kv0 + 4 * hi;
#pragma unroll
              for (int s = 0; s < 4; ++s)
#pragma unroll
                  for (int db = 0; db < 2; ++db) { vf[s][db][0] = *(const u32x2_*)(vp + (size_t)db * 32 * 16384 + 16 * s); vf[s][db][1] = *(const u32x2_*)(vp + (size_t)db * 32 * 16384 + 16 * s + 8); } }
            const bool diag = (kv0 + 63 >= q0);
            float z[32], sfx[32];
#pragma unroll
            for (int r = 0; r < 16; ++r) { z[r] = p0[r]; z[16 + r] = p1[r]; }
            if (diag) {
#pragma unroll
                for (int r = 0; r < 32; ++r) { const int kv = kv0 + (r & 3) + 8 * ((r & 15) >> 2) + 4 * hi + 32 * (r >> 4); if (kv >= qg) z[r] = -1.0e30f; } }
#pragma unroll
            for (int r = 0; r < 32; ++r) { const float e = __builtin_amdgcn_exp2f(-__builtin_fabsf(z[r]) * L2E); sfx[r] = -(__builtin_fmaxf(z[r], 0.f) + __builtin_amdgcn_logf(1.0f + e) * LN2); }
            float gs[8], pg[8];
#pragma unroll
            for (int k = 0; k < 8; ++k) { sfx[4 * k + 2] += sfx[4 * k + 3]; sfx[4 * k + 1] += sfx[4 * k + 2]; sfx[4 * k] += sfx[4 * k + 1]; gs[k] = sfx[4 * k]; }
#pragma unroll
            for (int k = 0; k < 8; ++k) pg[k] = __shfl_xor(gs[k], 32);
            float tail = 0.f;
#pragma unroll
            for (int k = 7; k >= 0; --k) { const float off = tail + (hi == 0 ? pg[k] : 0.f); tail += gs[k] + pg[k];
                sfx[4 * k] += off; sfx[4 * k + 1] += off; sfx[4 * k + 2] += off; sfx[4 * k + 3] += off; }
            unsigned pw[16];
#pragma unroll
            for (int r = 0; r < 32; r += 2) { const float w0 = __builtin_amdgcn_exp2f((z[r] + sfx[r] + c) * L2E), w1 = __builtin_amdgcn_exp2f((z[r + 1] + sfx[r + 1] + c) * L2E); pw[r >> 1] = cvtpk_bf16(w0, w1); }
            c += tail;
#pragma unroll
            for (int s = 0; s < 4; ++s) { const v4u pa = {pw[4 * s], pw[4 * s + 1], pw[4 * s + 2], pw[4 * s + 3]};
                const v4u b0 = {vf[s][0][0].x, vf[s][0][0].y, vf[s][0][1].x, vf[s][0][1].y}, b1 = {vf[s][1][0].x, vf[s][1][0].y, vf[s][1][1].x, vf[s][1][1].y};
                o0 = __builtin_amdgcn_mfma_f32_32x32x16_bf16(__builtin_bit_cast(bf16x8, pa), __builtin_bit_cast(bf16x8, b0), o0, 0, 0, 0);
                o1 = __builtin_amdgcn_mfma_f32_32x32x16_bf16(__builtin_bit_cast(bf16x8, pa), __builtin_bit_cast(bf16x8, b1), o1, 0, 0, 0); }
            if (__all(c < SB_CUT)) break;
        }
        bf16* yo = YSB + (size_t)(b * SEQ + q0) * 512 + h * 64 + r32;
#pragma unroll
        for (int r = 0; r < 16; ++r) { const int qr = (r & 3) + 8 * (r >> 2) + 4 * hi; yo[(size_t)qr * 512] = f2bf_s(o0[r]); yo[(size_t)qr * 512 + 32] = f2bf_s(o1[r]); }
    }
}
__device__ __forceinline__ void diffcombine_phase(Frame& F, const bf16* O0, const bf16* O1, const float* lamp  , const float* subg  , float lam_init, bf16* YDF) {
    const int gw = F.vcu * NWAVES + F.wave, NGW = F.G * NWAVES;
    const float s1 = wave_sum(lamp[F.lane] * lamp[64 + F.lane]), s2 = wave_sum(lamp[128 + F.lane] * lamp[192 + F.lane]);
    const float lam = expf(s1) - expf(s2) + lam_init;
    const int dd = (8 * F.lane) & 127; const f32x4 g0 = *(const f32x4*)(subg + dd), g1 = *(const f32x4*)(subg + dd + 4);
    for (int m = gw; m < T; m += NGW) {
        const v4u a = *(const v4u*)(O0 + (size_t)m * 512 + 8 * F.lane), bq = *(const v4u*)(O1 + (size_t)m * 512 + 8 * F.lane);
        float y[8]; y[0] = bf_lo(a.x) - lam * bf_lo(bq.x); y[1] = bf_hi(a.x) - lam * bf_hi(bq.x); y[2] = bf_lo(a.y) - lam * bf_lo(bq.y); y[3] = bf_hi(a.y) - lam * bf_hi(bq.y);
        y[4] = bf_lo(a.z) - lam * bf_lo(bq.z); y[5] = bf_hi(a.z) - lam * bf_hi(bq.z); y[6] = bf_lo(a.w) - lam * bf_lo(bq.w); y[7] = bf_hi(a.w) - lam * bf_hi(bq.w);
        float ss = 0.f;
#pragma unroll
        for (int j = 0; j < 8; ++j) ss += y[j] * y[j];
        ss += __shfl_xor(ss, 1); ss += __shfl_xor(ss, 2); ss += __shfl_xor(ss, 4); ss += __shfl_xor(ss, 8);
        const float rn = (1.0f / sqrtf(ss * (1.0f / 128.0f) + NORM_EPS)) * (1.0f - lam_init);
        v4u w; w.x = pk2(y[0] * rn * g0.x, y[1] * rn * g0.y); w.y = pk2(y[2] * rn * g0.z, y[3] * rn * g0.w); w.z = pk2(y[4] * rn * g1.x, y[5] * rn * g1.y); w.w = pk2(y[6] * rn * g1.z, y[7] * rn * g1.w);
        *(v4u*)(YDF + (size_t)m * 512 + 8 * F.lane) = w;
    }
}
#define CE_DESC(a_, b_) do { const float h_ = __builtin_fmaxf(a_, b_), l_ = __builtin_fminf(a_, b_); a_ = h_; b_ = l_; } while (0)
__device__ __forceinline__ void sort16_desc(float (&v)[16]) {
#pragma unroll
    for (int k = 2; k <= 16; k <<= 1)
#pragma unroll
        for (int j = k >> 1; j > 0; j >>= 1)
#pragma unroll
            for (int i = 0; i < 16; ++i) { const int l = i ^ j; if (l > i) { if ((i & k) == 0) CE_DESC(v[i], v[l]); else CE_DESC(v[l], v[i]); } }
}
__device__ __forceinline__ void merge_top16(float (&a)[16], const float (&b)[16]) {
#pragma unroll
    for (int i = 0; i < 16; ++i) a[i] = __builtin_fmaxf(a[i], b[15 - i]);
#pragma unroll
    for (int j = 8; j > 0; j >>= 1)
#pragma unroll
        for (int i = 0; i < 16; ++i) { const int l = i ^ j; if (l > i) CE_DESC(a[i], a[l]); }
}
__device__ __forceinline__ void topk_phase(Frame& F, const bf16* QP, const bf16* SUBK  , int* EIDX, float* EGATE) {
    const int lane = F.lane, r32 = lane & 31, hi = lane >> 5;
    for (int u0 = F.vcu * 16; u0 < 4096; u0 += F.G * 16)
#pragma unroll 1
      for (int uu = 0; uu < 2; ++uu) {
        const int unit = u0 + uu * 8 + F.wave, h = unit >> 9, t = (unit & 511) * 32 + r32;
        float lst[2][16];
#pragma unroll
        for (int c = 0; c < 2; ++c) {
            f32x16_ acc[4]; acc[0] = acc[1] = acc[2] = acc[3] = (f32x16_){};
            const bf16* qp = QP + (size_t)t * 2048 + h * 256 + c * 128 + hi * 8;
            const bf16* kp = SUBK + ((size_t)(h * 2 + c) * 128 + r32) * 128 + hi * 8;
#pragma unroll
            for (int ks = 0; ks < 8; ++ks) { const bf16x8 qf = *(const bf16x8*)(qp + ks * 16);
#pragma unroll
                for (int tl = 0; tl < 4; ++tl) { const bf16x8 kf = *(const bf16x8*)(kp + (size_t)tl * 32 * 128 + ks * 16); acc[tl] = __builtin_amdgcn_mfma_f32_32x32x16_bf16(kf, qf, acc[tl], 0, 0, 0); } }
            float g[4][16];
#pragma unroll
            for (int tl = 0; tl < 4; ++tl) {
#pragma unroll
                for (int r = 0; r < 16; ++r) g[tl][r] = __uint_as_float((__float_as_uint(acc[tl][r]) & ~127u) | (unsigned)(32 * tl + (r & 3) + 8 * (r >> 2) + 4 * hi));
                sort16_desc(g[tl]); }
            merge_top16(g[0], g[1]); merge_top16(g[2], g[3]); merge_top16(g[0], g[2]);
            float pr[16];
#pragma unroll
            for (int k = 0; k < 16; ++k) pr[k] = __shfl_xor(g[0][k], 32);
            merge_top16(g[0], pr);
#pragma unroll
            for (int k = 0; k < 16; ++k) lst[c][k] = g[0][k];
        }
        float bv[16];
#pragma unroll
        for (int k = 0; k < 16; ++k) bv[k] = -3.0e38f;
#pragma unroll
        for (int i = 0; i < 16; ++i)
#pragma unroll
            for (int j = 0; j < 16; ++j) if ((i + 1) * (j + 1) <= 16) {
                const unsigned a = __float_as_uint(lst[0][i]), b = __float_as_uint(lst[1][j]);
                float v = __uint_as_float((__float_as_uint(__uint_as_float(a & ~127u) + __uint_as_float(b & ~127u)) & ~255u) | (unsigned)(i * 16 + j));
#pragma unroll
                for (int k = 0; k < 16; ++k) { const float hh = __builtin_fmaxf(bv[k], v), ll = __builtin_fminf(bv[k], v); bv[k] = hh; v = ll; }
            }
        unsigned w0[4], w1[4];
#pragma unroll
        for (int k = 0; k < 4; ++k) { w0[k] = 0u; w1[k] = 0u;
#pragma unroll
            for (int b = 0; b < 4; ++b) { w0[k] |= (__float_as_uint(lst[0][4 * k + b]) & 127u) << (8 * b); w1[k] |= (__float_as_uint(lst[1][4 * k + b]) & 127u) << (8 * b); } }
        float e[16], sum = 0.f; int bp[16];
        const float vmax = __uint_as_float(__float_as_uint(bv[0]) & ~255u);
#pragma unroll
        for (int k = 0; k < 16; ++k) { const unsigned bits = __float_as_uint(bv[k]); const unsigned id = bits & 255u, ii = id >> 4, jj = id & 15u;
            const unsigned s0 = (ii >> 2) == 0 ? w0[0] : (ii >> 2) == 1 ? w0[1] : (ii >> 2) == 2 ? w0[2] : w0[3];
            const unsigned s1 = (jj >> 2) == 0 ? w1[0] : (jj >> 2) == 1 ? w1[1] : (jj >> 2) == 2 ? w1[2] : w1[3];
            bp[k] = (int)((((s0 >> (8 * (ii & 3))) & 127u) << 7) | ((s1 >> (8 * (jj & 3))) & 127u));
            e[k] = __expf(__uint_as_float(bits & ~255u) - vmax); sum += e[k]; }
        const float inv = 1.0f / sum;
        if (hi == 0) { int* ei = EIDX + (size_t)t * 128 + h * 16; float* eg = EGATE + (size_t)t * 128 + h * 16;
#pragma unroll
            for (int k = 0; k < 16; k += 4) { *(int4*)(ei + k) = make_int4(bp[k], bp[k + 1], bp[k + 2], bp[k + 3]); *(f32x4*)(eg + k) = (f32x4){e[k] * inv, e[k + 1] * inv, e[k + 2] * inv, e[k + 3] * inv}; } }
      }
}
struct XInfo { int k, nloc, nx, xi; };
__device__ __forceinline__ float dpp_add8(float s) {
    s += __builtin_bit_cast(float, __builtin_amdgcn_update_dpp(0, __builtin_bit_cast(int, s), 0xB1, 0xF, 0xF, true));
    s += __builtin_bit_cast(float, __builtin_amdgcn_update_dpp(0, __builtin_bit_cast(int, s), 0x4E, 0xF, 0xF, true));
    s += __builtin_bit_cast(float, __builtin_amdgcn_update_dpp(0, __builtin_bit_cast(int, s), 0x141, 0xF, 0xF, true));
    return s; }
typedef float f32x2_ __attribute__((ext_vector_type(2)));
#define PA_LOADE(E_, tt_) do { const int* ep_ = EIDX + (size_t)(tt_) * 128 + slot; _Pragma("unroll") for (int i_ = 0; i_ < 16; ++i_) E_[i_] = (unsigned)ep_[8 * i_] * 128u + sub16; } while (0)
#define PA_LOADW(W_, E_, base_) do { _Pragma("unroll") for (int i_ = 0; i_ < 16; ++i_) W_[i_] = *(const v4u*)((base_) + E_[i_]); } while (0)
template <int HALF_> __device__ __forceinline__ float peerA_eval_half(const v4u (&w)[16], const f32x2_ (&hf)[8], int sub) {
    float r0 = 0.f;
#pragma unroll
    for (int i = 8 * HALF_; i < 8 * HALF_ + 8; ++i) { f32x2_ acc = {0.f, 0.f};
#pragma unroll
        for (int c = 0; c < 4; ++c) { const int wd = (int)w[i][c]; acc = hf[2 * c] * __builtin_amdgcn_cvt_pk_f32_fp8(wd, false) + acc; acc = hf[2 * c + 1] * __builtin_amdgcn_cvt_pk_f32_fp8(wd, true) + acc; }
        const float s = dpp_add8(acc.x + acc.y);
        r0 = (sub == i - 8 * HALF_) ? s : r0; }
    return r0;
}
#define PA_LOADW_H(W_, E_, base_, H_) do { _Pragma("unroll") for (int i_ = 8 * (H_); i_ < 8 * (H_) + 8; ++i_) W_[i_] = *(const v4u*)((base_) + E_[i_]); } while (0)
#define PA_H2F(HF_, h0_, h1_) do { HF_[0] = (f32x2_){bf_lo(h0_.x), bf_hi(h0_.x)}; HF_[1] = (f32x2_){bf_lo(h0_.y), bf_hi(h0_.y)}; HF_[2] = (f32x2_){bf_lo(h0_.z), bf_hi(h0_.z)}; HF_[3] = (f32x2_){bf_lo(h0_.w), bf_hi(h0_.w)}; \
    HF_[4] = (f32x2_){bf_lo(h1_.x), bf_hi(h1_.x)}; HF_[5] = (f32x2_){bf_lo(h1_.y), bf_hi(h1_.y)}; HF_[6] = (f32x2_){bf_lo(h1_.z), bf_hi(h1_.z)}; HF_[7] = (f32x2_){bf_lo(h1_.w), bf_hi(h1_.w)}; } while (0)
__device__ __forceinline__ void peerA_phase(Frame& F, const XInfo X, const bf16* H2, const int* EIDX, const unsigned char* U8, float* APART) {
    const int sub = F.lane & 7, slot = F.lane >> 3; const int ts = X.nloc * NWAVES; const unsigned sub16 = (unsigned)sub * 16u;
    for (int r = X.xi; r < 8; r += X.nx) {
        const unsigned char* Ur = U8 + (size_t)r * NEXP * 128; float* Ar = APART + (size_t)r * T * 128; const bf16* Hr = H2 + 128 * r + 16 * sub;
        int t = X.k * NWAVES + F.wave;
        unsigned e0[16], e1[16]; v4u w0[16], w1[16]; v4u h0, h1; f32x2_ hf[8];
        PA_LOADE(e0, t); h0 = *(const v4u*)(Hr + (size_t)t * D); h1 = *(const v4u*)(Hr + (size_t)t * D + 8); PA_LOADW(w0, e0, Ur);
        if (t + ts < T) PA_LOADE(e1, t + ts);
        for (;;) {
            { const bool n1 = t + ts < T, n2 = t + 2 * ts < T;
              PA_H2F(hf, h0, h1);
              if (n1) { PA_LOADW_H(w1, e1, Ur, 0); h0 = *(const v4u*)(Hr + (size_t)(t + ts) * D); h1 = *(const v4u*)(Hr + (size_t)(t + ts) * D + 8); }
              const float ra = peerA_eval_half<0>(w0, hf, sub); __builtin_amdgcn_sched_barrier(0);
              if (n1) PA_LOADW_H(w1, e1, Ur, 1);
              if (n2) PA_LOADE(e0, t + 2 * ts);
              const float rb = peerA_eval_half<1>(w0, hf, sub);
              { float* dst = Ar + (size_t)t * 128; dst[8 * sub + slot] = ra; dst[64 + 8 * sub + slot] = rb; }
              if (!n1) break; t += ts; }
            { const bool n1 = t + ts < T, n2 = t + 2 * ts < T;
              PA_H2F(hf, h0, h1);
              if (n1) { PA_LOADW_H(w0, e0, Ur, 0); h0 = *(const v4u*)(Hr + (size_t)(t + ts) * D); h1 = *(const v4u*)(Hr + (size_t)(t + ts) * D + 8); }
              const float ra = peerA_eval_half<0>(w1, hf, sub); __builtin_amdgcn_sched_barrier(0);
              if (n1) PA_LOADW_H(w0, e0, Ur, 1);
              if (n2) PA_LOADE(e1, t + 2 * ts);
              const float rb = peerA_eval_half<1>(w1, hf, sub);
              { float* dst = Ar + (size_t)t * 128; dst[8 * sub + slot] = ra; dst[64 + 8 * sub + slot] = rb; }
              if (!n1) break; t += ts; }
        }
    }
}
__device__ __forceinline__ void peerAct_phase(Frame& F, const float* APART, float* EGATE) {
    const int gt = F.vcu * 512 + F.tid, NT = F.G * 512;
    for (int i = gt; i < T * 128 / 4; i += NT) { f32x4 a = *(const f32x4*)(APART + (size_t)i * 4);
#pragma unroll
        for (int r = 1; r < 8; ++r) a = a + *(const f32x4*)(APART + (size_t)r * T * 128 + (size_t)i * 4);
        a = a * (1.0f / 32.0f); const f32x4 g = *(const f32x4*)(EGATE + (size_t)i * 4); f32x4 o;
#pragma unroll
        for (int j = 0; j < 4; ++j) o[j] = 0.5f * a[j] * (1.0f + erff(a[j] * 0.70710678118654752f)) * g[j];
        *(f32x4*)(EGATE + (size_t)i * 4) = o; }
}
#define PB_LOADA(A_, tt_) do { const float* ap_ = ACT + (size_t)(tt_) * 128 + slot; _Pragma("unroll") for (int i_ = 0; i_ < 16; ++i_) A_[i_] = ap_[8 * i_]; } while (0)
__device__ __forceinline__ float swap32_add(float a, float b) { const auto r = __builtin_amdgcn_permlane32_swap(__float_as_uint(a), __float_as_uint(b), false, false); return __uint_as_float(r[0]) + __uint_as_float(r[1]); }
__device__ __forceinline__ float swap16_add(float a, float b) { const auto r = __builtin_amdgcn_permlane16_swap(__float_as_uint(a), __float_as_uint(b), false, false); return __uint_as_float(r[0]) + __uint_as_float(r[1]); }
__device__ __forceinline__ void peerB_eval(const v4u (&w)[16], const float (&a)[16], const float* xrow  , const float* grow  , float* orow, int sub, int slot) {
    f32x2_ acc[8];
#pragma unroll
    for (int j = 0; j < 8; ++j) acc[j] = (f32x2_){0.f, 0.f};
#pragma unroll
    for (int i = 0; i < 16; ++i) { const f32x2_ a2 = {a[i], a[i]};
#pragma unroll
        for (int c = 0; c < 4; ++c) { const int wd = (int)w[i][c]; acc[2 * c] = a2 * __builtin_amdgcn_cvt_pk_f32_fp8(wd, false) + acc[2 * c]; acc[2 * c + 1] = a2 * __builtin_amdgcn_cvt_pk_f32_fp8(wd, true) + acc[2 * c + 1]; } }
    float v8[8], v4[4];
#pragma unroll
    for (int j = 0; j < 8; ++j) v8[j] = swap32_add(acc[j >> 1][j & 1], acc[(j + 8) >> 1][j & 1]);
#pragma unroll
    for (int j = 0; j < 4; ++j) v4[j] = swap16_add(v8[j], v8[j + 4]);
    const bool b3 = (slot & 1) != 0; float v2[2];
#pragma unroll
    for (int j = 0; j < 2; ++j) { const float keep = b3 ? v4[j + 2] : v4[j], send = b3 ? v4[j] : v4[j + 2];
        v2[j] = keep + __builtin_bit_cast(float, __builtin_amdgcn_update_dpp(0, __builtin_bit_cast(int, send), 0x128, 0xF, 0xF, true)); }
    const int dd = 16 * sub + 2 * slot; const f32x2_ xv = *(const f32x2_*)(xrow + dd), gv = *(const f32x2_*)(grow + dd);
    *(f32x2_*)(orow + dd) = xv + gv * (f32x2_){v2[0], v2[1]};
}
__device__ __forceinline__ void peerB_phase(Frame& F, const XInfo X, const float* ACT, const int* EIDX, const unsigned char* V8, const float* x1, const float* gate2  , float* xout) {
    const int sub = F.lane & 7, slot = F.lane >> 3; const int ts = X.nloc * NWAVES; const unsigned sub16 = (unsigned)sub * 16u;
    for (int r = X.xi; r < 8; r += X.nx) {
        const unsigned char* Vr = V8 + (size_t)r * NEXP * 128;
        int t = X.k * NWAVES + F.wave;
        unsigned e0[16], e1[16]; float a0[16], a1[16]; v4u w0[16], w1[16];
        PA_LOADE(e0, t); PB_LOADA(a0, t); PA_LOADW(w0, e0, Vr);
        if (t + ts < T) PA_LOADE(e1, t + ts);
        for (;;) {
            { const bool n1 = t + ts < T, n2 = t + 2 * ts < T;
              if (n1) { PA_LOADW(w1, e1, Vr); PB_LOADA(a1, t + ts); }
              if (n2) PA_LOADE(e0, t + 2 * ts);
              peerB_eval(w0, a0, x1 + (size_t)t * D + 128 * r, gate2 + (size_t)(t >> 12) * 6144 + 128 * r, xout + (size_t)t * D + 128 * r, sub, slot);
              if (!n1) break; t += ts; }
            { const bool n1 = t + ts < T, n2 = t + 2 * ts < T;
              if (n1) { PA_LOADW(w0, e0, Vr); PB_LOADA(a0, t + ts); }
              if (n2) PA_LOADE(e1, t + 2 * ts);
              peerB_eval(w1, a1, x1 + (size_t)t * D + 128 * r, gate2 + (size_t)(t >> 12) * 6144 + 128 * r, xout + (size_t)t * D + 128 * r, sub, slot);
              if (!n1) break; t += ts; }
        }
    }
}
__device__ __forceinline__ void finalnorm_phase(Frame& F, const float* x, const float* g, float* out, const unsigned char* ws) {
    const int gw = F.vcu * NWAVES + F.wave, NGW = F.G * NWAVES;
    for (int m = gw; m < T; m += NGW) {
        const f32x4* xr = (const f32x4*)(x + (size_t)m * D) + F.lane; f32x4 v[4]; float s = 0.f;
#pragma unroll
        for (int j = 0; j < 4; ++j) { v[j] = xr[64 * j]; s += (v[j].x * v[j].x + v[j].y * v[j].y) + (v[j].z * v[j].z + v[j].w * v[j].w); }
        float r = 1.0f / sqrtf(wave_sum(s) * (1.0f / D) + NORM_EPS);
#ifdef TIMING_SEL
        r *= 1.0f + TIMING_GAIN * *(const float*)(ws + 65536);
#endif
        f32x4* o = (f32x4*)(out + (size_t)m * D) + F.lane;
#pragma unroll
        for (int j = 0; j < 4; ++j) o[64 * j] = (v[j] * r) * *(const f32x4*)(g + 4 * F.lane + 256 * j);
    }
}
#define WSP(T_, off) ((T_*)(ws + (off)))
#define RETID() do { int t_ = threadIdx.x; asm volatile("" : "+v"(t_)); F.tid = t_; F.lane = t_ & 63; F.wave = __builtin_amdgcn_readfirstlane(t_ >> 6); } while (0)
#define GRID_BAR() xcd_barrier(bar)
#ifdef TIMING_SEL
#define STAMP(id) do { if (blockIdx.x == 0 && threadIdx.x == 0) { const unsigned now_ = (unsigned)__builtin_amdgcn_s_memrealtime(); if ((TIMING_SEL >> (id)) & 1) F.MISC[17] = F.MISC[17] + (now_ - F.MISC[16]); F.MISC[16] = now_; } } while (0)
#else
#define STAMP(id) do { } while (0)
#endif
template <int l> __device__ __forceinline__ void layer_program(Frame& F, const Args& args, unsigned char* ws, const XcdBarrier& bar, unsigned char* lds) {
        const float* mod = WSP(const float, WS_MOD) + (size_t)l * 4 * 6144;
#ifndef NO_P1
        RETID();
        hnorm_phase(F, (l == 0) ? args.in[0] : WSP(const float, WS_XB), args.in[2] + (size_t)l * D, mod + 0, mod + 1024, WSP(bf16, WS_H));
        cvt_table8(F, args.in[15] + (size_t)l * NEXP * D, WSP(unsigned char, WS_U8), 32.0f);
        cvt_table8(F, args.in[16] + (size_t)l * NEXP * D, WSP(unsigned char, WS_V8), 1.0f);
#endif
        GRID_BAR(); STAMP(1);
#ifndef NO_P2
        { pg8::Gemm g{WSP(const bf16, WS_H), WSP(const bf16, WS_WIN) + (size_t)l * INCOLS * D, T, INCOLS, D}; pg8::StaticOrder S; S.init(T, INCOLS, F.G, (int)blockIdx.x);
          pg8::EpiIn E{ws, args.in[7] + (size_t)l * 2048};
          pg8::gemm_phase<pg8::EpiIn, pg8::StaticOrder, PG8_ALIGN, PG8_SP2>(F.lds + RING_OFF, g, S, E); }
#ifndef SB_SCALAR
        { pg8::Gemm g{WSP(const bf16, WS_WIN) + (size_t)l * INCOLS * D + (size_t)1024 * D, WSP(const bf16, WS_H), 512, T, D}; pg8::StaticOrder S; S.init(512, T, F.G, (int)blockIdx.x);
          pg8::EpiBf16<0> E{WSP(bf16, WS_SBVT), T, nullptr, 0, 0, 1.f};
          pg8::gemm_phase<pg8::EpiBf16<0>, pg8::StaticOrder, PG8_ALIGN, PG8_SP2>(F.lds + RING_OFF, g, S, E); }
#endif
#endif
        GRID_BAR(); STAMP(2);
#ifndef NO_P3A
        { const attn_body::AttnTensors AT{WSP(const attn_body::bf16, WS_DQ), WSP(const attn_body::bf16, WS_DK), WSP(const attn_body::bf16, WS_DV), WSP(attn_body::bf16, WS_H), WSP(attn_body::bf16, WS_H) + (size_t)T * 512};
          const attn_body::StaticOrder S((int)F.G, (int)blockIdx.x);
          attn_body::attn_phase<attn_body::StaticOrder>((char*)lds + RING_OFF, AT, S); }
#endif
        STAMP(3);
#ifndef NO_P3B
        RETID();
#ifdef SB_SCALAR
        sb_scalar_phase(F, WSP(const bf16, WS_SBQ), WSP(const bf16, WS_SBK), WSP(const bf16, WS_SBV), WSP(bf16, WS_YSB));
#else
        sb_mfma_phase(F, WSP(const bf16, WS_SBQ), WSP(const bf16, WS_SBK), WSP(const bf16, WS_SBVT), WSP(bf16, WS_YSB));
#endif
#endif
        GRID_BAR(); STAMP(4);
#ifndef NO_P4
        { pg8::Gemm g{WSP(const bf16, WS_YSB), WSP(const bf16, WS_WSB) + (size_t)l * D * 512, T, D, 512}; pg8::StaticOrder S; S.init(T, D, F.G, (int)blockIdx.x);
          pg8::EpiGate E{WSP(bf16, WS_M1), WSP(const bf16, WS_GSB), nullptr};
          pg8::gemm_phase<pg8::EpiGate, pg8::StaticOrder, PG8_ALIGN, PG8_SP2>(F.lds + RING_OFF, g, S, E); }
        RETID();
        diffcombine_phase(F, WSP(const bf16, WS_H), WSP(const bf16, WS_H) + (size_t)T * 512, args.in[8] + (size_t)l * 256, args.in[9] + (size_t)l * 128, 0.8f - 0.6f * expf(-0.3f * (float)l), WSP(bf16, WS_YDF));
#endif
        GRID_BAR(); STAMP(5);
#ifndef NO_P5
        { pg8::Gemm g{WSP(const bf16, WS_YDF), WSP(const bf16, WS_WDF) + (size_t)l * D * 512, T, D, 512}; pg8::StaticOrder S; S.init(T, D, F.G, (int)blockIdx.x);
          pg8::EpiGate E{WSP(bf16, WS_MRG), WSP(const bf16, WS_GDF), WSP(const bf16, WS_M1)};
          pg8::gemm_phase<pg8::EpiGate, pg8::StaticOrder, PG8_ALIGN, PG8_SP2>(F.lds + RING_OFF, g, S, E); }
#endif
        GRID_BAR(); STAMP(6);
#ifndef NO_P6
        { pg8::Gemm g{WSP(const bf16, WS_MRG), WSP(const bf16, WS_WOUT) + (size_t)l * D * D, T, D, D}; pg8::StaticOrder S; S.init(T, D, F.G, (int)blockIdx.x);
          pg8::EpiRes E{(l == 0) ? args.in[0] : WSP(const float, WS_XB), WSP(float, WS_XA), mod + 2048, 6144};
          pg8::gemm_phase<pg8::EpiRes, pg8::StaticOrder, PG8_ALIGN, PG8_SP2>(F.lds + RING_OFF, g, S, E); }
#endif
        GRID_BAR(); STAMP(7);
#ifndef NO_P7
        RETID();
        hnorm_phase(F, WSP(const float, WS_XA), args.in[3] + (size_t)l * D, mod + 3072, mod + 4096, WSP(bf16, WS_H));
#endif
        GRID_BAR(); STAMP(8);
#ifndef NO_P8
        { pg8::Gemm g{WSP(const bf16, WS_H), WSP(const bf16, WS_WQ) + (size_t)l * 2048 * D, T, 2048, D}; pg8::StaticOrder S; S.init(T, 2048, F.G, (int)blockIdx.x);
          pg8::EpiBf16<0> E{WSP(bf16, WS_QP), 2048, nullptr, 0, 0, 1.f};
          pg8::gemm_phase<pg8::EpiBf16<0>, pg8::StaticOrder, PG8_ALIGN, PG8_SP2>(F.lds + RING_OFF, g, S, E); }
#endif
        GRID_BAR(); STAMP(9);
#ifndef NO_P9
        RETID();
        topk_phase(F, WSP(const bf16, WS_QP), WSP(const bf16, WS_SUBK) + (size_t)l * 8 * 2 * 128 * 128, WSP(int, WS_EIDX), WSP(float, WS_EGATE));
#endif
        GRID_BAR(); STAMP(10);
#ifndef NO_P10
        { const XInfo X{__builtin_amdgcn_readfirstlane((int)F.MISC[10]), __builtin_amdgcn_readfirstlane((int)F.MISC[11]), __builtin_amdgcn_readfirstlane((int)F.MISC[12]), __builtin_amdgcn_readfirstlane((int)F.MISC[13])};
          RETID();
          peerA_phase(F, X, WSP(const bf16, WS_H), WSP(const int, WS_EIDX), WSP(const unsigned char, WS_U8), WSP(float, WS_APART));
          GRID_BAR(); STAMP(11);
          RETID();
          peerAct_phase(F, WSP(const float, WS_APART), WSP(float, WS_EGATE));
          GRID_BAR(); STAMP(12);
          RETID();
          peerB_phase(F, X, WSP(const float, WS_EGATE), WSP(const int, WS_EIDX), WSP(const unsigned char, WS_V8), WSP(const float, WS_XA), mod + 5120, WSP(float, WS_XB));
          if (l == DEPTH - 1) {
#ifdef TIMING_SEL
              asm volatile("s_waitcnt vmcnt(0)" ::: "memory"); __syncthreads(); STAMP(13);
              if (blockIdx.x == 0 && threadIdx.x == 0) { const unsigned now_ = (unsigned)__builtin_amdgcn_s_memrealtime(); *WSP(float, WS_CTL + 65536) = (float)F.MISC[17] / (float)(now_ - F.MISC[18]); }
#endif
              GRID_BAR(); RETID(); finalnorm_phase(F, WSP(const float, WS_XB), args.in[17], args.out, ws); }
          else { if (l + 1 < DEPTH) { GRID_BAR(); STAMP(13); } } }
#endif
}
__global__ void __launch_bounds__(NWAVES * 64, 2) mega_fwd(Args args) {
    extern __shared__ __attribute__((aligned(16))) unsigned char lds[];
    Frame F; F.lds = (LAS unsigned char*)lds; F.MISC = (volatile LAS unsigned*)(F.lds + MISC_OFF);
    F.tid = threadIdx.x; F.lane = F.tid & 63; F.wave = __builtin_amdgcn_readfirstlane(F.tid >> 6);
    F.G = gridDim.x; { const int bx = blockIdx.x; F.vcu = (F.G % 8 == 0) ? (bx % 8) * (F.G / 8) + bx / 8 : bx; }
    unsigned char* ws = args.ws;
    gu32* ctl = (gu32*)(ws + WS_CTL);
    for (int u = F.tid; u < (LDS_BYTES - LDSCTL_OFF) / 4; u += NWAVES * 64) ((LAS unsigned*)(F.lds + LDSCTL_OFF))[u] = 0u;
    __syncthreads();
    XcdBarrier bar = xcd_barrier_post((unsigned*)(ctl + CW_BAR), F.MISC + 8);
    if (F.tid == 0) F.MISC[10] = xb_add((unsigned*)(ctl + CW_RANK) + 64 * bar.x, 1u);
#ifdef TIMING_SEL
    if (blockIdx.x == 0 && threadIdx.x == 0) F.MISC[20] = (unsigned)__builtin_amdgcn_s_memrealtime();
#endif
    p0_prologue(F, args);
    asm volatile("s_waitcnt vmcnt(0)" ::: "memory");
    cg::this_grid().sync();
    GRID_BAR();
    if (F.tid == 0) { unsigned nx = 0u, xi = 0u, mine = 1u;
        for (unsigned j = 0; j < 16; ++j) { const unsigned c = xb_ld((unsigned*)(ctl + CW_RANK) + 64 * j); nx += c > 0u; xi += (c > 0u && j < bar.x); if (j == bar.x) mine = c; }
        F.MISC[11] = mine ? mine : 1u; F.MISC[12] = nx ? nx : 1u; F.MISC[13] = xi; }
    __syncthreads();
#ifdef TIMING_SEL
    if (blockIdx.x == 0 && threadIdx.x == 0) { const unsigned now_ = (unsigned)__builtin_amdgcn_s_memrealtime(); F.MISC[18] = F.MISC[20]; F.MISC[17] = ((TIMING_SEL) & 1) ? now_ - F.MISC[20] : 0u; F.MISC[16] = now_; }
#endif
    layer_program<0>(F, args, ws, bar, lds);
    layer_program<1>(F, args, ws, bar, lds);
}

extern "C" void kernel_launch(void* const* d_in, const int* in_sizes, int n_in, void* d_out, int out_size, void* d_ws, size_t ws_size, hipStream_t stream) {
    static int grid = 0;
    if (grid == 0) {
        if (n_in != 18 || in_sizes[0] != T * D || out_size != T * D || ws_size < WS_END) { fprintf(stderr, "kernel_launch: unexpected shapes (n_in %d, in0 %d, out %d, ws %zu < %zu); nothing launched\n", n_in, n_in > 0 ? in_sizes[0] : -1, out_size, ws_size, (size_t)WS_END); grid = -1; return; }
        int dev = 0, cus = 0, per_cu = 0;
        if (hipGetDevice(&dev) != hipSuccess || hipDeviceGetAttribute(&cus, hipDeviceAttributeMultiprocessorCount, dev) != hipSuccess) { fprintf(stderr, "kernel_launch: device query failed\n"); grid = -1; return; }
        if (hipFuncSetAttribute((const void*)mega_fwd, hipFuncAttributeMaxDynamicSharedMemorySize, LDS_BYTES) != hipSuccess) { fprintf(stderr, "kernel_launch: hipFuncSetAttribute failed\n"); grid = -1; return; }
        if (hipOccupancyMaxActiveBlocksPerMultiprocessor(&per_cu, (const void*)mega_fwd, NWAVES * 64, LDS_BYTES) != hipSuccess || per_cu < 1) { fprintf(stderr, "kernel_launch: occupancy query reports %d workgroups per CU\n", per_cu); (void)hipGetLastError(); grid = -1; return; }
        grid = cus;
    }
    if (grid < 0) return;
    if (hipMemsetAsync((char*)d_ws + WS_CTL, 0, CTL_ZERO_BYTES, stream) != hipSuccess) { fprintf(stderr, "kernel_launch: hipMemsetAsync failed\n"); return; }
    Args a{};
    for (int i = 0; i < 18; ++i) a.in[i] = (const float*)d_in[i];
    a.out = (float*)d_out; a.ws = (unsigned char*)d_ws;
    void* kargs[] = {&a};
    const hipError_t le = hipLaunchCooperativeKernel((const void*)mega_fwd, dim3(grid), dim3(NWAVES * 64), kargs, LDS_BYTES, stream);
    if (le != hipSuccess) fprintf(stderr, "kernel_launch: cooperative launch failed: %s (grid %d)\n", hipGetErrorName(le), grid);
}
```
